# Optimizing an MI355X kernel written in HIP

```python
import math
import jax, jax.numpy as jnp
from jax import lax
import numpy as np

D_MODEL = 1024
BATCH = 8
SEQ = 4096
DEPTH = 2

GRID_W = 64
CTX_LEN = 256
D_MIX = D_MODEL
S5_WIDTH = D_MIX // 4
S5_IN = 16
S5_GROUPS = S5_WIDTH // S5_IN
S5_STATE = 64
RET_WIDTH = D_MIX // 2
RET_HEAD_DIM = 64
RET_HEADS = RET_WIDTH // RET_HEAD_DIM
RET_CHUNK = 128
POOL_WIDTH = D_MIX - S5_WIDTH - RET_WIDTH
POOL_WINDOWS = (2, 4, 8, 16)
POOL_GROUP = POOL_WIDTH // len(POOL_WINDOWS)
IN_WIDTH = S5_WIDTH + 4 * RET_WIDTH + POOL_WIDTH
IN_SPLITS = (S5_WIDTH, S5_WIDTH + RET_WIDTH, S5_WIDTH + 2 * RET_WIDTH, S5_WIDTH + 3 * RET_WIDTH, S5_WIDTH + 4 * RET_WIDTH)
N_EXPERTS = 16
N_EXPERT_GROUPS = 4
EXPERTS_PER_GROUP = N_EXPERTS // N_EXPERT_GROUPS
TOP_K = 2
D_FF_EXPERT = 1024
MOE_BLOCK = 128
ROPE_BASE = 10000.0
NORM_EPS = 1e-6
GN_EPS = 1e-5

kernel_name = "hybrid_s5_retention_pool_grouped_moe_dit"

F32 = jnp.float32


def rmsnorm(t, w):
    t32 = t.astype(F32)
    y = t32 * lax.rsqrt(jnp.mean(t32 * t32, axis=-1, keepdims=True) + NORM_EPS) * w.astype(F32)
    return y.astype(t.dtype)


def rotary(t, pos):
    half = t.shape[-1] // 2
    inv_freq = ROPE_BASE ** (-jnp.arange(half, dtype=F32) / half)
    ang = pos[:, None] * inv_freq[None, :]
    cos, sin = jnp.cos(ang), jnp.sin(ang)
    t1, t2 = t[..., :half], t[..., half:]
    return jnp.concatenate([t1 * cos - t2 * sin, t1 * sin + t2 * cos], axis=-1)


def complex_affine_combine(first, second):
    a1r, a1i, b1r, b1i = first
    a2r, a2i, b2r, b2i = second
    return (a2r * a1r - a2i * a1i,
            a2r * a1i + a2i * a1r,
            a2r * b1r - a2i * b1i + b2r,
            a2r * b1i + a2i * b1r + b2i)


def s5_direction(u_c, u_l, a_re, a_im, log_dt, b_re, b_im, c_re, c_im, need_ctx_out):
    a_re, a_im = a_re.astype(F32), a_im.astype(F32)
    b_re, b_im = b_re.astype(F32), b_im.astype(F32)
    c_re, c_im = c_re.astype(F32), c_im.astype(F32)
    dt = jnp.exp(log_dt.astype(F32))[:, None]
    mag = jnp.exp(dt * a_re)
    ab_re = mag * jnp.cos(dt * a_im)
    ab_im = mag * jnp.sin(dt * a_im)
    inv_abs2 = 1.0 / (a_re * a_re + a_im * a_im)
    f_re = ((ab_re - 1.0) * a_re + ab_im * a_im) * inv_abs2
    f_im = (ab_im * a_re - (ab_re - 1.0) * a_im) * inv_abs2
    bb_re = f_re[..., None] * b_re - f_im[..., None] * b_im
    bb_im = f_re[..., None] * b_im + f_im[..., None] * b_re

    def scan(u, h0):
        s_re = jnp.einsum("blgh,gph->blgp", u, bb_re)
        s_im = jnp.einsum("blgh,gph->blgp", u, bb_im)
        if h0 is not None:
            h_re, h_im = h0
            s_re = s_re.at[:, 0].add(ab_re * h_re - ab_im * h_im)
            s_im = s_im.at[:, 0].add(ab_re * h_im + ab_im * h_re)
        a_r = jnp.broadcast_to(ab_re, s_re.shape)
        a_i = jnp.broadcast_to(ab_im, s_im.shape)
        _, _, s_re, s_im = lax.associative_scan(complex_affine_combine, (a_r, a_i, s_re, s_im), axis=1)
        return s_re, s_im

    def readout(s_re, s_im):
        return jnp.einsum("blgp,ghp->blgh", s_re, c_re) - jnp.einsum("blgp,ghp->blgh", s_im, c_im)

    sc_re, sc_im = scan(u_c, None)
    y_c = readout(sc_re, sc_im) if need_ctx_out else None
    y_l = readout(*scan(u_l, (sc_re[:, -1], sc_im[:, -1])))
    return y_c, y_l


def s5_mixer(u_c, u_l, a_re, a_im, log_dt, b_re, b_im, c_re, c_im, d_skip, glu_w, glu_b, need_ctx_out):
    def groups(u):
        return u.astype(F32).reshape(u.shape[0], u.shape[1], S5_GROUPS, S5_IN)

    def flip(t):
        return t[:, ::-1]

    uc, ul = groups(u_c), groups(u_l)
    yc_f, yl_f = s5_direction(uc, ul, a_re[0], a_im[0], log_dt[0], b_re[0], b_im[0], c_re[0], c_im[0], need_ctx_out)
    yc_b, yl_b = s5_direction(flip(uc), flip(ul), a_re[1], a_im[1], log_dt[1], b_re[1], b_im[1], c_re[1], c_im[1], need_ctx_out)

    def glu_out(y_f, y_b, u):
        y = (y_f + flip(y_b)).reshape(u.shape) + d_skip.astype(F32) * u.astype(F32)
        z = jax.nn.gelu(y)
        return (z * jax.nn.sigmoid(z @ glu_w.astype(F32) + glu_b.astype(F32))).astype(u.dtype)

    y_l = glu_out(yl_f, yl_b, u_l)
    y_c = glu_out(yc_f, yc_b, u_c) if need_ctx_out else None
    return y_c, y_l


def retention_chunks(q, k, v, log_gamma, state0, inclusive):
    bn, nh, seq_len, _ = q.shape
    n_chunks = seq_len // RET_CHUNK
    i = jnp.arange(RET_CHUNK, dtype=F32)
    diff = i[:, None] - i[None, :]
    keep = diff >= 0 if inclusive else diff > 0
    intra = jnp.where(keep, jnp.exp(jnp.maximum(diff, 0.0) * log_gamma[:, None, None]), 0.0)
    q_dec = jnp.exp((i[None, :] + 1.0) * log_gamma[:, None])[:, :, None]
    k_dec = jnp.exp((RET_CHUNK - 1.0 - i[None, :]) * log_gamma[:, None])[:, :, None]
    c_dec = jnp.exp(RET_CHUNK * log_gamma)[:, None, None]

    def to_chunks(t):
        return t.reshape(bn, nh, n_chunks, RET_CHUNK, t.shape[-1]).transpose(2, 0, 1, 3, 4)

    def step(state, blk):
        qc, kc, vc = blk
        scores = jnp.einsum("bhid,bhjd->bhij", qc, kc) * intra
        out = jnp.einsum("bhij,bhjv->bhiv", scores, vc) + jnp.einsum("bhid,bhdv->bhiv", qc, state) * q_dec
        state = state * c_dec + jnp.einsum("bhjd,bhjv->bhdv", kc * k_dec, vc)
        return state, out

    state, outs = lax.scan(step, state0, (to_chunks(q), to_chunks(k), to_chunks(v)))
    out = outs.transpose(1, 2, 0, 3, 4).reshape(bn, nh, seq_len, v.shape[-1])
    return out, state


def retention_direction(q_c, k_c, v_c, q_l, k_l, v_l, log_gamma, inclusive, need_ctx_out):
    n_ctx, n_lat = k_c.shape[2], k_l.shape[2]
    pos_c = jnp.arange(n_ctx, dtype=F32)
    pos_l = n_ctx + jnp.arange(n_lat, dtype=F32)
    k_c = rotary(k_c, pos_c)
    k_l = rotary(k_l, pos_l)
    q_l = rotary(q_l, pos_l)
    if need_ctx_out:
        state0 = jnp.zeros(k_c.shape[:2] + (k_c.shape[-1], v_c.shape[-1]), F32)
        o_c, state = retention_chunks(rotary(q_c, pos_c), k_c, v_c, log_gamma, state0, inclusive)
    else:
        age = (n_ctx - 1.0) - pos_c
        w = jnp.exp(age[None, :] * log_gamma[:, None])
        state = jnp.einsum("bhmd,bhmv->bhdv", k_c * w[None, :, :, None], v_c)
        o_c = None
    o_l, _ = retention_chunks(q_l, k_l, v_l, log_gamma, state, inclusive)
    return o_c, o_l


def retention_readout(o, g, gn_w):
    mu = jnp.mean(o, axis=-1, keepdims=True)
    var = jnp.mean((o - mu) ** 2, axis=-1, keepdims=True)
    o = (o - mu) * lax.rsqrt(var + GN_EPS)
    bn, nh, seq_len, dv = o.shape
    o = o.transpose(0, 2, 1, 3).reshape(bn, seq_len, nh * dv)
    return (o * gn_w.astype(F32) * jax.nn.silu(g.astype(F32))).astype(g.dtype)


def retention_mixer(q_c, k_c, v_c, g_c, q_l, k_l, v_l, g_l, decay_logit, gn_w, need_ctx_out):
    log_gamma = jax.nn.log_sigmoid(decay_logit.astype(F32))
    scale = RET_HEAD_DIM ** -0.5

    def heads(t):
        bn, seq_len, _ = t.shape
        return t.astype(F32).reshape(bn, seq_len, RET_HEADS, RET_HEAD_DIM).transpose(0, 2, 1, 3)

    def flip(t):
        return t[:, :, ::-1]

    qc, kc, vc = heads(q_c), heads(k_c) * scale, heads(v_c)
    ql, kl, vl = heads(q_l), heads(k_l) * scale, heads(v_l)
    oc_f, ol_f = retention_direction(qc, kc, vc, ql, kl, vl, log_gamma[0], True, need_ctx_out)
    oc_b, ol_b = retention_direction(flip(qc), flip(kc), flip(vc), flip(ql), flip(kl), flip(vl),
                                     log_gamma[1], False, need_ctx_out)
    y_l = retention_readout(ol_f + flip(ol_b), g_l, gn_w)
    y_c = retention_readout(oc_f + flip(oc_b), g_c, gn_w) if need_ctx_out else None
    return y_c, y_l


def centred_window_mean(v, window):
    n = v.shape[-2]
    j = np.arange(n)
    lo = np.maximum(j - window // 2, 0)
    hi = np.minimum(j - window // 2 + window - 1, n - 1)
    csum = jnp.cumsum(v, axis=-2)
    csum = jnp.concatenate([jnp.zeros_like(csum[..., :1, :]), csum], axis=-2)
    total = jnp.take(csum, hi + 1, axis=-2) - jnp.take(csum, lo, axis=-2)
    count = (hi - lo + 1).astype(np.float32)[:, None]
    return total / count


def pool_mixer(p, pool_w, pool_scale):
    p32 = p.astype(F32)
    parts = []
    for gi, win in enumerate(POOL_WINDOWS):
        vg = p32[..., gi * POOL_GROUP:(gi + 1) * POOL_GROUP]
        parts.append(centred_window_mean(vg, win) - vg)
    pooled = jnp.stack(parts, axis=-2)
    mixed = jnp.einsum("...gc,gcd->...gd", pooled, pool_w.astype(F32))
    return (mixed.reshape(p.shape) * pool_scale.astype(F32)).astype(p.dtype)


def token_mixer(h_c, h_l, rows, w_in, w_out, s5_a_re, s5_a_im, s5_log_dt, s5_b_re, s5_b_im, s5_c_re,
                s5_c_im, s5_d, s5_glu_w, s5_glu_b, ret_decay, ret_gn_w, pool_w, pool_scale, need_ctx_out):
    u_l, q_l, k_l, v_l, g_l, p_l = jnp.split(h_l @ w_in, IN_SPLITS, axis=-1)
    u_c, q_c, k_c, v_c, g_c, p_c = jnp.split(h_c @ w_in, IN_SPLITS, axis=-1)
    s5_c, s5_l = s5_mixer(u_c, u_l, s5_a_re, s5_a_im, s5_log_dt, s5_b_re, s5_b_im, s5_c_re, s5_c_im,
                          s5_d, s5_glu_w, s5_glu_b, need_ctx_out)
    ret_c, ret_l = retention_mixer(q_c, k_c, v_c, g_c, q_l, k_l, v_l, g_l, ret_decay, ret_gn_w, need_ctx_out)
    bn, seq_len, _ = h_l.shape
    pool_l = pool_mixer(p_l.reshape(bn, rows, GRID_W, POOL_WIDTH), pool_w, pool_scale).reshape(bn, seq_len, POOL_WIDTH)
    dt = h_l.dtype
    y_l = jnp.concatenate([s5_l.astype(dt), ret_l.astype(dt), pool_l.astype(dt)], axis=-1) @ w_out
    if need_ctx_out:
        pool_c = pool_mixer(p_c, pool_w, pool_scale)
        y_c = jnp.concatenate([s5_c.astype(dt), ret_c.astype(dt), pool_c.astype(dt)], axis=-1) @ w_out
    else:
        y_c = None
    return y_c, y_l


def moe_ffn(h, router_w, router_bias, w1, w3, w2):
    n_tok, d = h.shape
    probs = jax.nn.softmax(h.astype(F32) @ router_w.astype(F32), axis=-1)
    sel = probs + router_bias.astype(F32)
    grp_score = lax.top_k(sel.reshape(n_tok, N_EXPERT_GROUPS, EXPERTS_PER_GROUP), TOP_K)[0].sum(-1)
    best = jnp.argmax(grp_score, axis=-1)
    in_group = (jnp.arange(N_EXPERTS) // EXPERTS_PER_GROUP)[None, :] == best[:, None]
    _, top_idx = lax.top_k(jnp.where(in_group, sel, -jnp.inf), TOP_K)
    top_p = jnp.take_along_axis(probs, top_idx, axis=-1)
    gates = top_p / jnp.sum(top_p, axis=-1, keepdims=True)
    n_assign = n_tok * TOP_K
    flat_e = top_idx.reshape(-1)
    flat_tok = jnp.repeat(jnp.arange(n_tok, dtype=jnp.int32), TOP_K)
    flat_gate = gates.reshape(-1)
    order = jnp.argsort(flat_e)
    e_sorted = flat_e[order]
    counts = jnp.bincount(flat_e, length=N_EXPERTS)
    padded = (counts + MOE_BLOCK - 1) // MOE_BLOCK * MOE_BLOCK
    start = jnp.cumsum(counts) - counts
    ends_p = jnp.cumsum(padded)
    start_p = ends_p - padded
    slot = start_p[e_sorted] + (jnp.arange(n_assign) - start[e_sorted])
    n_blocks = -(-n_assign // MOE_BLOCK) + N_EXPERTS
    n_slots = n_blocks * MOE_BLOCK
    slot_tok = jnp.full((n_slots,), n_tok, jnp.int32).at[slot].set(flat_tok[order])
    slot_gate = jnp.zeros((n_slots,), F32).at[slot].set(flat_gate[order])
    block_expert = jnp.minimum(jnp.searchsorted(ends_p, jnp.arange(n_blocks) * MOE_BLOCK, side="right"), N_EXPERTS - 1)
    h_pad = jnp.concatenate([h, jnp.zeros((1, d), h.dtype)], axis=0)
    xb = h_pad[slot_tok].reshape(n_blocks, MOE_BLOCK, d)

    def expert_block(args):
        xe, e = args
        return (jax.nn.silu(xe @ w1[e]) * (xe @ w3[e])) @ w2[e]

    yb = lax.map(expert_block, (xb, block_expert)).reshape(n_slots, d)
    out = jnp.zeros((n_tok + 1, d), F32).at[slot_tok].add(yb.astype(F32) * slot_gate[:, None])
    return out[:n_tok].astype(h.dtype)


def setup_inputs(seed: int = 0) -> dict:
    key = jax.random.key(seed)
    k = jax.random.split(key, 30)

    def nrm(i, shape, scale):
        return scale * jax.random.normal(k[i], shape, jnp.float32)

    n_idx = np.arange(S5_STATE, dtype=np.float32)
    gamma = 1.0 - np.power(np.float32(2.0), -5.0 - np.arange(RET_HEADS, dtype=np.float32))
    decay_logit = np.log(gamma / (1.0 - gamma)).astype(np.float32)
    return {
        "x": nrm(0, (BATCH, SEQ, D_MODEL), 1.0),
        "c": nrm(1, (BATCH, D_MODEL), 1.0),
        "ctx": nrm(2, (BATCH, CTX_LEN, D_MODEL), 1.0),
        "c_ctx": nrm(3, (D_MODEL,), 1.0),
        "ada_w": nrm(4, (DEPTH, D_MODEL, 6 * D_MODEL), 0.5 * D_MODEL ** -0.5),
        "ada_b": nrm(5, (DEPTH, 6 * D_MODEL), 0.02),
        "norm_mix_w": 1.0 + nrm(6, (DEPTH, D_MODEL), 0.02),
        "norm_ffn_w": 1.0 + nrm(7, (DEPTH, D_MODEL), 0.02),
        "w_in": nrm(8, (DEPTH, D_MODEL, IN_WIDTH), D_MODEL ** -0.5),
        "w_out": nrm(9, (DEPTH, D_MIX, D_MODEL), D_MIX ** -0.5),
        "s5_a_re": -0.5 + nrm(10, (DEPTH, 2, S5_GROUPS, S5_STATE), 0.01),
        "s5_a_im": jnp.asarray(np.pi * n_idx) + nrm(11, (DEPTH, 2, S5_GROUPS, S5_STATE), 0.01),
        "s5_log_dt": jax.random.uniform(k[12], (DEPTH, 2, S5_GROUPS), jnp.float32, math.log(1e-3), math.log(1e-1)),
        "s5_b_re": nrm(13, (DEPTH, 2, S5_GROUPS, S5_STATE, S5_IN), (0.5 / S5_IN) ** 0.5),
        "s5_b_im": nrm(14, (DEPTH, 2, S5_GROUPS, S5_STATE, S5_IN), (0.5 / S5_IN) ** 0.5),
        "s5_c_re": nrm(15, (DEPTH, 2, S5_GROUPS, S5_IN, S5_STATE), 0.5 ** 0.5),
        "s5_c_im": nrm(16, (DEPTH, 2, S5_GROUPS, S5_IN, S5_STATE), 0.5 ** 0.5),
        "s5_d": nrm(17, (DEPTH, S5_WIDTH), 1.0),
        "s5_glu_w": nrm(18, (DEPTH, S5_WIDTH, S5_WIDTH), S5_WIDTH ** -0.5),
        "s5_glu_b": nrm(19, (DEPTH, S5_WIDTH), 0.02),
        "ret_decay": jnp.asarray(decay_logit) + nrm(20, (DEPTH, 2, RET_HEADS), 0.01),
        "ret_gn_w": 1.0 + nrm(21, (DEPTH, RET_WIDTH), 0.02),
        "pool_w": nrm(22, (DEPTH, len(POOL_WINDOWS), POOL_GROUP, POOL_GROUP), POOL_GROUP ** -0.5),
        "pool_scale": 1.0 + nrm(23, (DEPTH, POOL_WIDTH), 0.02),
        "router_w": nrm(24, (D_MODEL, N_EXPERTS), D_MODEL ** -0.5),
        "router_bias": nrm(25, (N_EXPERTS,), 0.01),
        "moe_w1": nrm(26, (DEPTH, N_EXPERTS, D_MODEL, D_FF_EXPERT), D_MODEL ** -0.5),
        "moe_w3": nrm(27, (DEPTH, N_EXPERTS, D_MODEL, D_FF_EXPERT), D_MODEL ** -0.5),
        "moe_w2": nrm(28, (DEPTH, N_EXPERTS, D_FF_EXPERT, D_MODEL), D_FF_EXPERT ** -0.5),
        "final_norm_w": 1.0 + nrm(29, (D_MODEL,), 0.02),
    }


def reference(x, c, ctx, c_ctx, ada_w, ada_b, norm_mix_w, norm_ffn_w, w_in, w_out, s5_a_re, s5_a_im,
              s5_log_dt, s5_b_re, s5_b_im, s5_c_re, s5_c_im, s5_d, s5_glu_w, s5_glu_b, ret_decay, ret_gn_w,
              pool_w, pool_scale, router_w, router_bias, moe_w1, moe_w3, moe_w2, final_norm_w):
    rows = x.shape[1] // GRID_W
    d = x.shape[-1]
    ctx_s = ctx
    for l in range(DEPTH):
        last = l == DEPTH - 1
        mod_l = (jax.nn.silu(c) @ ada_w[l] + ada_b[l])[:, None, :]
        mod_c = jax.nn.silu(c_ctx) @ ada_w[l] + ada_b[l]
        sh_a, sc_a, gt_a, sh_f, sc_f, gt_f = jnp.split(mod_l, 6, axis=-1)
        csh_a, csc_a, cgt_a, csh_f, csc_f, cgt_f = jnp.split(mod_c, 6, axis=-1)

        h_l = rmsnorm(x, norm_mix_w[l]) * (1.0 + sc_a) + sh_a
        h_c = rmsnorm(ctx_s, norm_mix_w[l]) * (1.0 + csc_a) + csh_a
        y_c, y_l = token_mixer(h_c, h_l, rows, w_in[l], w_out[l], s5_a_re[l], s5_a_im[l], s5_log_dt[l],
                               s5_b_re[l], s5_b_im[l], s5_c_re[l], s5_c_im[l], s5_d[l], s5_glu_w[l],
                               s5_glu_b[l], ret_decay[l], ret_gn_w[l], pool_w[l], pool_scale[l],
                               not last)
        x = x + gt_a * y_l
        f_l = rmsnorm(x, norm_ffn_w[l]) * (1.0 + sc_f) + sh_f
        if not last:
            ctx_s = ctx_s + cgt_a * y_c
            f_c = rmsnorm(ctx_s, norm_ffn_w[l]) * (1.0 + csc_f) + csh_f
            n_c = f_c.shape[0] * f_c.shape[1]
            tokens = jnp.concatenate([f_c.reshape(-1, d), f_l.reshape(-1, d)], axis=0)
            out = moe_ffn(tokens, router_w, router_bias, moe_w1[l], moe_w3[l], moe_w2[l])
            ctx_s = ctx_s + cgt_f * out[:n_c].reshape(ctx_s.shape)
            x = x + gt_f * out[n_c:].reshape(x.shape)
        else:
            out = moe_ffn(f_l.reshape(-1, d), router_w, router_bias, moe_w1[l], moe_w3[l], moe_w2[l])
            x = x + gt_f * out.reshape(x.shape)
    return rmsnorm(x, final_norm_w)
```

```cpp
#include <hip/hip_runtime.h>
#include <cstdio>
#include <cstdint>

#define LAS __attribute__((address_space(3)))
typedef unsigned short bf16_t;
typedef short bf16x8 __attribute__((ext_vector_type(8)));
typedef float f32x4 __attribute__((ext_vector_type(4)));
typedef float f32x2 __attribute__((ext_vector_type(2)));
typedef unsigned u32x4 __attribute__((ext_vector_type(4)));
typedef unsigned u32x2 __attribute__((ext_vector_type(2)));

constexpr int D = 1024, NB = 8, SEQ = 4096, CTXL = 256, DEPTH = 2, INW = 2560;
constexpr int RC = NB * CTXL, RL = NB * SEQ, RT = RC + RL;
constexpr int NE = 16;
constexpr int OFF_U = 0, OFF_Q = 256, OFF_K = 768, OFF_V = 1280, OFF_G = 1792, OFF_P = 2304;
constexpr int MAXTILES = 288, NPOS = CTXL + SEQ;
constexpr int NWAVES = 8, NTHR = 512;

constexpr size_t MiB = 1u << 20;
constexpr size_t WS_CTL = 0, CTL_BYTES = 1 * MiB;
constexpr size_t WS_MOD = 1 * MiB;
constexpr size_t WS_ROT = 2 * MiB;
constexpr size_t WS_TOKE = 4 * MiB;
constexpr size_t WS_TOKP = 4 * MiB + 512 * 1024;
constexpr size_t WS_TOKG = 5 * MiB;
constexpr size_t WS_LIST = 5 * MiB + 512 * 1024;
constexpr size_t WS_GLUT = 7 * MiB + 768 * 1024;
constexpr size_t WS_POOLT = 7 * MiB + 896 * 1024;
constexpr size_t WS_S5M = 8 * MiB;
constexpr size_t WS_WIN = 16 * MiB;
constexpr size_t WS_WOUT = 21 * MiB;
constexpr size_t WS_W13 = 24 * MiB;
constexpr size_t WS_W2 = 88 * MiB;
constexpr size_t WS_XN = 120 * MiB;
constexpr size_t WS_Z = 188 * MiB;
constexpr size_t WS_Y = 358 * MiB;
constexpr size_t WS_XRC = 502 * MiB;
constexpr size_t WS_END = 510 * MiB;
constexpr size_t WS_S5Y = WS_Y;
constexpr size_t WS_RO = WS_Y + 34 * MiB;
constexpr size_t WS_POOLED = WS_Y + 102 * MiB;
constexpr int CW_BAR = 4096, CW_GCNT = 8192;

__device__ __forceinline__ float wave_sum(float v) {
#pragma unroll
    for (int o = 1; o < 64; o <<= 1) v += __shfl_xor(v, o);
    return v;
}
__device__ __forceinline__ unsigned f2bf(float f) { unsigned u = __builtin_bit_cast(unsigned, f); return (u + 0x7fffu + ((u >> 16) & 1u)) >> 16; }
__device__ __forceinline__ unsigned pk2(float lo, float hi) { return f2bf(lo) | (f2bf(hi) << 16); }
__device__ __forceinline__ float bf2f(unsigned h) { return __builtin_bit_cast(float, h << 16); }
__device__ __forceinline__ float bflo(unsigned w) { return __builtin_bit_cast(float, w << 16); }
__device__ __forceinline__ float bfhi(unsigned w) { return __builtin_bit_cast(float, w & 0xffff0000u); }
__device__ __forceinline__ float sigmoidf_(float x) { return 1.0f / (1.0f + __expf(-x)); }
__device__ __forceinline__ float siluf_(float x) { return x / (1.0f + __expf(-x)); }
__device__ __forceinline__ float gelu_tanh(float x) { const float u = 0.7978845608028654f * (x + 0.044715f * x * x * x); return 0.5f * x * (1.0f + tanhf(u)); }
#define LDS_WAIT() asm volatile("s_waitcnt lgkmcnt(0)" ::: "memory")
#define VM_WAIT() asm volatile("s_waitcnt vmcnt(0)" ::: "memory")

namespace pg8 {
constexpr int BM = 256, BK = 64, HALF = 128, HTB = HALF * BK * 2, STAGE_BYTES = 8 * HTB, NXCD = 8, WGM = 8;
__host__ __device__ __forceinline__ int lds_byte(int r, int c) { const int st = (r >> 4) * 2 + (c >> 5), rr = r & 15, cc = c & 31, ob = rr * 64 + cc * 2; return st * 1024 + (ob ^ (((ob >> 9) & 1) << 5)); }
__host__ __device__ __forceinline__ void stage_rc(int b, int& R, int& C) { const int st = b / 1024, sb = b % 1024, swz = sb ^ (((sb >> 9) & 1) << 5); R = (st >> 1) * 16 + swz / 64; C = (st & 1) * 32 + (swz % 64) / 2; }
__host__ __device__ __forceinline__ int perm32(int rho) { const int n = rho >> 4, i = rho & 15; return 8 * (i >> 2) + 4 * n + (i & 3); }

struct Unit { int pm, pn, e, ui; };

__device__ __forceinline__ unsigned cvt_pk_bf16(float lo, float hi) { unsigned r; asm volatile("v_cvt_pk_bf16_f32 %0, %1, %2" : "=v"(r) : "v"(lo), "v"(hi)); return r; }

struct DenseOrder {
    int nM, nN, nwg, G, c, pm0, K; const char* Bt;
    __device__ void init(int nM_, int nN_, int G_, int c_, int pm0_, int K_, const void* Bt_) { nM = nM_; nN = nN_; nwg = nM * nN; G = G_; c = c_; pm0 = pm0_; K = K_; Bt = (const char*)Bt_; }
    __device__ bool next(int i, Unit& u) const {
        const long L = (long)i * G + c; if (L >= nwg) return false;
        int wgid = (int)L; { const int q = nwg / NXCD, r = nwg % NXCD, xcd = wgid % NXCD, off = wgid / NXCD; wgid = (xcd < r ? xcd * (q + 1) : r * (q + 1) + (xcd - r) * q) + off; }
        const int nig = WGM * nN, gid = wgid / nig, fm = gid * WGM, gsz = (nM - fm) < WGM ? (nM - fm) : WGM;
        u.pm = pm0 + fm + ((wgid % nig) % gsz); u.pn = (wgid % nig) / gsz; u.e = 0; u.ui = i; return true;
    }
    __device__ __forceinline__ void a_offs(const Unit& u, const int (&R)[2], const int (&C)[2], unsigned (&off)[2][2]) const {
#pragma unroll
        for (int h = 0; h < 2; ++h)
#pragma unroll
            for (int i = 0; i < 2; ++i) off[h][i] = (unsigned)((u.pm * BM + h * HALF + R[i]) * K + C[i]) * 2u;
    }
    __device__ __forceinline__ const char* b_ptr(const Unit& u) const { return Bt + (size_t)u.pn * BM * K * 2; }
};
struct MoeOrder {
    int ntiles, nN, G, c, K; const char* Bt; size_t bstride; const LAS int* tile_e; const LAS unsigned* rowoff;
    __device__ bool next(int i, Unit& u) const {
        const long L = (long)i * G + c; if (L >= (long)ntiles * nN) return false;
        u.pn = (int)(L % nN); u.pm = (int)(L / nN); u.e = tile_e[u.pm]; u.ui = i; return true;
    }
    __device__ __forceinline__ void a_offs(const Unit& u, const int (&R)[2], const int (&C)[2], unsigned (&off)[2][2]) const {
#pragma unroll
        for (int h = 0; h < 2; ++h)
#pragma unroll
            for (int i = 0; i < 2; ++i) off[h][i] = rowoff ? rowoff[u.ui * 256 + h * HALF + R[i]] + (unsigned)C[i] * 2u : (unsigned)((u.pm * BM + h * HALF + R[i]) * K + C[i]) * 2u;
    }
    __device__ __forceinline__ const char* b_ptr(const Unit& u) const { return Bt + (size_t)u.e * bstride + (size_t)u.pn * BM * K * 2; }
};

struct EpiBf16 {
    static constexpr bool PERM = true;
    bf16_t* O; int ldc;
    __device__ __forceinline__ void operator()(const f32x4 (&acc)[2][2][4][2], const Unit& u, int wr, int wc, int fr, int fq) const {
        const int row0 = u.pm * BM + wr * 64 + fr, col0 = u.pn * BM + wc * 32 + 8 * fq;
#pragma unroll
        for (int ai = 0; ai < 2; ++ai)
#pragma unroll
            for (int m = 0; m < 4; ++m) { bf16_t* rowp = O + (size_t)(row0 + ai * HALF + m * 16) * ldc + col0;
#pragma unroll
                for (int bj = 0; bj < 2; ++bj) { const f32x4 v0 = acc[ai][bj][m][0], v1 = acc[ai][bj][m][1];
                    u32x4 w; w.x = cvt_pk_bf16(v0[0], v0[1]); w.y = cvt_pk_bf16(v0[2], v0[3]); w.z = cvt_pk_bf16(v1[0], v1[1]); w.w = cvt_pk_bf16(v1[2], v1[3]);
                    *(u32x4*)(rowp + bj * HALF) = w; } }
    }
};
struct EpiSwiGLU {
    static constexpr bool PERM = true;
    bf16_t* O;
    __device__ __forceinline__ void operator()(const f32x4 (&acc)[2][2][4][2], const Unit& u, int wr, int wc, int fr, int fq) const {
        const int row0 = u.pm * BM + wr * 64 + fr, col0 = u.pn * HALF + wc * 32 + 8 * fq;
#pragma unroll
        for (int ai = 0; ai < 2; ++ai)
#pragma unroll
            for (int m = 0; m < 4; ++m) { bf16_t* rowp = O + (size_t)(row0 + ai * HALF + m * 16) * 1024 + col0;
                float h[8];
#pragma unroll
                for (int n = 0; n < 2; ++n)
#pragma unroll
                    for (int j = 0; j < 4; ++j) { const float a = acc[ai][0][m][n][j], b = acc[ai][1][m][n][j]; h[n * 4 + j] = a * __builtin_amdgcn_rcpf(1.0f + __builtin_amdgcn_exp2f(-1.4426950408889634f * a)) * b; }
                u32x4 w; w.x = cvt_pk_bf16(h[0], h[1]); w.y = cvt_pk_bf16(h[2], h[3]); w.z = cvt_pk_bf16(h[4], h[5]); w.w = cvt_pk_bf16(h[6], h[7]);
                *(u32x4*)rowp = w; }
    }
};
struct EpiRes {
    static constexpr bool PERM = false;
    const float* src_c; const float* src_l; float* dst_c; float* dst_l; const float* modl;
    __device__ __forceinline__ void operator()(const f32x4 (&acc)[2][2][4][2], const Unit& u, int wr, int wc, int fr, int fq) const {
        const bool isc = u.pm < 8; const int bidx = isc ? 8 : ((u.pm - 8) >> 4);
        const float* src = isc ? src_c : src_l; float* dst = isc ? dst_c : dst_l;
        const int rl0 = (isc ? u.pm * BM : (u.pm - 8) * BM) + wr * 64 + fr, col0 = u.pn * BM + wc * 32 + 4 * fq;
        const float* gate = modl + bidx * 6144 + 2048;
        f32x4 gv[2][2];
#pragma unroll
        for (int bj = 0; bj < 2; ++bj)
#pragma unroll
            for (int n = 0; n < 2; ++n) gv[bj][n] = *(const f32x4*)(gate + col0 + bj * HALF + n * 16);
#pragma unroll
        for (int ai = 0; ai < 2; ++ai)
#pragma unroll
            for (int m = 0; m < 4; ++m) { const size_t off = (size_t)(rl0 + ai * HALF + m * 16) * 1024 + col0;
#pragma unroll
                for (int bj = 0; bj < 2; ++bj)
#pragma unroll
                    for (int n = 0; n < 2; ++n) { const f32x4 s = *(const f32x4*)(src + off + bj * HALF + n * 16); *(f32x4*)(dst + off + bj * HALF + n * 16) = s + gv[bj][n] * acc[ai][bj][m][n]; } }
    }
};

template <class Epi, class Sched, bool ALIGN_EPI>
__device__ __forceinline__ void gemm_phase(LAS unsigned char* lds, const char* Abase, const int K, const Sched& S, const Epi& E) {
    const int tid = threadIdx.x, wid = __builtin_amdgcn_readfirstlane(tid >> 6), lane = tid & 63, wr = wid >> 2, wc = wid & 3, fr = lane & 15, fq = lane >> 4;
    const int nt = K / BK;
    int Rr[2], Cc[2]; unsigned voffB[2];
#pragma unroll
    for (int i = 0; i < 2; ++i) { int R, C; stage_rc(tid * 16 + i * 8192, R, C); Rr[i] = R; Cc[i] = C; const int Rb = Epi::PERM ? ((R & ~31) + perm32(R & 31)) : R; voffB[i] = (unsigned)(Rb * K + C) * 2u; }
    const size_t kstep = (size_t)(BK * 2);
    const size_t hstepB = (size_t)HALF * K * 2;
    const unsigned ldsw = (unsigned)wid * 1024u;
    const int aoff = lds_byte(wr * 64 + fr, fq * 8), boff = lds_byte(wc * 32 + fr, fq * 8);
#define PG8_SA(b, h) (((b) * 2 + (h)) * HTB)
#define PG8_SB(b, h) ((4 + (b) * 2 + (h)) * HTB)
#define PG8_STAGE_B(bufoff, gbase) do { _Pragma("unroll") for (int _i = 0; _i < 2; ++_i) \
        __builtin_amdgcn_global_load_lds((const unsigned*)((const char*)(gbase) + voffB[_i]), (LAS unsigned*)(lds + (bufoff) + ldsw + _i * 8192), 16, 0, 0); } while (0)
#define PG8_STAGE_A(bufoff, offs, kb) do { _Pragma("unroll") for (int _i = 0; _i < 2; ++_i) \
        __builtin_amdgcn_global_load_lds((const unsigned*)(Abase + (kb) + (offs)[_i]), (LAS unsigned*)(lds + (bufoff) + ldsw + _i * 8192), 16, 0, 0); } while (0)
#define PG8_LDA(dst, b, h) do { _Pragma("unroll") for (int m = 0; m < 4; ++m) _Pragma("unroll") for (int k = 0; k < 2; ++k) dst[m][k] = *(const LAS bf16x8*)(lds + PG8_SA(b, h) + aoff + m * 2048 + k * 1024); } while (0)
#define PG8_LDB(dst, b, h) do { _Pragma("unroll") for (int n = 0; n < 2; ++n) _Pragma("unroll") for (int k = 0; k < 2; ++k) dst[n][k] = *(const LAS bf16x8*)(lds + PG8_SB(b, h) + boff + n * 2048 + k * 1024); } while (0)
#define PG8_MMA(ai, bj, At, Bt) do { __builtin_amdgcn_s_setprio(1); _Pragma("unroll") for (int m = 0; m < 4; ++m) _Pragma("unroll") for (int n = 0; n < 2; ++n) _Pragma("unroll") for (int k = 0; k < 2; ++k) \
        acc[ai][bj][m][n] = __builtin_amdgcn_mfma_f32_16x16x32_bf16(Bt[n][k], At[m][k], acc[ai][bj][m][n], 0, 0, 0); __builtin_amdgcn_s_setprio(0); } while (0)
#define PG8_WAIT_V(n) asm volatile("s_waitcnt vmcnt(" #n ")" ::: "memory")
#define PG8_WAIT_L(n) asm volatile("s_waitcnt lgkmcnt(" #n ")" ::: "memory")
#define PG8_BAR __builtin_amdgcn_s_barrier()
#define PG8_SCHED __builtin_amdgcn_sched_barrier(0)
    Unit cur, nxt; int ui = 0;
    if (!S.next(0, cur)) return;
    f32x4 acc[2][2][4][2];
#pragma unroll
    for (int a = 0; a < 2; ++a)
#pragma unroll
        for (int b = 0; b < 2; ++b)
#pragma unroll
            for (int m = 0; m < 4; ++m)
#pragma unroll
                for (int n = 0; n < 2; ++n) acc[a][b][m][n] = (f32x4){0.f, 0.f, 0.f, 0.f};
    bf16x8 At[4][2], B0[2][2], B1[2][2];
    unsigned cO[2][2], nO[2][2];
    S.a_offs(cur, Rr, Cc, cO);
    const char* cB = S.b_ptr(cur); const char* nB = cB;
    PG8_STAGE_B(PG8_SB(0, 0), cB); PG8_STAGE_B(PG8_SB(0, 1), cB + hstepB); PG8_STAGE_A(PG8_SA(0, 0), cO[0], 0); PG8_STAGE_A(PG8_SA(0, 1), cO[1], 0);
    if (wr == 1) PG8_BAR;
    PG8_WAIT_V(2); PG8_BAR;
    PG8_STAGE_B(PG8_SB(1, 0), cB + kstep); PG8_STAGE_A(PG8_SA(1, 0), cO[0], kstep); PG8_STAGE_B(PG8_SB(1, 1), cB + hstepB + kstep);
    PG8_WAIT_V(6); PG8_BAR;
    for (;;) {
        const bool has_next = S.next(ui + 1, nxt);
        if (has_next) { S.a_offs(nxt, Rr, Cc, nO); nB = S.b_ptr(nxt); }
        else { nO[0][0] = cO[0][0]; nO[0][1] = cO[0][1]; nO[1][0] = cO[1][0]; nO[1][1] = cO[1][1]; nB = cB; }
        for (int t = 0; t < nt; t += 2) {
            const bool last = (t == nt - 2);
            const size_t k1 = (size_t)(t + 1) * kstep;
            const size_t k2 = last ? (size_t)0 : (size_t)(t + 2) * kstep, k3 = k2 + kstep;
            unsigned o2[2][2];
            o2[0][0] = last ? nO[0][0] : cO[0][0]; o2[0][1] = last ? nO[0][1] : cO[0][1]; o2[1][0] = last ? nO[1][0] : cO[1][0]; o2[1][1] = last ? nO[1][1] : cO[1][1];
            const char* b2 = (last ? nB : cB) + k2; const char* b3 = b2 + kstep;
            PG8_LDB(B0, 0, 0); PG8_LDB(B1, 0, 1); PG8_SCHED; PG8_LDA(At, 0, 0); PG8_STAGE_A(PG8_SA(1, 1), cO[1], k1);
            PG8_WAIT_V(8); PG8_WAIT_L(0); PG8_BAR; PG8_MMA(0, 0, At, B0); PG8_MMA(0, 1, At, B1); PG8_BAR; PG8_SCHED;
            PG8_LDA(At, 0, 1); PG8_STAGE_B(PG8_SB(0, 0), b2); PG8_STAGE_B(PG8_SB(0, 1), b2 + hstepB); PG8_STAGE_A(PG8_SA(0, 0), o2[0], k2);
            PG8_WAIT_V(8); PG8_WAIT_L(0); PG8_BAR; PG8_MMA(1, 0, At, B0); PG8_MMA(1, 1, At, B1); PG8_BAR; PG8_SCHED;
            PG8_LDB(B0, 1, 0); PG8_LDB(B1, 1, 1); PG8_SCHED; PG8_LDA(At, 1, 0); PG8_STAGE_A(PG8_SA(0, 1), o2[1], k2);
            PG8_WAIT_V(8); PG8_WAIT_L(0); PG8_BAR; PG8_MMA(0, 0, At, B0); PG8_MMA(0, 1, At, B1); PG8_BAR; PG8_SCHED;
            PG8_LDA(At, 1, 1); PG8_STAGE_B(PG8_SB(1, 0), b3); PG8_STAGE_B(PG8_SB(1, 1), b3 + hstepB); PG8_STAGE_A(PG8_SA(1, 0), o2[0], k3);
            PG8_WAIT_V(8); PG8_WAIT_L(0); PG8_BAR; PG8_MMA(1, 0, At, B0); PG8_MMA(1, 1, At, B1); PG8_BAR; PG8_SCHED;
        }
        if constexpr (ALIGN_EPI) { if (wr == 0) PG8_BAR; }
        E(acc, cur, wr, wc, fr, fq);
        if (!has_next) break;
#pragma unroll
        for (int a = 0; a < 2; ++a)
#pragma unroll
            for (int b = 0; b < 2; ++b)
#pragma unroll
                for (int m = 0; m < 4; ++m)
#pragma unroll
                    for (int n = 0; n < 2; ++n) acc[a][b][m][n] = (f32x4){0.f, 0.f, 0.f, 0.f};
        cur = nxt; cB = nB; cO[0][0] = nO[0][0]; cO[0][1] = nO[0][1]; cO[1][0] = nO[1][0]; cO[1][1] = nO[1][1]; ++ui;
        if constexpr (ALIGN_EPI) { if (wr == 1) PG8_BAR; }
    }
    PG8_WAIT_V(0);
    if constexpr (!ALIGN_EPI) { if (wr == 0) PG8_BAR; }
    PG8_BAR;
#undef PG8_SA
#undef PG8_SB
#undef PG8_STAGE_A
#undef PG8_STAGE_B
#undef PG8_LDA
#undef PG8_LDB
#undef PG8_MMA
#undef PG8_WAIT_V
#undef PG8_WAIT_L
#undef PG8_BAR
#undef PG8_SCHED
}
}

constexpr int RING_BYTES = 131072;
constexpr int LC_TILE_E = RING_BYTES;
constexpr int LC_TSTART = LC_TILE_E + 1280;
constexpr int LC_CNT = LC_TSTART + 128;
constexpr int LC_MISC = LC_CNT + 64;
constexpr int LC_ROWOFF = LC_MISC + 128;
constexpr int LDS_BYTES = 147456;
static_assert(LC_ROWOFF + 10 * 256 * 4 <= LDS_BYTES, "LDS map");

struct Args { const float* in[30]; float* out; unsigned char* ws; int ph, l; };

struct Frame {
    LAS unsigned char* lds; int tid, lane, wave, G, gw, NGW;
    const Args* a;
};

__device__ __forceinline__ float* xres_row(const Args& A, int row) { return row < RC ? (float*)(A.ws + WS_XRC) + (size_t)row * D : A.out + (size_t)(row - RC) * D; }
__device__ __forceinline__ const float* xin_row(const Args& A, int row) { return row < RC ? A.in[2] + (size_t)row * D : A.in[0] + (size_t)(row - RC) * D; }
__device__ __forceinline__ int row_bidx(int row) { return row < RC ? 8 : ((row - RC) >> 12); }

__device__ __forceinline__ void sincos_d(float ang, float& s, float& c) { const double a = (double)ang; s = (float)sin(a); c = (float)cos(a); }

__device__ __forceinline__ void transpose_item(const float* W, int N, int Kdst, bf16_t* WT, int k0, int n0, int drow0, LAS float* scr, int lane) {
#pragma unroll 8
    for (int i = 0; i < 32; ++i) { const int kk = 2 * i + (lane >> 5); scr[kk * 33 + (lane & 31)] = W[(size_t)(k0 + kk) * N + n0 + (lane & 31)]; }
    LDS_WAIT(); asm volatile("" ::: "memory");
    const int c = lane & 7;
#pragma unroll
    for (int j = 0; j < 4; ++j) { const int n = (lane >> 3) + 8 * j; const LAS float* s = scr + (8 * c) * 33 + n;
        u32x4 o; o.x = pk2(s[0 * 33], s[1 * 33]); o.y = pk2(s[2 * 33], s[3 * 33]); o.z = pk2(s[4 * 33], s[5 * 33]); o.w = pk2(s[6 * 33], s[7 * 33]);
        *(u32x4*)(WT + (size_t)(drow0 + n) * Kdst + k0 + 8 * c) = o; }
    LDS_WAIT(); asm volatile("" ::: "memory");
}
__device__ __forceinline__ void phase_weights(Frame& F, int l) {
    const Args& A = *F.a;
    LAS float* scr = (LAS float*)(F.lds + F.wave * 16384);
    unsigned char* ws = A.ws;
    constexpr int I_IN = 16 * 80, I_OUT = 16 * 32, I_E = 16 * 32, I_GLU = 4 * 8, I_POOL = 8;
    constexpr int NITEMS = I_IN + I_OUT + NE * 3 * I_E + I_GLU + I_POOL;
    for (int it = F.gw; it < NITEMS; it += F.NGW) {
        int r = it;
        if (r < I_IN) { const int kb = r / 80, nb = r % 80; transpose_item(A.in[8] + (size_t)l * D * INW, INW, D, (bf16_t*)(ws + WS_WIN), 64 * kb, 32 * nb, 32 * nb, scr, F.lane); continue; } r -= I_IN;
        if (r < I_OUT) { const int kb = r / 32, nb = r % 32; transpose_item(A.in[9] + (size_t)l * D * D, D, D, (bf16_t*)(ws + WS_WOUT), 64 * kb, 32 * nb, 32 * nb, scr, F.lane); continue; } r -= I_OUT;
        if (r < NE * 3 * I_E) { const int e = r / (3 * I_E), q = (r % (3 * I_E)) / I_E, s = r % I_E, kb = s / 32, nb = s % 32, n0 = 32 * nb;
            const size_t wo = ((size_t)l * NE + e) * D * D;
            if (q == 0) transpose_item(A.in[26] + wo, D, D, (bf16_t*)(ws + WS_W13) + (size_t)e * 2048 * D, 64 * kb, n0, 256 * (n0 >> 7) + (n0 & 127), scr, F.lane);
            else if (q == 1) transpose_item(A.in[27] + wo, D, D, (bf16_t*)(ws + WS_W13) + (size_t)e * 2048 * D, 64 * kb, n0, 256 * (n0 >> 7) + 128 + (n0 & 127), scr, F.lane);
            else transpose_item(A.in[28] + wo, D, D, (bf16_t*)(ws + WS_W2) + (size_t)e * D * D, 64 * kb, n0, n0, scr, F.lane);
            continue; } r -= NE * 3 * I_E;
        if (r < I_GLU) { const int kb = r / 8, nb = r % 8; transpose_item(A.in[18] + (size_t)l * 256 * 256, 256, 256, (bf16_t*)(ws + WS_GLUT), 64 * kb, 32 * nb, 32 * nb, scr, F.lane); continue; } r -= I_GLU;
        { const int g = r / 2, nb = r % 2; transpose_item(A.in[22] + ((size_t)l * 4 + g) * 64 * 64, 64, 64, (bf16_t*)(ws + WS_POOLT) + g * 64 * 64, 0, 32 * nb, 32 * nb, scr, F.lane); }
    }
}
__device__ __forceinline__ void phase_tables(Frame& F) {
    const Args& A = *F.a;
    __syncthreads();
    LAS float* sc = (LAS float*)F.lds;
    LAS float* part = (LAS float*)(F.lds + 40960);
    float* MOD = (float*)(A.ws + WS_MOD);
    if ((int)blockIdx.x < 192) {
        for (int i = F.tid; i < 9 * 1024; i += NTHR) { const int r = i >> 10, k = i & 1023; const float v = r < 8 ? A.in[1][r * 1024 + k] : A.in[3][k]; sc[i] = siluf_(v); }
        __syncthreads();
        for (int it = blockIdx.x; it < 192; it += F.G) {
            const int l = it / 96, cg = it % 96, col = F.tid & 63, ks = F.tid >> 6;
            const float* W = A.in[4] + (size_t)l * D * 6144 + cg * 64 + col;
            float acc[9];
#pragma unroll
            for (int r = 0; r < 9; ++r) acc[r] = 0.f;
            for (int kk = 0; kk < 128; ++kk) { const int k = ks * 128 + kk; const float w = W[(size_t)k * 6144];
#pragma unroll
                for (int r = 0; r < 9; ++r) acc[r] += sc[r * 1024 + k] * w; }
#pragma unroll
            for (int r = 0; r < 9; ++r) part[(ks * 9 + r) * 64 + col] = acc[r];
            __syncthreads();
            for (int idx = F.tid; idx < 576; idx += NTHR) { const int r = idx >> 6, c = idx & 63; float s = A.in[5][l * 6144 + cg * 64 + c];
#pragma unroll
                for (int k8 = 0; k8 < 8; ++k8) s += part[(k8 * 9 + r) * 64 + c];
                MOD[(l * 9 + r) * 6144 + cg * 64 + c] = s; }
            __syncthreads();
        }
    }
    f32x2* ROT = (f32x2*)(A.ws + WS_ROT);
    for (int idx = blockIdx.x * NTHR + F.tid; idx < NPOS * 32; idx += F.G * NTHR) {
        const int pos = idx >> 5, i = idx & 31; const float inv = powf(10000.0f, -(float)i / 32.0f); const float ang = (float)pos * inv; float s, c; sincos_d(ang, s, c); ROT[idx] = (f32x2){c, s};
    }
    __syncthreads();
}

struct RowComb { float g1, g2; const bf16_t* y1; const bf16_t* y2; };
__device__ __forceinline__ void load_row(const float* p, int lane, f32x4 (&v)[4]) {
#pragma unroll
    for (int j = 0; j < 4; ++j) v[j] = ((const f32x4*)p)[lane + 64 * j];
}
__device__ __forceinline__ void store_row(float* p, int lane, const f32x4 (&v)[4]) {
#pragma unroll
    for (int j = 0; j < 4; ++j) ((f32x4*)p)[lane + 64 * j] = v[j];
}
__device__ __forceinline__ void moe_combine(const Args& A, int lp, int row, int lane, const LAS int* tstart, f32x4 (&v)[4]) {
    const int* TOKE = (const int*)(A.ws + WS_TOKE); const int* TOKP = (const int*)(A.ws + WS_TOKP); const float* TOKG = (const float*)(A.ws + WS_TOKG);
    const int e1 = TOKE[row * 2], e2 = TOKE[row * 2 + 1], p1 = TOKP[row * 2], p2 = TOKP[row * 2 + 1];
    const float g1 = TOKG[row * 2], g2 = TOKG[row * 2 + 1];
    const size_t s1 = (size_t)tstart[e1] * 256 + p1, s2 = (size_t)tstart[e2] * 256 + p2;
    const bf16_t* Y = (const bf16_t*)(A.ws + WS_Y);
    const float* gt = (const float*)(A.ws + WS_MOD) + (size_t)(lp * 9 + row_bidx(row)) * 6144 + 5 * 1024;
#pragma unroll
    for (int j = 0; j < 4; ++j) { const u32x2 a = ((const u32x2*)(Y + s1 * 1024))[lane + 64 * j], b = ((const u32x2*)(Y + s2 * 1024))[lane + 64 * j]; const f32x4 g = ((const f32x4*)gt)[lane + 64 * j];
        v[j].x += g.x * (g1 * bflo(a.x) + g2 * bflo(b.x)); v[j].y += g.y * (g1 * bfhi(a.x) + g2 * bfhi(b.x));
        v[j].z += g.z * (g1 * bflo(a.y) + g2 * bflo(b.y)); v[j].w += g.w * (g1 * bfhi(a.y) + g2 * bfhi(b.y)); }
}
__device__ __forceinline__ void build_tstart(Frame& F, int lp) {
    LAS int* tstart = (LAS int*)(F.lds + LC_TSTART); LAS int* cnt = (LAS int*)(F.lds + LC_CNT);
    const unsigned* gcnt = (const unsigned*)(F.a->ws + WS_CTL) + CW_GCNT + lp * 16;
    __syncthreads();
    if (F.tid == 0) { int s = 0; for (int e = 0; e < NE; ++e) { const int c = (int)__hip_atomic_load(gcnt + e, __ATOMIC_RELAXED, __HIP_MEMORY_SCOPE_AGENT); cnt[e] = c; tstart[e] = s; s += (c + 255) >> 8; } tstart[NE] = s; }
    __syncthreads();
}
__device__ __forceinline__ float row_rstd(const f32x4 (&v)[4]) {
    float ss = 0.f;
#pragma unroll
    for (int j = 0; j < 4; ++j) ss += (v[j].x * v[j].x + v[j].y * v[j].y) + (v[j].z * v[j].z + v[j].w * v[j].w);
    return 1.0f / sqrtf(wave_sum(ss) * (1.0f / D) + 1e-6f);
}
__device__ __forceinline__ void norm_mod_store(const f32x4 (&v)[4], float rstd, const float* nw, const float* sc, const float* sh, bf16_t* orow, int lane, f32x4 (*keep)[4]) {
#pragma unroll
    for (int j = 0; j < 4; ++j) { const f32x4 w = ((const f32x4*)nw)[lane + 64 * j], s = ((const f32x4*)sc)[lane + 64 * j], b = ((const f32x4*)sh)[lane + 64 * j];
        const f32x4 h = v[j] * rstd * w * (s + 1.0f) + b; if (keep) (*keep)[j] = h;
        u32x2 o; o.x = pk2(h.x, h.y); o.y = pk2(h.z, h.w); ((u32x2*)orow)[lane + 64 * j] = o; }
}
__device__ __forceinline__ void phase_prenorm(Frame& F, int l) {
    const Args& A = *F.a;
    if (l > 0) build_tstart(F, l - 1);
    const LAS int* tstart = (const LAS int*)(F.lds + LC_TSTART);
    const float* MOD = (const float*)(A.ws + WS_MOD);
    bf16_t* XN = (bf16_t*)(A.ws + WS_XN);
    for (int row = F.gw; row < RT; row += F.NGW) {
        f32x4 v[4];
        if (l == 0) load_row(xin_row(A, row), F.lane, v);
        else { float* xr = xres_row(A, row); load_row(xr, F.lane, v); moe_combine(A, l - 1, row, F.lane, tstart, v); store_row(xr, F.lane, v); }
        const float rstd = row_rstd(v);
        const float* m = MOD + (size_t)(l * 9 + row_bidx(row)) * 6144;
        norm_mod_store(v, rstd, A.in[6] + l * D, m + 1024, m, XN + (size_t)row * D, F.lane, nullptr);
    }
}
__device__ __forceinline__ void phase_final(Frame& F) {
    const Args& A = *F.a;
    build_tstart(F, DEPTH - 1);
    const LAS int* tstart = (const LAS int*)(F.lds + LC_TSTART);
    for (int row = RC + F.gw; row < RT; row += F.NGW) {
        f32x4 v[4]; float* xr = xres_row(A, row); load_row(xr, F.lane, v); moe_combine(A, DEPTH - 1, row, F.lane, tstart, v);
        const float rstd = row_rstd(v);
#pragma unroll
        for (int j = 0; j < 4; ++j) { const f32x4 w = ((const f32x4*)A.in[29])[F.lane + 64 * j]; v[j] = v[j] * rstd * w; }
        store_row(xr, F.lane, v);
    }
}
constexpr int RW_STRIDE = 20;
__device__ __forceinline__ void phase_router(Frame& F, int l) {
    const Args& A = *F.a;
    __syncthreads();
    LAS float* rw = (LAS float*)F.lds;
    LAS int* lcnt = (LAS int*)(F.lds + 1024 * RW_STRIDE * 4);
    LAS int* rec = lcnt + 32;
    for (int i = F.tid; i < 1024 * 16; i += NTHR) rw[(i >> 4) * RW_STRIDE + (i & 15)] = A.in[24][i];
    if (F.tid < 32) lcnt[F.tid] = 0;
    __syncthreads();
    const float* MOD = (const float*)(A.ws + WS_MOD);
    bf16_t* FB = (bf16_t*)(A.ws + WS_XN);
    int* TOKE = (int*)(A.ws + WS_TOKE); int* TOKP = (int*)(A.ws + WS_TOKP); float* TOKG = (float*)(A.ws + WS_TOKG); int* LIST = (int*)(A.ws + WS_LIST);
    float bias[16];
#pragma unroll
    for (int e = 0; e < 16; ++e) bias[e] = A.in[25][e];
    const int row0 = (l == DEPTH - 1) ? RC : 0;
    int nrec = 0;
    for (int row = row0 + F.gw; row < RT; row += F.NGW) {
        f32x4 v[4], f[4]; load_row(xres_row(A, row), F.lane, v);
        const float rstd = row_rstd(v);
        const float* m = MOD + (size_t)(l * 9 + row_bidx(row)) * 6144;
        norm_mod_store(v, rstd, A.in[7] + l * D, m + 4 * 1024, m + 3 * 1024, FB + (size_t)row * D, F.lane, &f);
        float lg[16];
#pragma unroll
        for (int e = 0; e < 16; ++e) lg[e] = 0.f;
#pragma unroll
        for (int j = 0; j < 4; ++j)
#pragma unroll
            for (int q = 0; q < 4; ++q) { const int k = 4 * F.lane + 256 * j + q; const float fv = f[j][q]; const LAS f32x4* wr = (const LAS f32x4*)(rw + k * RW_STRIDE);
#pragma unroll
                for (int e4 = 0; e4 < 4; ++e4) { const f32x4 w = wr[e4]; lg[e4 * 4 + 0] += fv * w.x; lg[e4 * 4 + 1] += fv * w.y; lg[e4 * 4 + 2] += fv * w.z; lg[e4 * 4 + 3] += fv * w.w; } }
#pragma unroll
        for (int e = 0; e < 16; ++e) lg[e] = wave_sum(lg[e]);
        float mx = lg[0];
#pragma unroll
        for (int e = 1; e < 16; ++e) mx = fmaxf(mx, lg[e]);
        float pr[16], sel[16], ps = 0.f;
#pragma unroll
        for (int e = 0; e < 16; ++e) { pr[e] = __expf(lg[e] - mx); ps += pr[e]; }
        const float ips = 1.0f / ps;
#pragma unroll
        for (int e = 0; e < 16; ++e) { pr[e] *= ips; sel[e] = pr[e] + bias[e]; }
        int bg = 0; float bs = -INFINITY;
#pragma unroll
        for (int g = 0; g < 4; ++g) { float f1 = -INFINITY, f2 = -INFINITY;
#pragma unroll
            for (int q = 0; q < 4; ++q) { const float x = sel[g * 4 + q]; if (x > f1) { f2 = f1; f1 = x; } else if (x > f2) f2 = x; }
            const float gs = f1 + f2; if (gs > bs) { bs = gs; bg = g; } }
        float s4[4], p4[4];
#pragma unroll
        for (int q = 0; q < 4; ++q) { s4[q] = sel[q]; p4[q] = pr[q]; }
#pragma unroll
        for (int g = 1; g < 4; ++g) if (bg == g) {
#pragma unroll
            for (int q = 0; q < 4; ++q) { s4[q] = sel[g * 4 + q]; p4[q] = pr[g * 4 + q]; } }
        int i1 = 0; float b1 = s4[0], q1 = p4[0];
#pragma unroll
        for (int q = 1; q < 4; ++q) if (s4[q] > b1) { b1 = s4[q]; i1 = q; q1 = p4[q]; }
        int i2 = -1; float b2 = -INFINITY, q2 = 0.f;
#pragma unroll
        for (int q = 0; q < 4; ++q) if (q != i1 && s4[q] > b2) { b2 = s4[q]; i2 = q; q2 = p4[q]; }
        const int e1 = bg * 4 + i1, e2 = bg * 4 + i2; const float gsum = q1 + q2;
        if (F.lane == 0) {
            const int lp1 = atomicAdd((int*)(lcnt + e1), 1), lp2 = atomicAdd((int*)(lcnt + e2), 1);
            LAS int* r5 = rec + (F.wave * 20 + nrec) * 5; r5[0] = row; r5[1] = e1; r5[2] = lp1; r5[3] = e2; r5[4] = lp2;
            TOKG[row * 2] = q1 / gsum; TOKG[row * 2 + 1] = q2 / gsum;
        }
        ++nrec;
    }
    __syncthreads();
    unsigned* gcnt = (unsigned*)(A.ws + WS_CTL) + CW_GCNT + l * 16;
    if (F.tid < 16) lcnt[16 + F.tid] = (int)__hip_atomic_fetch_add(gcnt + F.tid, (unsigned)lcnt[F.tid], __ATOMIC_RELAXED, __HIP_MEMORY_SCOPE_AGENT);
    __syncthreads();
    if (F.lane == 0) for (int i = 0; i < nrec; ++i) { const LAS int* r5 = rec + (F.wave * 20 + i) * 5; const int row = r5[0], e1 = r5[1], e2 = r5[3], p1 = lcnt[16 + e1] + r5[2], p2 = lcnt[16 + e2] + r5[4];
        TOKE[row * 2] = e1; TOKE[row * 2 + 1] = e2; TOKP[row * 2] = p1; TOKP[row * 2 + 1] = p2; LIST[(size_t)e1 * RT + p1] = row; LIST[(size_t)e2 * RT + p2] = row; }
    __syncthreads();
}

__device__ __forceinline__ void phase_gemm_in(Frame& F) {
    const Args& A = *F.a;
    pg8::DenseOrder S; S.init(RT / 256, INW / 256, F.G, (int)blockIdx.x, 0, D, A.ws + WS_WIN);
    pg8::EpiBf16 E{(bf16_t*)(A.ws + WS_Z), INW};
    pg8::gemm_phase<pg8::EpiBf16, pg8::DenseOrder, true>(F.lds, (const char*)(A.ws + WS_XN), D, S, E);
}
__device__ __forceinline__ void phase_gemm_out(Frame& F, int l) {
    const Args& A = *F.a;
    const bool lastl = (l == DEPTH - 1);
    pg8::DenseOrder S; S.init(lastl ? RL / 256 : RT / 256, D / 256, F.G, (int)blockIdx.x, lastl ? 8 : 0, D, A.ws + WS_WOUT);
    float* xrc = (float*)(A.ws + WS_XRC);
    pg8::EpiRes E{l == 0 ? A.in[2] : xrc, l == 0 ? A.in[0] : A.out, xrc, A.out, (const float*)(A.ws + WS_MOD) + (size_t)l * 9 * 6144};
    pg8::gemm_phase<pg8::EpiRes, pg8::DenseOrder, true>(F.lds, (const char*)(A.ws + WS_XN), D, S, E);
}
__device__ __forceinline__ int build_moe_tables(Frame& F, int l, int nN, bool gather) {
    const Args& A = *F.a;
    build_tstart(F, l);
    const LAS int* tstart = (const LAS int*)(F.lds + LC_TSTART); const LAS int* cnt = (const LAS int*)(F.lds + LC_CNT);
    LAS int* tile_e = (LAS int*)(F.lds + LC_TILE_E); LAS unsigned* rowoff = (LAS unsigned*)(F.lds + LC_ROWOFF);
    const int ntiles = tstart[NE];
    for (int t = F.tid; t < ntiles; t += NTHR) { int e = 0;
#pragma unroll
        for (int q = 1; q < NE; ++q) if (t >= tstart[q]) e = q;
        tile_e[t] = e; }
    __syncthreads();
    if (gather) {
        const int* LIST = (const int*)(A.ws + WS_LIST);
        for (int i = 0; i < 10; ++i) { const long L = (long)i * F.G + blockIdx.x; if (L >= (long)ntiles * nN) break;
            const int tile = (int)(L / nN), e = tile_e[tile], lt = tile - tstart[e];
            for (int r = F.tid; r < 256; r += NTHR) { const int j = lt * 256 + r; const int tok = j < cnt[e] ? LIST[(size_t)e * RT + j] : 0; rowoff[i * 256 + r] = (unsigned)tok * (unsigned)(D * 2); } }
        __syncthreads();
    }
    return ntiles;
}
__device__ __forceinline__ void phase_moe1(Frame& F, int l) {
    const Args& A = *F.a;
    const int ntiles = build_moe_tables(F, l, 8, true);
    pg8::MoeOrder S{ntiles, 8, F.G, (int)blockIdx.x, D, (const char*)(A.ws + WS_W13), (size_t)2048 * D * 2, (const LAS int*)(F.lds + LC_TILE_E), (const LAS unsigned*)(F.lds + LC_ROWOFF)};
    pg8::EpiSwiGLU E{(bf16_t*)(A.ws + WS_Z)};
    pg8::gemm_phase<pg8::EpiSwiGLU, pg8::MoeOrder, true>(F.lds, (const char*)(A.ws + WS_XN), D, S, E);
}
__device__ __forceinline__ void phase_moe2(Frame& F, int l) {
    const Args& A = *F.a;
    const int ntiles = build_moe_tables(F, l, 4, false);
    pg8::MoeOrder S{ntiles, 4, F.G, (int)blockIdx.x, D, (const char*)(A.ws + WS_W2), (size_t)D * D * 2, (const LAS int*)(F.lds + LC_TILE_E), nullptr};
    pg8::EpiBf16 E{(bf16_t*)(A.ws + WS_Y), D};
    pg8::gemm_phase<pg8::EpiBf16, pg8::MoeOrder, true>(F.lds, (const char*)(A.ws + WS_Z), D, S, E);
}

enum { PH_W = 0, PH_TAB, PH_PRENORM, PH_GEMM_IN, PH_GEMM_OUT, PH_ROUTER, PH_MOE1, PH_MOE2, PH_FINAL };
__global__ void __launch_bounds__(NTHR, 2) mk_fwd(Args args) {
    extern __shared__ __attribute__((aligned(16))) unsigned char lds_raw[];
    Frame F; F.lds = (LAS unsigned char*)lds_raw; F.tid = threadIdx.x; F.lane = F.tid & 63; F.wave = __builtin_amdgcn_readfirstlane(F.tid >> 6);
    F.G = gridDim.x; F.gw = blockIdx.x * NWAVES + F.wave; F.NGW = F.G * NWAVES; F.a = &args;
    const int ph = args.ph, l = args.l;
    if (ph == PH_W) phase_weights(F, l);
    else if (ph == PH_TAB) phase_tables(F);
    else if (ph == PH_PRENORM) phase_prenorm(F, l);
    else if (ph == PH_GEMM_IN) phase_gemm_in(F);
    else if (ph == PH_GEMM_OUT) phase_gemm_out(F, l);
    else if (ph == PH_ROUTER) phase_router(F, l);
    else if (ph == PH_MOE1) phase_moe1(F, l);
    else if (ph == PH_MOE2) phase_moe2(F, l);
    else if (ph == PH_FINAL) phase_final(F);
}

struct MixArgs { const float* in[30]; unsigned char* ws; int l, pad; };
__device__ __forceinline__ int scan_row(int b, int dir, int s) {
    if (s < CTXL) { const int i = dir == 0 ? s : CTXL - 1 - s; return b * CTXL + i; }
    const int t = s - CTXL; return RC + b * SEQ + (dir == 0 ? t : SEQ - 1 - t);
}
__global__ void __launch_bounds__(64) naive_s5(MixArgs a) {
    const int blk = blockIdx.x, dir = blk & 1, g = (blk >> 1) & 15, b = blk >> 5, p = threadIdx.x, l = a.l;
    const int pg = ((l * 2 + dir) * 16 + g);
    const float are = a.in[10][pg * 64 + p], aim = a.in[11][pg * 64 + p], dt = expf(a.in[12][pg]);
    const float mag = expf(dt * are); float sn, cs; sincos_d(dt * aim, sn, cs);
    const float abr = mag * cs, abi = mag * sn, inv = 1.0f / (are * are + aim * aim);
    const float fre = ((abr - 1.0f) * are + abi * aim) * inv, fim = (abi * are - (abr - 1.0f) * aim) * inv;
    float bbr[16], bbi[16], cr[16], ci[16];
#pragma unroll
    for (int h = 0; h < 16; ++h) { const float br = a.in[13][(pg * 64 + p) * 16 + h], bi = a.in[14][(pg * 64 + p) * 16 + h];
        bbr[h] = fre * br - fim * bi; bbi[h] = fre * bi + fim * br; cr[h] = a.in[15][(pg * 16 + h) * 64 + p]; ci[h] = a.in[16][(pg * 16 + h) * 64 + p]; }
    const bf16_t* Z = (const bf16_t*)(a.ws + WS_Z); float* S5Y = (float*)(a.ws + WS_S5Y);
    float hr = 0.f, hi = 0.f;
    for (int s = 0; s < NPOS; ++s) {
        const int row = scan_row(b, dir, s);
        const u32x4 u0 = *(const u32x4*)(Z + (size_t)row * INW + OFF_U + g * 16), u1 = *(const u32x4*)(Z + (size_t)row * INW + OFF_U + g * 16 + 8);
        float u[16]; u[0] = bflo(u0.x); u[1] = bfhi(u0.x); u[2] = bflo(u0.y); u[3] = bfhi(u0.y); u[4] = bflo(u0.z); u[5] = bfhi(u0.z); u[6] = bflo(u0.w); u[7] = bfhi(u0.w);
        u[8] = bflo(u1.x); u[9] = bfhi(u1.x); u[10] = bflo(u1.y); u[11] = bfhi(u1.y); u[12] = bflo(u1.z); u[13] = bfhi(u1.z); u[14] = bflo(u1.w); u[15] = bfhi(u1.w);
        float sr = 0.f, si = 0.f;
#pragma unroll
        for (int h = 0; h < 16; ++h) { sr += bbr[h] * u[h]; si += bbi[h] * u[h]; }
        const float nr = abr * hr - abi * hi + sr, ni = abr * hi + abi * hr + si; hr = nr; hi = ni;
        float mine = 0.f;
#pragma unroll
        for (int h = 0; h < 16; ++h) { const float y = wave_sum(cr[h] * hr - ci[h] * hi); if (p == h) mine = y; }
        if (p < 16) atomicAdd(S5Y + (size_t)row * 256 + g * 16 + p, mine);
    }
}
__global__ void __launch_bounds__(256) naive_s5_glu(MixArgs a) {
    const int row = blockIdx.x, c = threadIdx.x, l = a.l;
    __shared__ float z[256];
    const bf16_t* Z = (const bf16_t*)(a.ws + WS_Z); const float* S5Y = (const float*)(a.ws + WS_S5Y);
    const float u = bf2f(Z[(size_t)row * INW + OFF_U + c]);
    const float y = S5Y[(size_t)row * 256 + c] + a.in[17][l * 256 + c] * u;
    const float zz = gelu_tanh(y); z[c] = zz;
    __syncthreads();
    float s = a.in[19][l * 256 + c]; const float* W = a.in[18] + (size_t)l * 256 * 256 + c;
    for (int k = 0; k < 256; ++k) s += z[k] * W[k * 256];
    ((bf16_t*)(a.ws + WS_XN))[(size_t)row * D + c] = (bf16_t)f2bf(zz * sigmoidf_(s));
}
__global__ void __launch_bounds__(64) naive_ret(MixArgs a) {
    const int blk = blockIdx.x, dir = blk & 1, hd = (blk >> 1) & 7, b = blk >> 4, lane = threadIdx.x, l = a.l;
    const float dl = a.in[20][(l * 2 + dir) * 8 + hd];
    const float lgam = fminf(dl, 0.f) - log1pf(expf(-fabsf(dl)));
    const float gam = expf(lgam);
    const bf16_t* Z = (const bf16_t*)(a.ws + WS_Z); float* RO = (float*)(a.ws + WS_RO); const f32x2* ROT = (const f32x2*)(a.ws + WS_ROT);
    float S[64];
#pragma unroll
    for (int d = 0; d < 64; ++d) S[d] = 0.f;
    for (int s = 0; s < NPOS; ++s) {
        const int row = scan_row(b, dir, s);
        const bf16_t* zr = Z + (size_t)row * INW + hd * 64;
        const float qo = bf2f(zr[OFF_Q + lane]), ko = bf2f(zr[OFF_K + lane]) * 0.125f, v = bf2f(zr[OFF_V + lane]);
        const f32x2 csn = ROT[s * 32 + (lane & 31)];
        const float qp = __shfl_xor(qo, 32), kp = __shfl_xor(ko, 32);
        const float q = lane < 32 ? qo * csn.x - qp * csn.y : qp * csn.y + qo * csn.x;
        const float k = lane < 32 ? ko * csn.x - kp * csn.y : kp * csn.y + ko * csn.x;
        float o = 0.f;
        if (dir == 0) {
#pragma unroll
            for (int d = 0; d < 64; ++d) { S[d] = gam * S[d] + __shfl(k, d) * v; o += __shfl(q, d) * S[d]; }
        } else {
#pragma unroll
            for (int d = 0; d < 64; ++d) { o += __shfl(q, d) * S[d]; S[d] = gam * S[d] + __shfl(k, d) * v; }
            o *= gam;
        }
        atomicAdd(RO + (size_t)row * 512 + hd * 64 + lane, o);
    }
}
__global__ void __launch_bounds__(64) naive_ret_out(MixArgs a) {
    const int row = blockIdx.x >> 3, hd = blockIdx.x & 7, lane = threadIdx.x, l = a.l;
    const float o = ((const float*)(a.ws + WS_RO))[(size_t)row * 512 + hd * 64 + lane];
    const float mu = wave_sum(o) * (1.0f / 64.0f); const float dv = o - mu; const float var = wave_sum(dv * dv) * (1.0f / 64.0f);
    const float g = bf2f(((const bf16_t*)(a.ws + WS_Z))[(size_t)row * INW + OFF_G + hd * 64 + lane]);
    const float r = dv / sqrtf(var + 1e-5f) * a.in[21][l * 512 + hd * 64 + lane] * siluf_(g);
    ((bf16_t*)(a.ws + WS_XN))[(size_t)row * D + 256 + hd * 64 + lane] = (bf16_t)f2bf(r);
}
__global__ void __launch_bounds__(256) naive_pool(MixArgs a) {
    const int row = blockIdx.x, c = threadIdx.x, l = a.l, g = c >> 6, win = 2 << g;
    __shared__ float pooled[256];
    const bf16_t* Z = (const bf16_t*)(a.ws + WS_Z);
    int base, j, n;
    if (row < RC) { j = row & (CTXL - 1); base = row - j; n = CTXL; } else { const int t = (row - RC) & (SEQ - 1); j = t & 63; base = row - j; n = 64; }
    int lo = j - win / 2; if (lo < 0) lo = 0; int hi = j - win / 2 + win - 1; if (hi > n - 1) hi = n - 1;
    float s = 0.f; for (int q = lo; q <= hi; ++q) s += bf2f(Z[(size_t)(base + q) * INW + OFF_P + c]);
    pooled[c] = s / (float)(hi - lo + 1) - bf2f(Z[(size_t)row * INW + OFF_P + c]);
    __syncthreads();
    const int d = c & 63; const float* W = a.in[22] + ((size_t)l * 4 + g) * 64 * 64 + d; float o = 0.f;
    for (int k = 0; k < 64; ++k) o += pooled[g * 64 + k] * W[k * 64];
    ((bf16_t*)(a.ws + WS_XN))[(size_t)row * D + 768 + c] = (bf16_t)f2bf(o * a.in[23][l * 256 + c]);
}

extern "C" void kernel_launch(void* const* d_in, const int* in_sizes, int n_in, void* d_out, int out_size, void* d_ws, size_t ws_size, hipStream_t stream) {
    static int grid = 0;
    if (grid == 0) {
        if (n_in != 30 || out_size != RL * D || ws_size < WS_END) { fprintf(stderr, "kernel_launch: unexpected shapes (n_in %d out %d ws %zu)\n", n_in, out_size, ws_size); grid = -1; return; }
        int dev = 0, cus = 0, per_cu = 0;
        hipGetDevice(&dev); hipDeviceGetAttribute(&cus, hipDeviceAttributeMultiprocessorCount, dev);
        hipFuncSetAttribute((const void*)mk_fwd, hipFuncAttributeMaxDynamicSharedMemorySize, LDS_BYTES);
        hipOccupancyMaxActiveBlocksPerMultiprocessor(&per_cu, (const void*)mk_fwd, NTHR, LDS_BYTES);
        (void)hipGetLastError();
        grid = cus * (per_cu >= 1 ? 1 : 1);
        fprintf(stderr, "kernel_launch: cus %d per_cu %d grid %d ws %zu\n", cus, per_cu, grid, ws_size);
    }
    if (grid < 0) return;
    hipMemsetAsync((char*)d_ws + WS_CTL, 0, CTL_BYTES, stream);
    Args a{}; for (int i = 0; i < 30; ++i) a.in[i] = (const float*)d_in[i];
    a.out = (float*)d_out; a.ws = (unsigned char*)d_ws;
    MixArgs m{}; for (int i = 0; i < 30; ++i) m.in[i] = (const float*)d_in[i];
    m.ws = (unsigned char*)d_ws;
#define LAUNCH(PH, L) do { a.ph = (PH); a.l = (L); hipLaunchKernelGGL(mk_fwd, dim3(grid), dim3(NTHR), LDS_BYTES, stream, a); } while (0)
    LAUNCH(PH_TAB, 0);
    for (int l = 0; l < DEPTH; ++l) {
        LAUNCH(PH_W, l);
        LAUNCH(PH_PRENORM, l);
        LAUNCH(PH_GEMM_IN, l);
        m.l = l;
        hipMemsetAsync((char*)d_ws + WS_S5Y, 0, (size_t)RT * 256 * 4, stream);
        hipMemsetAsync((char*)d_ws + WS_RO, 0, (size_t)RT * 512 * 4, stream);
        hipLaunchKernelGGL(naive_s5, dim3(NB * 16 * 2), dim3(64), 0, stream, m);
        hipLaunchKernelGGL(naive_ret, dim3(NB * 8 * 2), dim3(64), 0, stream, m);
        hipLaunchKernelGGL(naive_s5_glu, dim3(RT), dim3(256), 0, stream, m);
        hipLaunchKernelGGL(naive_ret_out, dim3(RT * 8), dim3(64), 0, stream, m);
        hipLaunchKernelGGL(naive_pool, dim3(RT), dim3(256), 0, stream, m);
        LAUNCH(PH_GEMM_OUT, l);
        LAUNCH(PH_ROUTER, l);
        LAUNCH(PH_MOE1, l);
        LAUNCH(PH_MOE2, l);
    }
    LAUNCH(PH_FINAL, 0);
#undef LAUNCH
}
```

```cpp
#include <hip/hip_runtime.h>
#include <hip/hip_cooperative_groups.h>
#include <cstdio>
#include <cstdint>

#define LAS __attribute__((address_space(3)))
typedef unsigned short bf16_t;
typedef short bf16x8 __attribute__((ext_vector_type(8)));
typedef float f32x4 __attribute__((ext_vector_type(4)));
typedef float f32x2 __attribute__((ext_vector_type(2)));
typedef unsigned u32x4 __attribute__((ext_vector_type(4)));
typedef unsigned u32x2 __attribute__((ext_vector_type(2)));

constexpr int D = 1024, NB = 8, SEQ = 4096, CTXL = 256, DEPTH = 2, INW = 2560;
constexpr int RC = NB * CTXL, RL = NB * SEQ, RT = RC + RL;
constexpr int NE = 16;
constexpr int OFF_U = 0, OFF_Q = 256, OFF_K = 768, OFF_V = 1280, OFF_G = 1792, OFF_P = 2304;
constexpr int MAXTILES = 288, NPOS = CTXL + SEQ;
constexpr int NWAVES = 8, NTHR = 512;

constexpr size_t MiB = 1u << 20;
constexpr size_t WS_CTL = 0, CTL_BYTES = 1 * MiB;
constexpr size_t WS_MOD = 1 * MiB;
constexpr size_t WS_ROT = 2 * MiB;
constexpr size_t WS_TOKE = 4 * MiB;
constexpr size_t WS_TOKP = 4 * MiB + 512 * 1024;
constexpr size_t WS_TOKG = 5 * MiB;
constexpr size_t WS_LIST = 5 * MiB + 512 * 1024;
constexpr size_t WS_GLUT = 7 * MiB + 768 * 1024;
constexpr size_t WS_POOLT = 7 * MiB + 896 * 1024;
constexpr size_t WS_S5M = 8 * MiB;
constexpr size_t WS_WIN = 16 * MiB;
constexpr size_t WS_WOUT = 21 * MiB;
constexpr size_t WS_W13 = 24 * MiB;
constexpr size_t WS_W2 = 88 * MiB;
constexpr size_t WS_XN = 120 * MiB;
constexpr size_t WS_Z = 188 * MiB;
constexpr size_t WS_Y = 358 * MiB;
constexpr size_t WS_XRC = 502 * MiB;
constexpr size_t WS_END = 510 * MiB;
constexpr size_t WS_S5Y = WS_Y;
constexpr size_t WS_RO = WS_Y + 34 * MiB;
constexpr size_t WS_POOLED = WS_Y + 102 * MiB;
constexpr int CW_BAR = 4096, CW_GCNT = 8192;

__device__ __forceinline__ float wave_sum(float v) {
#pragma unroll
    for (int o = 1; o < 64; o <<= 1) v += __shfl_xor(v, o);
    return v;
}
__device__ __forceinline__ unsigned f2bf(float f) { unsigned u = __builtin_bit_cast(unsigned, f); return (u + 0x7fffu + ((u >> 16) & 1u)) >> 16; }
__device__ __forceinline__ unsigned pk2(float lo, float hi) { return f2bf(lo) | (f2bf(hi) << 16); }
__device__ __forceinline__ float bf2f(unsigned h) { return __builtin_bit_cast(float, h << 16); }
__device__ __forceinline__ float bflo(unsigned w) { return __builtin_bit_cast(float, w << 16); }
__device__ __forceinline__ float bfhi(unsigned w) { return __builtin_bit_cast(float, w & 0xffff0000u); }
__device__ __forceinline__ float sigmoidf_(float x) { return 1.0f / (1.0f + __expf(-x)); }
__device__ __forceinline__ float siluf_(float x) { return x / (1.0f + __expf(-x)); }
__device__ __forceinline__ float gelu_tanh(float x) { const float u = 0.7978845608028654f * (x + 0.044715f * x * x * x); return 0.5f * x * (1.0f + tanhf(u)); }
#define LDS_WAIT() asm volatile("s_waitcnt lgkmcnt(0)" ::: "memory")
#define VM_WAIT() asm volatile("s_waitcnt vmcnt(0)" ::: "memory")

namespace pg8 {
constexpr int BM = 256, BK = 64, HALF = 128, HTB = HALF * BK * 2, STAGE_BYTES = 8 * HTB, NXCD = 8, WGM = 8;
__host__ __device__ __forceinline__ int lds_byte(int r, int c) { const int st = (r >> 4) * 2 + (c >> 5), rr = r & 15, cc = c & 31, ob = rr * 64 + cc * 2; return st * 1024 + (ob ^ (((ob >> 9) & 1) << 5)); }
__host__ __device__ __forceinline__ void stage_rc(int b, int& R, int& C) { const int st = b / 1024, sb = b % 1024, swz = sb ^ (((sb >> 9) & 1) << 5); R = (st >> 1) * 16 + swz / 64; C = (st & 1) * 32 + (swz % 64) / 2; }
__host__ __device__ __forceinline__ int perm32(int rho) { const int n = rho >> 4, i = rho & 15; return 8 * (i >> 2) + 4 * n + (i & 3); }

struct Unit { int pm, pn, e, ui; };

__device__ __forceinline__ unsigned cvt_pk_bf16(float lo, float hi) { unsigned r; asm volatile("v_cvt_pk_bf16_f32 %0, %1, %2" : "=v"(r) : "v"(lo), "v"(hi)); return r; }

struct DenseOrder {
    int nM, nN, nwg, G, c, pm0, K; const char* Bt;
    __device__ void init(int nM_, int nN_, int G_, int c_, int pm0_, int K_, const void* Bt_) { nM = nM_; nN = nN_; nwg = nM * nN; G = G_; c = c_; pm0 = pm0_; K = K_; Bt = (const char*)Bt_; }
    __device__ bool next(int i, Unit& u) const {
        const long L = (long)i * G + c; if (L >= nwg) return false;
        int wgid = (int)L; { const int q = nwg / NXCD, r = nwg % NXCD, xcd = wgid % NXCD, off = wgid / NXCD; wgid = (xcd < r ? xcd * (q + 1) : r * (q + 1) + (xcd - r) * q) + off; }
        const int nig = WGM * nN, gid = wgid / nig, fm = gid * WGM, gsz = (nM - fm) < WGM ? (nM - fm) : WGM;
        u.pm = pm0 + fm + ((wgid % nig) % gsz); u.pn = (wgid % nig) / gsz; u.e = 0; u.ui = i; return true;
    }
    __device__ __forceinline__ void a_offs(const Unit& u, const int (&R)[2], const int (&C)[2], unsigned (&off)[2][2]) const {
#pragma unroll
        for (int h = 0; h < 2; ++h)
#pragma unroll
            for (int i = 0; i < 2; ++i) off[h][i] = (unsigned)((u.pm * BM + h * HALF + R[i]) * K + C[i]) * 2u;
    }
    __device__ __forceinline__ const char* b_ptr(const Unit& u) const { return Bt + (size_t)u.pn * BM * K * 2; }
};
struct MoeOrder {
    int ntiles, nN, G, c, K; const char* Bt; size_t bstride; const LAS int* tile_e; const LAS unsigned* rowoff;
    __device__ bool next(int i, Unit& u) const {
        const long L = (long)i * G + c; if (L >= (long)ntiles * nN) return false;
        u.pn = (int)(L % nN); u.pm = (int)(L / nN); u.e = tile_e[u.pm]; u.ui = i; return true;
    }
    __device__ __forceinline__ void a_offs(const Unit& u, const int (&R)[2], const int (&C)[2], unsigned (&off)[2][2]) const {
#pragma unroll
        for (int h = 0; h < 2; ++h)
#pragma unroll
            for (int i = 0; i < 2; ++i) off[h][i] = rowoff ? rowoff[u.ui * 256 + h * HALF + R[i]] + (unsigned)C[i] * 2u : (unsigned)((u.pm * BM + h * HALF + R[i]) * K + C[i]) * 2u;
    }
    __device__ __forceinline__ const char* b_ptr(const Unit& u) const { return Bt + (size_t)u.e * bstride + (size_t)u.pn * BM * K * 2; }
};

struct EpiBf16 {
    static constexpr bool PERM = true;
    bf16_t* O; int ldc;
    __device__ __forceinline__ void operator()(const f32x4 (&acc)[2][2][4][2], const Unit& u, int wr, int wc, int fr, int fq) const {
        const int row0 = u.pm * BM + wr * 64 + fr, col0 = u.pn * BM + wc * 32 + 8 * fq;
#pragma unroll
        for (int ai = 0; ai < 2; ++ai)
#pragma unroll
            for (int m = 0; m < 4; ++m) { bf16_t* rowp = O + (size_t)(row0 + ai * HALF + m * 16) * ldc + col0;
#pragma unroll
                for (int bj = 0; bj < 2; ++bj) { const f32x4 v0 = acc[ai][bj][m][0], v1 = acc[ai][bj][m][1];
                    u32x4 w; w.x = cvt_pk_bf16(v0[0], v0[1]); w.y = cvt_pk_bf16(v0[2], v0[3]); w.z = cvt_pk_bf16(v1[0], v1[1]); w.w = cvt_pk_bf16(v1[2], v1[3]);
                    *(u32x4*)(rowp + bj * HALF) = w; } }
    }
};
struct EpiSwiGLU {
    static constexpr bool PERM = true;
    bf16_t* O;
    __device__ __forceinline__ void operator()(const f32x4 (&acc)[2][2][4][2], const Unit& u, int wr, int wc, int fr, int fq) const {
        const int row0 = u.pm * BM + wr * 64 + fr, col0 = u.pn * HALF + wc * 32 + 8 * fq;
#pragma unroll
        for (int ai = 0; ai < 2; ++ai)
#pragma unroll
            for (int m = 0; m < 4; ++m) { bf16_t* rowp = O + (size_t)(row0 + ai * HALF + m * 16) * 1024 + col0;
                float h[8];
#pragma unroll
                for (int n = 0; n < 2; ++n)
#pragma unroll
                    for (int j = 0; j < 4; ++j) { const float a = acc[ai][0][m][n][j], b = acc[ai][1][m][n][j]; h[n * 4 + j] = a * __builtin_amdgcn_rcpf(1.0f + __builtin_amdgcn_exp2f(-1.4426950408889634f * a)) * b; }
                u32x4 w; w.x = cvt_pk_bf16(h[0], h[1]); w.y = cvt_pk_bf16(h[2], h[3]); w.z = cvt_pk_bf16(h[4], h[5]); w.w = cvt_pk_bf16(h[6], h[7]);
                *(u32x4*)rowp = w; }
    }
};
struct EpiRes {
    static constexpr bool PERM = false;
    const float* src_c; const float* src_l; float* dst_c; float* dst_l; const float* modl;
    __device__ __forceinline__ void operator()(const f32x4 (&acc)[2][2][4][2], const Unit& u, int wr, int wc, int fr, int fq) const {
        const bool isc = u.pm < 8; const int bidx = isc ? 8 : ((u.pm - 8) >> 4);
        const float* src = isc ? src_c : src_l; float* dst = isc ? dst_c : dst_l;
        const int rl0 = (isc ? u.pm * BM : (u.pm - 8) * BM) + wr * 64 + fr, col0 = u.pn * BM + wc * 32 + 4 * fq;
        const float* gate = modl + bidx * 6144 + 2048;
        f32x4 gv[2][2];
#pragma unroll
        for (int bj = 0; bj < 2; ++bj)
#pragma unroll
            for (int n = 0; n < 2; ++n) gv[bj][n] = *(const f32x4*)(gate + col0 + bj * HALF + n * 16);
#pragma unroll
        for (int ai = 0; ai < 2; ++ai)
#pragma unroll
            for (int m = 0; m < 4; ++m) { const size_t off = (size_t)(rl0 + ai * HALF + m * 16) * 1024 + col0;
#pragma unroll
                for (int bj = 0; bj < 2; ++bj)
#pragma unroll
                    for (int n = 0; n < 2; ++n) { const f32x4 s = *(const f32x4*)(src + off + bj * HALF + n * 16); *(f32x4*)(dst + off + bj * HALF + n * 16) = s + gv[bj][n] * acc[ai][bj][m][n]; } }
    }
};

template <class Epi, class Sched, bool ALIGN_EPI>
__device__ __forceinline__ void gemm_phase(LAS unsigned char* lds, const char* Abase, const int K, const Sched& S, const Epi& E) {
    int tid_ = threadIdx.x; asm volatile("" : "+v"(tid_));
    const int tid = tid_, wid = __builtin_amdgcn_readfirstlane(tid >> 6), lane = tid & 63, wr = wid >> 2, wc = wid & 3, fr = lane & 15, fq = lane >> 4;
    const int nt = K / BK;
    int Rr[2], Cc[2]; unsigned voffB[2];
#pragma unroll
    for (int i = 0; i < 2; ++i) { int R, C; stage_rc(tid * 16 + i * 8192, R, C); Rr[i] = R; Cc[i] = C; const int Rb = Epi::PERM ? ((R & ~31) + perm32(R & 31)) : R; voffB[i] = (unsigned)(Rb * K + C) * 2u; }
    const size_t kstep = (size_t)(BK * 2);
    const size_t hstepB = (size_t)HALF * K * 2;
    const unsigned ldsw = (unsigned)wid * 1024u;
    const int aoff = lds_byte(wr * 64 + fr, fq * 8), boff = lds_byte(wc * 32 + fr, fq * 8);
#define PG8_SA(b, h) (((b) * 2 + (h)) * HTB)
#define PG8_SB(b, h) ((4 + (b) * 2 + (h)) * HTB)
#define PG8_STAGE_B(bufoff, gbase) do { _Pragma("unroll") for (int _i = 0; _i < 2; ++_i) \
        __builtin_amdgcn_global_load_lds((const unsigned*)((const char*)(gbase) + voffB[_i]), (LAS unsigned*)(lds + (bufoff) + ldsw + _i * 8192), 16, 0, 0); } while (0)
#define PG8_STAGE_A(bufoff, offs, kb) do { _Pragma("unroll") for (int _i = 0; _i < 2; ++_i) \
        __builtin_amdgcn_global_load_lds((const unsigned*)(Abase + (kb) + (offs)[_i]), (LAS unsigned*)(lds + (bufoff) + ldsw + _i * 8192), 16, 0, 0); } while (0)
#define PG8_LDA(dst, b, h) do { _Pragma("unroll") for (int m = 0; m < 4; ++m) _Pragma("unroll") for (int k = 0; k < 2; ++k) dst[m][k] = *(const LAS bf16x8*)(lds + PG8_SA(b, h) + aoff + m * 2048 + k * 1024); } while (0)
#define PG8_LDB(dst, b, h) do { _Pragma("unroll") for (int n = 0; n < 2; ++n) _Pragma("unroll") for (int k = 0; k < 2; ++k) dst[n][k] = *(const LAS bf16x8*)(lds + PG8_SB(b, h) + boff + n * 2048 + k * 1024); } while (0)
#define PG8_MMA(ai, bj, At, Bt) do { __builtin_amdgcn_s_setprio(1); _Pragma("unroll") for (int m = 0; m < 4; ++m) _Pragma("unroll") for (int n = 0; n < 2; ++n) _Pragma("unroll") for (int k = 0; k < 2; ++k) \
        acc[ai][bj][m][n] = __builtin_amdgcn_mfma_f32_16x16x32_bf16(Bt[n][k], At[m][k], acc[ai][bj][m][n], 0, 0, 0); __builtin_amdgcn_s_setprio(0); } while (0)
#define PG8_WAIT_V(n) asm volatile("s_waitcnt vmcnt(" #n ")" ::: "memory")
#define PG8_WAIT_L(n) asm volatile("s_waitcnt lgkmcnt(" #n ")" ::: "memory")
#define PG8_BAR __builtin_amdgcn_s_barrier()
#define PG8_SCHED __builtin_amdgcn_sched_barrier(0)
    Unit cur, nxt; int ui = 0;
    if (!S.next(0, cur)) return;
    f32x4 acc[2][2][4][2];
#pragma unroll
    for (int a = 0; a < 2; ++a)
#pragma unroll
        for (int b = 0; b < 2; ++b)
#pragma unroll
            for (int m = 0; m < 4; ++m)
#pragma unroll
                for (int n = 0; n < 2; ++n) acc[a][b][m][n] = (f32x4){0.f, 0.f, 0.f, 0.f};
    bf16x8 At[4][2], B0[2][2], B1[2][2];
    unsigned cO[2][2], nO[2][2];
    S.a_offs(cur, Rr, Cc, cO);
    const char* cB = S.b_ptr(cur); const char* nB = cB;
    PG8_STAGE_B(PG8_SB(0, 0), cB); PG8_STAGE_B(PG8_SB(0, 1), cB + hstepB); PG8_STAGE_A(PG8_SA(0, 0), cO[0], 0); PG8_STAGE_A(PG8_SA(0, 1), cO[1], 0);
    if (wr == 1) PG8_BAR;
    PG8_WAIT_V(2); PG8_BAR;
    PG8_STAGE_B(PG8_SB(1, 0), cB + kstep); PG8_STAGE_A(PG8_SA(1, 0), cO[0], kstep); PG8_STAGE_B(PG8_SB(1, 1), cB + hstepB + kstep);
    PG8_WAIT_V(6); PG8_BAR;
    for (;;) {
        const bool has_next = S.next(ui + 1, nxt);
        if (has_next) { S.a_offs(nxt, Rr, Cc, nO); nB = S.b_ptr(nxt); }
        else { nO[0][0] = cO[0][0]; nO[0][1] = cO[0][1]; nO[1][0] = cO[1][0]; nO[1][1] = cO[1][1]; nB = cB; }
        for (int t = 0; t < nt; t += 2) {
            const bool last = (t == nt - 2);
            const size_t k1 = (size_t)(t + 1) * kstep;
            const size_t k2 = last ? (size_t)0 : (size_t)(t + 2) * kstep, k3 = k2 + kstep;
            unsigned o2[2][2];
            o2[0][0] = last ? nO[0][0] : cO[0][0]; o2[0][1] = last ? nO[0][1] : cO[0][1]; o2[1][0] = last ? nO[1][0] : cO[1][0]; o2[1][1] = last ? nO[1][1] : cO[1][1];
            const char* b2 = (last ? nB : cB) + k2; const char* b3 = b2 + kstep;
            PG8_LDB(B0, 0, 0); PG8_LDB(B1, 0, 1); PG8_SCHED; PG8_LDA(At, 0, 0); PG8_STAGE_A(PG8_SA(1, 1), cO[1], k1);
            PG8_WAIT_V(8); PG8_WAIT_L(0); PG8_BAR; PG8_MMA(0, 0, At, B0); PG8_MMA(0, 1, At, B1); PG8_BAR; PG8_SCHED;
            PG8_LDA(At, 0, 1); PG8_STAGE_B(PG8_SB(0, 0), b2); PG8_STAGE_B(PG8_SB(0, 1), b2 + hstepB); PG8_STAGE_A(PG8_SA(0, 0), o2[0], k2);
            PG8_WAIT_V(8); PG8_WAIT_L(0); PG8_BAR; PG8_MMA(1, 0, At, B0); PG8_MMA(1, 1, At, B1); PG8_BAR; PG8_SCHED;
            PG8_LDB(B0, 1, 0); PG8_LDB(B1, 1, 1); PG8_SCHED; PG8_LDA(At, 1, 0); PG8_STAGE_A(PG8_SA(0, 1), o2[1], k2);
            PG8_WAIT_V(8); PG8_WAIT_L(0); PG8_BAR; PG8_MMA(0, 0, At, B0); PG8_MMA(0, 1, At, B1); PG8_BAR; PG8_SCHED;
            PG8_LDA(At, 1, 1); PG8_STAGE_B(PG8_SB(1, 0), b3); PG8_STAGE_B(PG8_SB(1, 1), b3 + hstepB); PG8_STAGE_A(PG8_SA(1, 0), o2[0], k3);
            PG8_WAIT_V(8); PG8_WAIT_L(0); PG8_BAR; PG8_MMA(1, 0, At, B0); PG8_MMA(1, 1, At, B1); PG8_BAR; PG8_SCHED;
        }
        if constexpr (ALIGN_EPI) { if (wr == 0) PG8_BAR; }
        E(acc, cur, wr, wc, fr, fq);
        if (!has_next) break;
#pragma unroll
        for (int a = 0; a < 2; ++a)
#pragma unroll
            for (int b = 0; b < 2; ++b)
#pragma unroll
                for (int m = 0; m < 4; ++m)
#pragma unroll
                    for (int n = 0; n < 2; ++n) acc[a][b][m][n] = (f32x4){0.f, 0.f, 0.f, 0.f};
        cur = nxt; cB = nB; cO[0][0] = nO[0][0]; cO[0][1] = nO[0][1]; cO[1][0] = nO[1][0]; cO[1][1] = nO[1][1]; ++ui;
        if constexpr (ALIGN_EPI) { if (wr == 1) PG8_BAR; }
    }
    PG8_WAIT_V(0);
    if constexpr (!ALIGN_EPI) { if (wr == 0) PG8_BAR; }
    PG8_BAR;
#undef PG8_SA
#undef PG8_SB
#undef PG8_STAGE_A
#undef PG8_STAGE_B
#undef PG8_LDA
#undef PG8_LDB
#undef PG8_MMA
#undef PG8_WAIT_V
#undef PG8_WAIT_L
#undef PG8_BAR
#undef PG8_SCHED
}
}


#define XB_TMO      128
#define XB_XCNT(j)  (256  + 64 * (j))
#define XB_XSUB(j)  (1280 + 64 * (j))
#define XB_XGEN(j)  (2304 + 64 * (j))
#define XB_TOP      3328
#define XB_TOPGEN   3392
#define XCD_BAR_WORDS 3456
#define XB_SPIN_CAP (1u << 22)
__device__ __forceinline__ unsigned xb_ld(unsigned* p)              { return __hip_atomic_load(p, __ATOMIC_RELAXED, __HIP_MEMORY_SCOPE_AGENT); }
__device__ __forceinline__ unsigned xb_add(unsigned* p, unsigned v) { return __hip_atomic_fetch_add(p, v, __ATOMIC_RELAXED, __HIP_MEMORY_SCOPE_AGENT); }
__device__ __forceinline__ unsigned xb_xcc_id() { return (unsigned)__builtin_amdgcn_s_getreg((3 << 11) | 20) & 0xFu; }
#define XB_SPIN(cond, bar) do { unsigned _sp = 0; while (cond) { __builtin_amdgcn_s_sleep(1); \
    if ((++_sp & 255u) == 0u) { if (xb_ld(&(bar)[XB_TMO])) break; if (_sp > XB_SPIN_CAP) { atomicAdd(&(bar)[XB_TMO], 1u); break; } } } } while (0)
struct XcdBarrier { unsigned* bar; unsigned x; volatile LAS unsigned* st; };
__device__ __forceinline__ XcdBarrier xcd_barrier_post(unsigned* bar, volatile LAS unsigned* st) {
    XcdBarrier b; b.bar = bar; b.x = xb_xcc_id(); b.st = st;
    if (threadIdx.x == 0) (void)xb_add(&bar[XB_XCNT(b.x)], 1u);
    return b;
}
__device__ __forceinline__ void xcd_barrier_complete(unsigned* bar, unsigned x, unsigned& nloc, unsigned& nx) {
    const unsigned G = gridDim.x * gridDim.y * gridDim.z;
    unsigned sum, cnt, mine, sp = 0u;
    for (;;) {
        sum = 0u; cnt = 0u; mine = 0u;
#pragma unroll
        for (unsigned j = 0; j < 16; ++j) { const unsigned c = xb_ld(&bar[XB_XCNT(j)]); sum += c; cnt += (c > 0u) ? 1u : 0u; mine = (j == x) ? c : mine; }
        if (sum == G) break;
        __builtin_amdgcn_s_sleep(1);
        if ((++sp & 255u) == 0u) { if (xb_ld(&bar[XB_TMO])) break; if (sp > XB_SPIN_CAP) { atomicAdd(&bar[XB_TMO], 1u); break; } }
    }
    nloc = mine > 0u ? mine : 1u; nx = cnt > 0u ? cnt : 1u;
}
__device__ __forceinline__ void xcd_barrier(const XcdBarrier& b) {
    asm volatile("s_waitcnt vmcnt(0)" ::: "memory");
    __syncthreads();
    if (threadIdx.x == 0) {
        unsigned* bar = b.bar;
        __builtin_amdgcn_s_waitcnt(0);
        unsigned nloc = b.st[0], nx = b.st[1];
        if (nloc == 0u) { xcd_barrier_complete(bar, b.x, nloc, nx); b.st[0] = nloc; b.st[1] = nx; }
        const unsigned old = xb_add(&bar[XB_XSUB(b.x)], 1u);
        const unsigned gen = old / nloc;
        if (old + 1u == (gen + 1u) * nloc) {
            __builtin_amdgcn_fence(__ATOMIC_RELEASE, "agent");
            asm volatile("s_waitcnt vmcnt(0)" ::: "memory");
            const unsigned og = xb_add(&bar[XB_TOP], 1u);
            const unsigned tg = og / nx;
            if (og + 1u == (tg + 1u) * nx) xb_add(&bar[XB_TOPGEN], 1u);
            else XB_SPIN(xb_ld(&bar[XB_TOPGEN]) == tg, bar);
            __builtin_amdgcn_fence(__ATOMIC_ACQUIRE, "agent");
            xb_add(&bar[XB_XGEN(b.x)], 1u);
            asm volatile("s_waitcnt vmcnt(0)" ::: "memory");
        } else {
            XB_SPIN(xb_ld(&bar[XB_XGEN(b.x)]) == gen, bar);
            __builtin_amdgcn_fence(__ATOMIC_ACQUIRE, "agent");
            asm volatile("s_waitcnt vmcnt(0)" ::: "memory");
        }
    }
    __syncthreads();
}

constexpr int RING_BYTES = 131072;
constexpr int LC_TILE_E = RING_BYTES;
constexpr int LC_TSTART = LC_TILE_E + 1280;
constexpr int LC_CNT = LC_TSTART + 128;
constexpr int LC_MISC = LC_CNT + 64;
constexpr int LC_ROWOFF = LC_MISC + 128;
constexpr int LDS_BYTES = 147456;
static_assert(LC_ROWOFF + 10 * 256 * 4 <= LDS_BYTES, "LDS map");

struct Args { const float* in[30]; float* out; unsigned char* ws; };
typedef const __attribute__((address_space(4))) Args CArgs;
__device__ __forceinline__ CArgs* get_args() { CArgs* p = (CArgs*)__builtin_amdgcn_kernarg_segment_ptr(); asm volatile("" : "+s"(p)); return p; }

struct Frame {
    LAS unsigned char* lds; int tid, lane, wave, G, gw, NGW;
};

__device__ __forceinline__ float* xres_row(CArgs& A, int row) { return row < RC ? (float*)(A.ws + WS_XRC) + (size_t)row * D : A.out + (size_t)(row - RC) * D; }
__device__ __forceinline__ const float* xin_row(CArgs& A, int row) { return row < RC ? A.in[2] + (size_t)row * D : A.in[0] + (size_t)(row - RC) * D; }
__device__ __forceinline__ int row_bidx(int row) { return row < RC ? 8 : ((row - RC) >> 12); }

__device__ __forceinline__ void sincos_d(float ang, float& s, float& c) { const double a = (double)ang; s = (float)sin(a); c = (float)cos(a); }

__device__ __forceinline__ void transpose_item(const float* W, int N, int Kdst, bf16_t* WT, int k0, int n0, int drow0, LAS float* scr, int lane) {
#pragma unroll 8
    for (int i = 0; i < 32; ++i) { const int kk = 2 * i + (lane >> 5); scr[kk * 33 + (lane & 31)] = W[(size_t)(k0 + kk) * N + n0 + (lane & 31)]; }
    LDS_WAIT(); asm volatile("" ::: "memory");
    const int c = lane & 7;
#pragma unroll
    for (int j = 0; j < 4; ++j) { const int n = (lane >> 3) + 8 * j; const LAS float* s = scr + (8 * c) * 33 + n;
        u32x4 o; o.x = pk2(s[0 * 33], s[1 * 33]); o.y = pk2(s[2 * 33], s[3 * 33]); o.z = pk2(s[4 * 33], s[5 * 33]); o.w = pk2(s[6 * 33], s[7 * 33]);
        *(u32x4*)(WT + (size_t)(drow0 + n) * Kdst + k0 + 8 * c) = o; }
    LDS_WAIT(); asm volatile("" ::: "memory");
}
__device__ __forceinline__ void phase_weights(Frame& F, int l) {
    CArgs& A = *get_args();
    LAS float* scr = (LAS float*)(F.lds + F.wave * 16384);
    unsigned char* ws = A.ws;
    constexpr int I_IN = 16 * 80, I_OUT = 16 * 32, I_E = 16 * 32, I_GLU = 4 * 8, I_POOL = 8;
    constexpr int NITEMS = I_IN + I_OUT + NE * 3 * I_E + I_GLU + I_POOL;
    for (int it = F.gw; it < NITEMS; it += F.NGW) {
        int r = it;
        if (r < I_IN) { const int kb = r / 80, nb = r % 80; transpose_item(A.in[8] + (size_t)l * D * INW, INW, D, (bf16_t*)(ws + WS_WIN), 64 * kb, 32 * nb, 32 * nb, scr, F.lane); continue; } r -= I_IN;
        if (r < I_OUT) { const int kb = r / 32, nb = r % 32; transpose_item(A.in[9] + (size_t)l * D * D, D, D, (bf16_t*)(ws + WS_WOUT), 64 * kb, 32 * nb, 32 * nb, scr, F.lane); continue; } r -= I_OUT;
        if (r < NE * 3 * I_E) { const int e = r / (3 * I_E), q = (r % (3 * I_E)) / I_E, s = r % I_E, kb = s / 32, nb = s % 32, n0 = 32 * nb;
            const size_t wo = ((size_t)l * NE + e) * D * D;
            if (q == 0) transpose_item(A.in[26] + wo, D, D, (bf16_t*)(ws + WS_W13) + (size_t)e * 2048 * D, 64 * kb, n0, 256 * (n0 >> 7) + (n0 & 127), scr, F.lane);
            else if (q == 1) transpose_item(A.in[27] + wo, D, D, (bf16_t*)(ws + WS_W13) + (size_t)e * 2048 * D, 64 * kb, n0, 256 * (n0 >> 7) + 128 + (n0 & 127), scr, F.lane);
            else transpose_item(A.in[28] + wo, D, D, (bf16_t*)(ws + WS_W2) + (size_t)e * D * D, 64 * kb, n0, n0, scr, F.lane);
            continue; } r -= NE * 3 * I_E;
        if (r < I_GLU) { const int kb = r / 8, nb = r % 8; transpose_item(A.in[18] + (size_t)l * 256 * 256, 256, 256, (bf16_t*)(ws + WS_GLUT), 64 * kb, 32 * nb, 32 * nb, scr, F.lane); continue; } r -= I_GLU;
        { const int g = r / 2, nb = r % 2; transpose_item(A.in[22] + ((size_t)l * 4 + g) * 64 * 64, 64, 64, (bf16_t*)(ws + WS_POOLT) + g * 64 * 64, 0, 32 * nb, 32 * nb, scr, F.lane); }
    }
}
__device__ __forceinline__ void phase_tables(Frame& F) {
    CArgs& A = *get_args();
    __syncthreads();
    LAS float* sc = (LAS float*)F.lds;
    LAS float* part = (LAS float*)(F.lds + 40960);
    float* MOD = (float*)(A.ws + WS_MOD);
    if ((int)blockIdx.x < 192) {
        for (int i = F.tid; i < 9 * 1024; i += NTHR) { const int r = i >> 10, k = i & 1023; const float v = r < 8 ? A.in[1][r * 1024 + k] : A.in[3][k]; sc[i] = siluf_(v); }
        __syncthreads();
        for (int it = blockIdx.x; it < 192; it += F.G) {
            const int l = it / 96, cg = it % 96, col = F.tid & 63, ks = F.tid >> 6;
            const float* W = A.in[4] + (size_t)l * D * 6144 + cg * 64 + col;
            float acc[9];
#pragma unroll
            for (int r = 0; r < 9; ++r) acc[r] = 0.f;
            for (int kk = 0; kk < 128; ++kk) { const int k = ks * 128 + kk; const float w = W[(size_t)k * 6144];
#pragma unroll
                for (int r = 0; r < 9; ++r) acc[r] += sc[r * 1024 + k] * w; }
#pragma unroll
            for (int r = 0; r < 9; ++r) part[(ks * 9 + r) * 64 + col] = acc[r];
            __syncthreads();
            for (int idx = F.tid; idx < 576; idx += NTHR) { const int r = idx >> 6, c = idx & 63; float s = A.in[5][l * 6144 + cg * 64 + c];
#pragma unroll
                for (int k8 = 0; k8 < 8; ++k8) s += part[(k8 * 9 + r) * 64 + c];
                MOD[(l * 9 + r) * 6144 + cg * 64 + c] = s; }
            __syncthreads();
        }
    }
    f32x2* ROT = (f32x2*)(A.ws + WS_ROT);
    for (int idx = blockIdx.x * NTHR + F.tid; idx < NPOS * 32; idx += F.G * NTHR) {
        const int pos = idx >> 5, i = idx & 31; const float inv = powf(10000.0f, -(float)i / 32.0f); const float ang = (float)pos * inv; float s, c; sincos_d(ang, s, c); ROT[idx] = (f32x2){c, s};
    }
    __syncthreads();
}

struct RowComb { float g1, g2; const bf16_t* y1; const bf16_t* y2; };
__device__ __forceinline__ void load_row(const float* p, int lane, f32x4 (&v)[4]) {
#pragma unroll
    for (int j = 0; j < 4; ++j) v[j] = ((const f32x4*)p)[lane + 64 * j];
}
__device__ __forceinline__ void store_row(float* p, int lane, const f32x4 (&v)[4]) {
#pragma unroll
    for (int j = 0; j < 4; ++j) ((f32x4*)p)[lane + 64 * j] = v[j];
}
__device__ __forceinline__ void moe_combine(CArgs& A, int lp, int row, int lane, const LAS int* tstart, f32x4 (&v)[4]) {
    const int* TOKE = (const int*)(A.ws + WS_TOKE); const int* TOKP = (const int*)(A.ws + WS_TOKP); const float* TOKG = (const float*)(A.ws + WS_TOKG);
    const int e1 = TOKE[row * 2], e2 = TOKE[row * 2 + 1], p1 = TOKP[row * 2], p2 = TOKP[row * 2 + 1];
    const float g1 = TOKG[row * 2], g2 = TOKG[row * 2 + 1];
    const size_t s1 = (size_t)tstart[e1] * 256 + p1, s2 = (size_t)tstart[e2] * 256 + p2;
    const bf16_t* Y = (const bf16_t*)(A.ws + WS_Y);
    const float* gt = (const float*)(A.ws + WS_MOD) + (size_t)(lp * 9 + row_bidx(row)) * 6144 + 5 * 1024;
#pragma unroll
    for (int j = 0; j < 4; ++j) { const u32x2 a = ((const u32x2*)(Y + s1 * 1024))[lane + 64 * j], b = ((const u32x2*)(Y + s2 * 1024))[lane + 64 * j]; const f32x4 g = ((const f32x4*)gt)[lane + 64 * j];
        v[j].x += g.x * (g1 * bflo(a.x) + g2 * bflo(b.x)); v[j].y += g.y * (g1 * bfhi(a.x) + g2 * bfhi(b.x));
        v[j].z += g.z * (g1 * bflo(a.y) + g2 * bflo(b.y)); v[j].w += g.w * (g1 * bfhi(a.y) + g2 * bfhi(b.y)); }
}
__device__ __forceinline__ void build_tstart(Frame& F, int lp) {
    LAS int* tstart = (LAS int*)(F.lds + LC_TSTART); LAS int* cnt = (LAS int*)(F.lds + LC_CNT);
    const unsigned* gcnt = (const unsigned*)(get_args()->ws + WS_CTL) + CW_GCNT + lp * 16;
    __syncthreads();
    if (F.tid == 0) { int s = 0; for (int e = 0; e < NE; ++e) { const int c = (int)__hip_atomic_load(gcnt + e, __ATOMIC_RELAXED, __HIP_MEMORY_SCOPE_AGENT); cnt[e] = c; tstart[e] = s; s += (c + 255) >> 8; } tstart[NE] = s; }
    __syncthreads();
}
__device__ __forceinline__ float row_rstd(const f32x4 (&v)[4]) {
    float ss = 0.f;
#pragma unroll
    for (int j = 0; j < 4; ++j) ss += (v[j].x * v[j].x + v[j].y * v[j].y) + (v[j].z * v[j].z + v[j].w * v[j].w);
    return 1.0f / sqrtf(wave_sum(ss) * (1.0f / D) + 1e-6f);
}
__device__ __forceinline__ void norm_mod_store(const f32x4 (&v)[4], float rstd, const float* nw, const float* sc, const float* sh, bf16_t* orow, int lane, f32x4 (*keep)[4]) {
#pragma unroll
    for (int j = 0; j < 4; ++j) { const f32x4 w = ((const f32x4*)nw)[lane + 64 * j], s = ((const f32x4*)sc)[lane + 64 * j], b = ((const f32x4*)sh)[lane + 64 * j];
        const f32x4 h = v[j] * rstd * w * (s + 1.0f) + b; if (keep) (*keep)[j] = h;
        u32x2 o; o.x = pk2(h.x, h.y); o.y = pk2(h.z, h.w); ((u32x2*)orow)[lane + 64 * j] = o; }
}
__device__ __forceinline__ void phase_prenorm(Frame& F, int l) {
    CArgs& A = *get_args();
    if (l > 0) build_tstart(F, l - 1);
    const LAS int* tstart = (const LAS int*)(F.lds + LC_TSTART);
    const float* MOD = (const float*)(A.ws + WS_MOD);
    bf16_t* XN = (bf16_t*)(A.ws + WS_XN);
    for (int row = F.gw; row < RT; row += F.NGW) {
        f32x4 v[4];
        if (l == 0) load_row(xin_row(A, row), F.lane, v);
        else { float* xr = xres_row(A, row); load_row(xr, F.lane, v); moe_combine(A, l - 1, row, F.lane, tstart, v); store_row(xr, F.lane, v); }
        const float rstd = row_rstd(v);
        const float* m = MOD + (size_t)(l * 9 + row_bidx(row)) * 6144;
        norm_mod_store(v, rstd, A.in[6] + l * D, m + 1024, m, XN + (size_t)row * D, F.lane, nullptr);
    }
}
__device__ __forceinline__ void phase_final(Frame& F) {
    CArgs& A = *get_args();
    build_tstart(F, DEPTH - 1);
    const LAS int* tstart = (const LAS int*)(F.lds + LC_TSTART);
    for (int row = RC + F.gw; row < RT; row += F.NGW) {
        f32x4 v[4]; float* xr = xres_row(A, row); load_row(xr, F.lane, v); moe_combine(A, DEPTH - 1, row, F.lane, tstart, v);
        const float rstd = row_rstd(v);
#pragma unroll
        for (int j = 0; j < 4; ++j) { const f32x4 w = ((const f32x4*)A.in[29])[F.lane + 64 * j]; v[j] = v[j] * rstd * w; }
        store_row(xr, F.lane, v);
    }
}
constexpr int RW_STRIDE = 20;
__device__ __forceinline__ void phase_router(Frame& F, int l) {
    CArgs& A = *get_args();
    __syncthreads();
    LAS float* rw = (LAS float*)F.lds;
    LAS int* lcnt = (LAS int*)(F.lds + 1024 * RW_STRIDE * 4);
    LAS int* rec = lcnt + 32;
    for (int i = F.tid; i < 1024 * 16; i += NTHR) rw[(i >> 4) * RW_STRIDE + (i & 15)] = A.in[24][i];
    if (F.tid < 32) lcnt[F.tid] = 0;
    __syncthreads();
    const float* MOD = (const float*)(A.ws + WS_MOD);
    bf16_t* FB = (bf16_t*)(A.ws + WS_XN);
    int* TOKE = (int*)(A.ws + WS_TOKE); int* TOKP = (int*)(A.ws + WS_TOKP); float* TOKG = (float*)(A.ws + WS_TOKG); int* LIST = (int*)(A.ws + WS_LIST);
    float bias[16];
#pragma unroll
    for (int e = 0; e < 16; ++e) bias[e] = A.in[25][e];
    const int row0 = (l == DEPTH - 1) ? RC : 0;
    int nrec = 0;
    for (int row = row0 + F.gw; row < RT; row += F.NGW) {
        f32x4 v[4], f[4]; load_row(xres_row(A, row), F.lane, v);
        const float rstd = row_rstd(v);
        const float* m = MOD + (size_t)(l * 9 + row_bidx(row)) * 6144;
        norm_mod_store(v, rstd, A.in[7] + l * D, m + 4 * 1024, m + 3 * 1024, FB + (size_t)row * D, F.lane, &f);
        float lg[16];
#pragma unroll
        for (int e = 0; e < 16; ++e) lg[e] = 0.f;
#pragma unroll
        for (int j = 0; j < 4; ++j)
#pragma unroll
            for (int q = 0; q < 4; ++q) { const int k = 4 * F.lane + 256 * j + q; const float fv = f[j][q]; const LAS f32x4* wr = (const LAS f32x4*)(rw + k * RW_STRIDE);
#pragma unroll
                for (int e4 = 0; e4 < 4; ++e4) { const f32x4 w = wr[e4]; lg[e4 * 4 + 0] += fv * w.x; lg[e4 * 4 + 1] += fv * w.y; lg[e4 * 4 + 2] += fv * w.z; lg[e4 * 4 + 3] += fv * w.w; } }
#pragma unroll
        for (int e = 0; e < 16; ++e) lg[e] = wave_sum(lg[e]);
        float mx = lg[0];
#pragma unroll
        for (int e = 1; e < 16; ++e) mx = fmaxf(mx, lg[e]);
        float pr[16], sel[16], ps = 0.f;
#pragma unroll
        for (int e = 0; e < 16; ++e) { pr[e] = __expf(lg[e] - mx); ps += pr[e]; }
        const float ips = 1.0f / ps;
#pragma unroll
        for (int e = 0; e < 16; ++e) { pr[e] *= ips; sel[e] = pr[e] + bias[e]; }
        int bg = 0; float bs = -INFINITY;
#pragma unroll
        for (int g = 0; g < 4; ++g) { float f1 = -INFINITY, f2 = -INFINITY;
#pragma unroll
            for (int q = 0; q < 4; ++q) { const float x = sel[g * 4 + q]; if (x > f1) { f2 = f1; f1 = x; } else if (x > f2) f2 = x; }
            const float gs = f1 + f2; if (gs > bs) { bs = gs; bg = g; } }
        float s4[4], p4[4];
#pragma unroll
        for (int q = 0; q < 4; ++q) { s4[q] = sel[q]; p4[q] = pr[q]; }
#pragma unroll
        for (int g = 1; g < 4; ++g) if (bg == g) {
#pragma unroll
            for (int q = 0; q < 4; ++q) { s4[q] = sel[g * 4 + q]; p4[q] = pr[g * 4 + q]; } }
        int i1 = 0; float b1 = s4[0], q1 = p4[0];
#pragma unroll
        for (int q = 1; q < 4; ++q) if (s4[q] > b1) { b1 = s4[q]; i1 = q; q1 = p4[q]; }
        int i2 = -1; float b2 = -INFINITY, q2 = 0.f;
#pragma unroll
        for (int q = 0; q < 4; ++q) if (q != i1 && s4[q] > b2) { b2 = s4[q]; i2 = q; q2 = p4[q]; }
        const int e1 = bg * 4 + i1, e2 = bg * 4 + i2; const float gsum = q1 + q2;
        if (F.lane == 0) {
            const int lp1 = atomicAdd((int*)(lcnt + e1), 1), lp2 = atomicAdd((int*)(lcnt + e2), 1);
            LAS int* r5 = rec + (F.wave * 20 + nrec) * 5; r5[0] = row; r5[1] = e1; r5[2] = lp1; r5[3] = e2; r5[4] = lp2;
            TOKG[row * 2] = q1 / gsum; TOKG[row * 2 + 1] = q2 / gsum;
        }
        ++nrec;
    }
    __syncthreads();
    unsigned* gcnt = (unsigned*)(A.ws + WS_CTL) + CW_GCNT + l * 16;
    if (F.tid < 16) lcnt[16 + F.tid] = (int)__hip_atomic_fetch_add(gcnt + F.tid, (unsigned)lcnt[F.tid], __ATOMIC_RELAXED, __HIP_MEMORY_SCOPE_AGENT);
    __syncthreads();
    if (F.lane == 0) for (int i = 0; i < nrec; ++i) { const LAS int* r5 = rec + (F.wave * 20 + i) * 5; const int row = r5[0], e1 = r5[1], e2 = r5[3], p1 = lcnt[16 + e1] + r5[2], p2 = lcnt[16 + e2] + r5[4];
        TOKE[row * 2] = e1; TOKE[row * 2 + 1] = e2; TOKP[row * 2] = p1; TOKP[row * 2 + 1] = p2; LIST[(size_t)e1 * RT + p1] = row; LIST[(size_t)e2 * RT + p2] = row; }
    __syncthreads();
}

__device__ __forceinline__ void phase_gemm_in(Frame& F) {
    CArgs& A = *get_args();
    pg8::DenseOrder S; S.init(RT / 256, INW / 256, F.G, (int)blockIdx.x, 0, D, A.ws + WS_WIN);
    pg8::EpiBf16 E{(bf16_t*)(A.ws + WS_Z), INW};
    pg8::gemm_phase<pg8::EpiBf16, pg8::DenseOrder, true>(F.lds, (const char*)(A.ws + WS_XN), D, S, E);
}
__device__ __forceinline__ void phase_gemm_out(Frame& F, int l) {
    CArgs& A = *get_args();
    const bool lastl = (l == DEPTH - 1);
    pg8::DenseOrder S; S.init(lastl ? RL / 256 : RT / 256, D / 256, F.G, (int)blockIdx.x, lastl ? 8 : 0, D, A.ws + WS_WOUT);
    float* xrc = (float*)(A.ws + WS_XRC);
    pg8::EpiRes E{l == 0 ? A.in[2] : xrc, l == 0 ? A.in[0] : A.out, xrc, A.out, (const float*)(A.ws + WS_MOD) + (size_t)l * 9 * 6144};
    pg8::gemm_phase<pg8::EpiRes, pg8::DenseOrder, true>(F.lds, (const char*)(A.ws + WS_XN), D, S, E);
}
__device__ __forceinline__ int build_moe_tables(Frame& F, int l, int nN, bool gather) {
    CArgs& A = *get_args();
    build_tstart(F, l);
    const LAS int* tstart = (const LAS int*)(F.lds + LC_TSTART); const LAS int* cnt = (const LAS int*)(F.lds + LC_CNT);
    LAS int* tile_e = (LAS int*)(F.lds + LC_TILE_E); LAS unsigned* rowoff = (LAS unsigned*)(F.lds + LC_ROWOFF);
    const int ntiles = tstart[NE];
    for (int t = F.tid; t < ntiles; t += NTHR) { int e = 0;
#pragma unroll
        for (int q = 1; q < NE; ++q) if (t >= tstart[q]) e = q;
        tile_e[t] = e; }
    __syncthreads();
    if (gather) {
        const int* LIST = (const int*)(A.ws + WS_LIST);
        for (int i = 0; i < 10; ++i) { const long L = (long)i * F.G + blockIdx.x; if (L >= (long)ntiles * nN) break;
            const int tile = (int)(L / nN), e = tile_e[tile], lt = tile - tstart[e];
            for (int r = F.tid; r < 256; r += NTHR) { const int j = lt * 256 + r; const int tok = j < cnt[e] ? LIST[(size_t)e * RT + j] : 0; rowoff[i * 256 + r] = (unsigned)tok * (unsigned)(D * 2); } }
        __syncthreads();
    }
    return ntiles;
}
__device__ __forceinline__ void phase_moe1(Frame& F, int l) {
    CArgs& A = *get_args();
    const int ntiles = build_moe_tables(F, l, 8, true);
    pg8::MoeOrder S{ntiles, 8, F.G, (int)blockIdx.x, D, (const char*)(A.ws + WS_W13), (size_t)2048 * D * 2, (const LAS int*)(F.lds + LC_TILE_E), (const LAS unsigned*)(F.lds + LC_ROWOFF)};
    pg8::EpiSwiGLU E{(bf16_t*)(A.ws + WS_Z)};
    pg8::gemm_phase<pg8::EpiSwiGLU, pg8::MoeOrder, true>(F.lds, (const char*)(A.ws + WS_XN), D, S, E);
}
__device__ __forceinline__ void phase_moe2(Frame& F, int l) {
    CArgs& A = *get_args();
    const int ntiles = build_moe_tables(F, l, 4, false);
    pg8::MoeOrder S{ntiles, 4, F.G, (int)blockIdx.x, D, (const char*)(A.ws + WS_W2), (size_t)D * D * 2, (const LAS int*)(F.lds + LC_TILE_E), nullptr};
    pg8::EpiBf16 E{(bf16_t*)(A.ws + WS_Y), D};
    pg8::gemm_phase<pg8::EpiBf16, pg8::MoeOrder, true>(F.lds, (const char*)(A.ws + WS_Z), D, S, E);
}

__device__ __forceinline__ int scan_row(int b, int dir, int s) {
    if (s < CTXL) { const int i = dir == 0 ? s : CTXL - 1 - s; return b * CTXL + i; }
    const int t = s - CTXL; return RC + b * SEQ + (dir == 0 ? t : SEQ - 1 - t);
}
__device__ __forceinline__ void naive_s5_item(CArgs& a, int l, int b, int g, int p) {
    const bf16_t* Z = (const bf16_t*)(a.ws + WS_Z); float* S5Y = (float*)(a.ws + WS_S5Y);
    for (int dir = 0; dir < 2; ++dir) {
        const int pg = ((l * 2 + dir) * 16 + g);
        const float are = a.in[10][pg * 64 + p], aim = a.in[11][pg * 64 + p], dt = expf(a.in[12][pg]);
        const float mag = expf(dt * are); float sn, cs; sincos_d(dt * aim, sn, cs);
        const float abr = mag * cs, abi = mag * sn, inv = 1.0f / (are * are + aim * aim);
        const float fre = ((abr - 1.0f) * are + abi * aim) * inv, fim = (abi * are - (abr - 1.0f) * aim) * inv;
        float bbr[16], bbi[16], cr[16], ci[16];
#pragma unroll
        for (int h = 0; h < 16; ++h) { const float br = a.in[13][(pg * 64 + p) * 16 + h], bi = a.in[14][(pg * 64 + p) * 16 + h];
            bbr[h] = fre * br - fim * bi; bbi[h] = fre * bi + fim * br; cr[h] = a.in[15][(pg * 16 + h) * 64 + p]; ci[h] = a.in[16][(pg * 16 + h) * 64 + p]; }
        float hr = 0.f, hi = 0.f;
        for (int s = 0; s < NPOS; ++s) {
            const int row = scan_row(b, dir, s);
            const u32x4 u0 = *(const u32x4*)(Z + (size_t)row * INW + OFF_U + g * 16), u1 = *(const u32x4*)(Z + (size_t)row * INW + OFF_U + g * 16 + 8);
            float u[16]; u[0] = bflo(u0.x); u[1] = bfhi(u0.x); u[2] = bflo(u0.y); u[3] = bfhi(u0.y); u[4] = bflo(u0.z); u[5] = bfhi(u0.z); u[6] = bflo(u0.w); u[7] = bfhi(u0.w);
            u[8] = bflo(u1.x); u[9] = bfhi(u1.x); u[10] = bflo(u1.y); u[11] = bfhi(u1.y); u[12] = bflo(u1.z); u[13] = bfhi(u1.z); u[14] = bflo(u1.w); u[15] = bfhi(u1.w);
            float sr = 0.f, si = 0.f;
#pragma unroll
            for (int h = 0; h < 16; ++h) { sr += bbr[h] * u[h]; si += bbi[h] * u[h]; }
            const float nr = abr * hr - abi * hi + sr, ni = abr * hi + abi * hr + si; hr = nr; hi = ni;
            float mine = 0.f;
#pragma unroll
            for (int h = 0; h < 16; ++h) { const float y = wave_sum(cr[h] * hr - ci[h] * hi); if (p == h) mine = y; }
            if (p < 16) { float* d = S5Y + (size_t)row * 256 + g * 16 + p; if (dir == 0) *d = mine; else *d += mine; }
        }
    }
}
__device__ __forceinline__ void naive_ret_item(CArgs& a, int l, int b, int hd, int lane) {
    const bf16_t* Z = (const bf16_t*)(a.ws + WS_Z); float* RO = (float*)(a.ws + WS_RO); const f32x2* ROT = (const f32x2*)(a.ws + WS_ROT);
    for (int dir = 0; dir < 2; ++dir) {
        const float dl = a.in[20][(l * 2 + dir) * 8 + hd];
        const float lgam = fminf(dl, 0.f) - log1pf(expf(-fabsf(dl)));
        const float gam = expf(lgam);
        float S[64];
#pragma unroll
        for (int d = 0; d < 64; ++d) S[d] = 0.f;
        for (int s = 0; s < NPOS; ++s) {
            const int row = scan_row(b, dir, s);
            const bf16_t* zr = Z + (size_t)row * INW + hd * 64;
            const float qo = bf2f(zr[OFF_Q + lane]), ko = bf2f(zr[OFF_K + lane]) * 0.125f, v = bf2f(zr[OFF_V + lane]);
            const f32x2 csn = ROT[s * 32 + (lane & 31)];
            const float qp = __shfl_xor(qo, 32), kp = __shfl_xor(ko, 32);
            const float q = lane < 32 ? qo * csn.x - qp * csn.y : qp * csn.y + qo * csn.x;
            const float k = lane < 32 ? ko * csn.x - kp * csn.y : kp * csn.y + ko * csn.x;
            float o = 0.f;
            if (dir == 0) {
#pragma unroll
                for (int d = 0; d < 64; ++d) { S[d] = gam * S[d] + __shfl(k, d) * v; o += __shfl(q, d) * S[d]; }
            } else {
#pragma unroll
                for (int d = 0; d < 64; ++d) { o += __shfl(q, d) * S[d]; S[d] = gam * S[d] + __shfl(k, d) * v; }
                o *= gam;
            }
            float* d = RO + (size_t)row * 512 + hd * 64 + lane; if (dir == 0) *d = o; else *d += o;
        }
    }
}
__device__ __forceinline__ void phase_naive_scan(Frame& F, int l) {
    if (F.wave != 0) return;
    const int i = blockIdx.x;
    if (i < 128) naive_s5_item(*get_args(), l, i >> 4, i & 15, F.lane);
    else if (i < 192) naive_ret_item(*get_args(), l, (i - 128) >> 3, (i - 128) & 7, F.lane);
}
__device__ __forceinline__ void phase_naive_out(Frame& F, int l) {
    CArgs& a = *get_args();
    LAS float* wsm = (LAS float*)(F.lds + F.wave * 2048);
    const bf16_t* Z = (const bf16_t*)(a.ws + WS_Z); bf16_t* MIX = (bf16_t*)(a.ws + WS_XN);
    const int lane = F.lane;
    for (int row = F.gw; row < RT; row += F.NGW) {
        float zz[4];
#pragma unroll
        for (int q = 0; q < 4; ++q) { const int c = lane + 64 * q; const float u = bf2f(Z[(size_t)row * INW + OFF_U + c]);
            const float y = ((const float*)(a.ws + WS_S5Y))[(size_t)row * 256 + c] + a.in[17][l * 256 + c] * u; zz[q] = gelu_tanh(y); wsm[c] = zz[q]; }
        LDS_WAIT(); asm volatile("" ::: "memory");
#pragma unroll
        for (int q = 0; q < 4; ++q) { const int c = lane + 64 * q; float s = a.in[19][l * 256 + c]; const float* W = a.in[18] + (size_t)l * 256 * 256 + c;
            for (int k = 0; k < 256; ++k) s += wsm[k] * W[k * 256];
            MIX[(size_t)row * D + c] = (bf16_t)f2bf(zz[q] * sigmoidf_(s)); }
        for (int hd = 0; hd < 8; ++hd) {
            const float o = ((const float*)(a.ws + WS_RO))[(size_t)row * 512 + hd * 64 + lane];
            const float mu = wave_sum(o) * (1.0f / 64.0f); const float dv = o - mu; const float var = wave_sum(dv * dv) * (1.0f / 64.0f);
            const float g = bf2f(Z[(size_t)row * INW + OFF_G + hd * 64 + lane]);
            MIX[(size_t)row * D + 256 + hd * 64 + lane] = (bf16_t)f2bf(dv / sqrtf(var + 1e-5f) * a.in[21][l * 512 + hd * 64 + lane] * siluf_(g));
        }
        int base, j, n;
        if (row < RC) { j = row & (CTXL - 1); base = row - j; n = CTXL; } else { const int t = (row - RC) & (SEQ - 1); j = t & 63; base = row - j; n = 64; }
        LDS_WAIT(); asm volatile("" ::: "memory");
#pragma unroll
        for (int g = 0; g < 4; ++g) { const int c = g * 64 + lane, win = 2 << g;
            int lo = j - win / 2; if (lo < 0) lo = 0; int hi = j - win / 2 + win - 1; if (hi > n - 1) hi = n - 1;
            float s = 0.f; for (int q = lo; q <= hi; ++q) s += bf2f(Z[(size_t)(base + q) * INW + OFF_P + c]);
            wsm[c] = s / (float)(hi - lo + 1) - bf2f(Z[(size_t)row * INW + OFF_P + c]); }
        LDS_WAIT(); asm volatile("" ::: "memory");
#pragma unroll
        for (int g = 0; g < 4; ++g) { const float* W = a.in[22] + ((size_t)l * 4 + g) * 64 * 64 + lane; float o = 0.f;
            for (int k = 0; k < 64; ++k) o += wsm[g * 64 + k] * W[k * 64];
            MIX[(size_t)row * D + 768 + g * 64 + lane] = (bf16_t)f2bf(o * a.in[23][l * 256 + g * 64 + lane]); }
        LDS_WAIT(); asm volatile("" ::: "memory");
    }
}

__global__ void __launch_bounds__(NTHR, 2) mk_fwd(Args args) {
    extern __shared__ __attribute__((aligned(16))) unsigned char lds_raw[];
#define MKF() Frame F; { int t_ = threadIdx.x; asm volatile("" : "+v"(t_)); F.lds = (LAS unsigned char*)lds_raw; F.tid = t_; F.lane = t_ & 63; F.wave = __builtin_amdgcn_readfirstlane(t_ >> 6); \
        F.G = gridDim.x; F.gw = blockIdx.x * NWAVES + F.wave; F.NGW = F.G * NWAVES; }
    volatile LAS unsigned* MISC = (volatile LAS unsigned*)((LAS unsigned char*)lds_raw + LC_MISC);
    if (threadIdx.x < 32) MISC[threadIdx.x] = 0u;
    __syncthreads();
    XcdBarrier bar = xcd_barrier_post((unsigned*)(get_args()->ws + WS_CTL) + CW_BAR, MISC + 8);
#define GRID_BAR() xcd_barrier(bar)
    { MKF(); phase_tables(F); phase_weights(F, 0); }
    cooperative_groups::this_grid().sync();
    for (int l = 0; l < DEPTH; ++l) {
        { MKF(); if (l > 0) phase_weights(F, l); phase_prenorm(F, l); } GRID_BAR();
        { MKF(); phase_gemm_in(F); } GRID_BAR();
        { MKF(); phase_naive_scan(F, l); } GRID_BAR();
        { MKF(); phase_naive_out(F, l); } GRID_BAR();
        { MKF(); phase_gemm_out(F, l); } GRID_BAR();
        { MKF(); phase_router(F, l); } GRID_BAR();
        { MKF(); phase_moe1(F, l); } GRID_BAR();
        { MKF(); phase_moe2(F, l); } GRID_BAR();
    }
    { MKF(); phase_final(F); }
}

extern "C" void kernel_launch(void* const* d_in, const int* in_sizes, int n_in, void* d_out, int out_size, void* d_ws, size_t ws_size, hipStream_t stream) {
    static int grid = 0;
    if (grid == 0) {
        if (n_in != 30 || out_size != RL * D || ws_size < WS_END) { fprintf(stderr, "kernel_launch: unexpected shapes (n_in %d out %d ws %zu)\n", n_in, out_size, ws_size); grid = -1; return; }
        int dev = 0, cus = 0, per_cu = 0;
        (void)hipGetDevice(&dev); (void)hipDeviceGetAttribute(&cus, hipDeviceAttributeMultiprocessorCount, dev);
        (void)hipFuncSetAttribute((const void*)mk_fwd, hipFuncAttributeMaxDynamicSharedMemorySize, LDS_BYTES);
        (void)hipOccupancyMaxActiveBlocksPerMultiprocessor(&per_cu, (const void*)mk_fwd, NTHR, LDS_BYTES);
        (void)hipGetLastError();
        if (per_cu < 1) { fprintf(stderr, "kernel_launch: occupancy query says %d blocks per CU\n", per_cu); grid = -1; return; }
        grid = cus;
        fprintf(stderr, "kernel_launch: cus %d per_cu %d grid %d ws %zu\n", cus, per_cu, grid, ws_size);
    }
    if (grid < 0) return;
    (void)hipMemsetAsync((char*)d_ws + WS_CTL, 0, CTL_BYTES, stream);
    Args a{}; for (int i = 0; i < 30; ++i) a.in[i] = (const float*)d_in[i];
    a.out = (float*)d_out; a.ws = (unsigned char*)d_ws;
    void* kargs[] = {&a};
    hipError_t e = hipLaunchCooperativeKernel((const void*)mk_fwd, dim3(grid), dim3(NTHR), kargs, LDS_BYTES, stream);
    if (e != hipSuccess) fprintf(stderr, "kernel_launch: cooperative launch failed: %s (grid %d)\n", hipGetErrorString(e), grid);
}
```

```cpp
#include <hip/hip_runtime.h>
#include <hip/hip_cooperative_groups.h>
#include <cstdio>
#include <cstdint>

#define LAS __attribute__((address_space(3)))
typedef unsigned short bf16_t;
typedef short bf16x8 __attribute__((ext_vector_type(8)));
typedef float f32x4 __attribute__((ext_vector_type(4)));
typedef float f32x2 __attribute__((ext_vector_type(2)));
typedef unsigned u32x4 __attribute__((ext_vector_type(4)));
typedef unsigned u32x2 __attribute__((ext_vector_type(2)));

constexpr int D = 1024, NB = 8, SEQ = 4096, CTXL = 256, DEPTH = 2, INW = 2560;
constexpr int RC = NB * CTXL, RL = NB * SEQ, RT = RC + RL;
constexpr int NE = 16;
constexpr int OFF_U = 0, OFF_Q = 256, OFF_K = 768, OFF_V = 1280, OFF_G = 1792, OFF_P = 2304;
constexpr int MAXTILES = 288, NPOS = CTXL + SEQ;
constexpr int NWAVES = 8, NTHR = 512;

constexpr size_t MiB = 1u << 20;
constexpr size_t WS_CTL = 0, CTL_BYTES = 1 * MiB;
constexpr size_t WS_MOD = 1 * MiB;
constexpr size_t WS_ROT = 2 * MiB;
constexpr size_t WS_TOKE = 4 * MiB;
constexpr size_t WS_TOKP = 4 * MiB + 512 * 1024;
constexpr size_t WS_TOKG = 5 * MiB;
constexpr size_t WS_LIST = 5 * MiB + 512 * 1024;
constexpr size_t WS_GLUT = 7 * MiB + 768 * 1024;
constexpr size_t WS_POOLT = 7 * MiB + 896 * 1024;
constexpr size_t WS_S5M = 8 * MiB;
constexpr size_t WS_WIN = 16 * MiB;
constexpr size_t WS_WOUT = 21 * MiB;
constexpr size_t WS_W13 = 24 * MiB;
constexpr size_t WS_W2 = 88 * MiB;
constexpr size_t WS_XN = 120 * MiB;
constexpr size_t WS_Z = 188 * MiB;
constexpr size_t WS_Y = 358 * MiB;
constexpr size_t WS_XRC = 502 * MiB;
constexpr size_t WS_END = 510 * MiB;
constexpr size_t WS_S5Y = WS_Y + 104 * MiB;
constexpr size_t WS_RO = WS_Y + 34 * MiB;
constexpr size_t WS_POOLED = WS_Y + 102 * MiB;
constexpr int CW_BAR = 4096, CW_GCNT = 8192;

__device__ __forceinline__ float wave_sum(float v) {
#pragma unroll
    for (int o = 1; o < 64; o <<= 1) v += __shfl_xor(v, o);
    return v;
}
__device__ __forceinline__ unsigned f2bf(float f) { unsigned u = __builtin_bit_cast(unsigned, f); return (u + 0x7fffu + ((u >> 16) & 1u)) >> 16; }
__device__ __forceinline__ unsigned pk2(float lo, float hi) { return f2bf(lo) | (f2bf(hi) << 16); }
__device__ __forceinline__ float bf2f(unsigned h) { return __builtin_bit_cast(float, h << 16); }
__device__ __forceinline__ float bflo(unsigned w) { return __builtin_bit_cast(float, w << 16); }
__device__ __forceinline__ float bfhi(unsigned w) { return __builtin_bit_cast(float, w & 0xffff0000u); }
__device__ __forceinline__ float sigmoidf_(float x) { return 1.0f / (1.0f + __expf(-x)); }
__device__ __forceinline__ float siluf_(float x) { return x / (1.0f + __expf(-x)); }
__device__ __forceinline__ float gelu_tanh(float x) { const float u = 0.7978845608028654f * (x + 0.044715f * x * x * x); return 0.5f * x * (1.0f + tanhf(u)); }
#define LDS_WAIT() asm volatile("s_waitcnt lgkmcnt(0)" ::: "memory")
#define VM_WAIT() asm volatile("s_waitcnt vmcnt(0)" ::: "memory")

namespace pg8 {
constexpr int BM = 256, BK = 64, HALF = 128, HTB = HALF * BK * 2, STAGE_BYTES = 8 * HTB, NXCD = 8, WGM = 8;
__host__ __device__ __forceinline__ int lds_byte(int r, int c) { const int st = (r >> 4) * 2 + (c >> 5), rr = r & 15, cc = c & 31, ob = rr * 64 + cc * 2; return st * 1024 + (ob ^ (((ob >> 9) & 1) << 5)); }
__host__ __device__ __forceinline__ void stage_rc(int b, int& R, int& C) { const int st = b / 1024, sb = b % 1024, swz = sb ^ (((sb >> 9) & 1) << 5); R = (st >> 1) * 16 + swz / 64; C = (st & 1) * 32 + (swz % 64) / 2; }
__host__ __device__ __forceinline__ int perm32(int rho) { const int n = rho >> 4, i = rho & 15; return 8 * (i >> 2) + 4 * n + (i & 3); }

struct Unit { int pm, pn, e, ui; };

__device__ __forceinline__ unsigned cvt_pk_bf16(float lo, float hi) { unsigned r; asm volatile("v_cvt_pk_bf16_f32 %0, %1, %2" : "=v"(r) : "v"(lo), "v"(hi)); return r; }

struct DenseOrder {
    int nM, nN, nwg, G, c, pm0, K; const char* Bt;
    __device__ void init(int nM_, int nN_, int G_, int c_, int pm0_, int K_, const void* Bt_) { nM = nM_; nN = nN_; nwg = nM * nN; G = G_; c = c_; pm0 = pm0_; K = K_; Bt = (const char*)Bt_; }
    __device__ bool next(int i, Unit& u) const {
        const long L = (long)i * G + c; if (L >= nwg) return false;
        int wgid = (int)L; { const int q = nwg / NXCD, r = nwg % NXCD, xcd = wgid % NXCD, off = wgid / NXCD; wgid = (xcd < r ? xcd * (q + 1) : r * (q + 1) + (xcd - r) * q) + off; }
        const int nig = WGM * nN, gid = wgid / nig, fm = gid * WGM, gsz = (nM - fm) < WGM ? (nM - fm) : WGM;
        u.pm = pm0 + fm + ((wgid % nig) % gsz); u.pn = (wgid % nig) / gsz; u.e = 0; u.ui = i; return true;
    }
    __device__ __forceinline__ void a_offs(const Unit& u, const int (&R)[2], const int (&C)[2], unsigned (&off)[2][2]) const {
#pragma unroll
        for (int h = 0; h < 2; ++h)
#pragma unroll
            for (int i = 0; i < 2; ++i) off[h][i] = (unsigned)((u.pm * BM + h * HALF + R[i]) * K + C[i]) * 2u;
    }
    __device__ __forceinline__ const char* b_ptr(const Unit& u) const { return Bt + (size_t)u.pn * BM * K * 2; }
};
struct MoeOrder {
    int ntiles, nN, G, c, K; const char* Bt; size_t bstride; const LAS int* tile_e; const LAS unsigned* rowoff;
    __device__ bool next(int i, Unit& u) const {
        const long L = (long)i * G + c; if (L >= (long)ntiles * nN) return false;
        u.pn = (int)(L % nN); u.pm = (int)(L / nN); u.e = tile_e[u.pm]; u.ui = i; return true;
    }
    __device__ __forceinline__ void a_offs(const Unit& u, const int (&R)[2], const int (&C)[2], unsigned (&off)[2][2]) const {
#pragma unroll
        for (int h = 0; h < 2; ++h)
#pragma unroll
            for (int i = 0; i < 2; ++i) off[h][i] = rowoff ? rowoff[u.ui * 256 + h * HALF + R[i]] + (unsigned)C[i] * 2u : (unsigned)((u.pm * BM + h * HALF + R[i]) * K + C[i]) * 2u;
    }
    __device__ __forceinline__ const char* b_ptr(const Unit& u) const { return Bt + (size_t)u.e * bstride + (size_t)u.pn * BM * K * 2; }
};

struct EpiBf16 {
    static constexpr bool PERM = true;
    bf16_t* O; int ldc;
    __device__ __forceinline__ void operator()(const f32x4 (&acc)[2][2][4][2], const Unit& u, int wr, int wc, int fr, int fq) const {
        const int row0 = u.pm * BM + wr * 64 + fr, col0 = u.pn * BM + wc * 32 + 8 * fq;
#pragma unroll
        for (int ai = 0; ai < 2; ++ai)
#pragma unroll
            for (int m = 0; m < 4; ++m) { bf16_t* rowp = O + (size_t)(row0 + ai * HALF + m * 16) * ldc + col0;
#pragma unroll
                for (int bj = 0; bj < 2; ++bj) { const f32x4 v0 = acc[ai][bj][m][0], v1 = acc[ai][bj][m][1];
                    u32x4 w; w.x = cvt_pk_bf16(v0[0], v0[1]); w.y = cvt_pk_bf16(v0[2], v0[3]); w.z = cvt_pk_bf16(v1[0], v1[1]); w.w = cvt_pk_bf16(v1[2], v1[3]);
                    *(u32x4*)(rowp + bj * HALF) = w; } }
    }
};
struct EpiSwiGLU {
    static constexpr bool PERM = true;
    bf16_t* O;
    __device__ __forceinline__ void operator()(const f32x4 (&acc)[2][2][4][2], const Unit& u, int wr, int wc, int fr, int fq) const {
        const int row0 = u.pm * BM + wr * 64 + fr, col0 = u.pn * HALF + wc * 32 + 8 * fq;
#pragma unroll
        for (int ai = 0; ai < 2; ++ai)
#pragma unroll
            for (int m = 0; m < 4; ++m) { bf16_t* rowp = O + (size_t)(row0 + ai * HALF + m * 16) * 1024 + col0;
                float h[8];
#pragma unroll
                for (int n = 0; n < 2; ++n)
#pragma unroll
                    for (int j = 0; j < 4; ++j) { const float a = acc[ai][0][m][n][j], b = acc[ai][1][m][n][j]; h[n * 4 + j] = a * __builtin_amdgcn_rcpf(1.0f + __builtin_amdgcn_exp2f(-1.4426950408889634f * a)) * b; }
                u32x4 w; w.x = cvt_pk_bf16(h[0], h[1]); w.y = cvt_pk_bf16(h[2], h[3]); w.z = cvt_pk_bf16(h[4], h[5]); w.w = cvt_pk_bf16(h[6], h[7]);
                *(u32x4*)rowp = w; }
    }
};
struct EpiRes {
    static constexpr bool PERM = false;
    const float* src_c; const float* src_l; float* dst_c; float* dst_l; const float* modl;
    __device__ __forceinline__ void operator()(const f32x4 (&acc)[2][2][4][2], const Unit& u, int wr, int wc, int fr, int fq) const {
        const bool isc = u.pm < 8; const int bidx = isc ? 8 : ((u.pm - 8) >> 4);
        const float* src = isc ? src_c : src_l; float* dst = isc ? dst_c : dst_l;
        const int rl0 = (isc ? u.pm * BM : (u.pm - 8) * BM) + wr * 64 + fr, col0 = u.pn * BM + wc * 32 + 4 * fq;
        const float* gate = modl + bidx * 6144 + 2048;
        f32x4 gv[2][2];
#pragma unroll
        for (int bj = 0; bj < 2; ++bj)
#pragma unroll
            for (int n = 0; n < 2; ++n) gv[bj][n] = *(const f32x4*)(gate + col0 + bj * HALF + n * 16);
#pragma unroll
        for (int ai = 0; ai < 2; ++ai)
#pragma unroll
            for (int m = 0; m < 4; ++m) { const size_t off = (size_t)(rl0 + ai * HALF + m * 16) * 1024 + col0;
#pragma unroll
                for (int bj = 0; bj < 2; ++bj)
#pragma unroll
                    for (int n = 0; n < 2; ++n) { const f32x4 s = *(const f32x4*)(src + off + bj * HALF + n * 16); *(f32x4*)(dst + off + bj * HALF + n * 16) = s + gv[bj][n] * acc[ai][bj][m][n]; } }
    }
};

template <class Epi, class Sched, bool ALIGN_EPI>
__device__ __forceinline__ void gemm_phase(LAS unsigned char* lds, const char* Abase, const int K, const Sched& S, const Epi& E) {
    int tid_ = threadIdx.x; asm volatile("" : "+v"(tid_));
    const int tid = tid_, wid = __builtin_amdgcn_readfirstlane(tid >> 6), lane = tid & 63, wr = wid >> 2, wc = wid & 3, fr = lane & 15, fq = lane >> 4;
    const int nt = K / BK;
    int Rr[2], Cc[2]; unsigned voffB[2];
#pragma unroll
    for (int i = 0; i < 2; ++i) { int R, C; stage_rc(tid * 16 + i * 8192, R, C); Rr[i] = R; Cc[i] = C; const int Rb = Epi::PERM ? ((R & ~31) + perm32(R & 31)) : R; voffB[i] = (unsigned)(Rb * K + C) * 2u; }
    const size_t kstep = (size_t)(BK * 2);
    const size_t hstepB = (size_t)HALF * K * 2;
    const unsigned ldsw = (unsigned)wid * 1024u;
    const int aoff = lds_byte(wr * 64 + fr, fq * 8), boff = lds_byte(wc * 32 + fr, fq * 8);
#define PG8_SA(b, h) (((b) * 2 + (h)) * HTB)
#define PG8_SB(b, h) ((4 + (b) * 2 + (h)) * HTB)
#define PG8_STAGE_B(bufoff, gbase) do { _Pragma("unroll") for (int _i = 0; _i < 2; ++_i) \
        __builtin_amdgcn_global_load_lds((const unsigned*)((const char*)(gbase) + voffB[_i]), (LAS unsigned*)(lds + (bufoff) + ldsw + _i * 8192), 16, 0, 0); } while (0)
#define PG8_STAGE_A(bufoff, offs, kb) do { _Pragma("unroll") for (int _i = 0; _i < 2; ++_i) \
        __builtin_amdgcn_global_load_lds((const unsigned*)(Abase + (kb) + (offs)[_i]), (LAS unsigned*)(lds + (bufoff) + ldsw + _i * 8192), 16, 0, 0); } while (0)
#define PG8_LDA(dst, b, h) do { _Pragma("unroll") for (int m = 0; m < 4; ++m) _Pragma("unroll") for (int k = 0; k < 2; ++k) dst[m][k] = *(const LAS bf16x8*)(lds + PG8_SA(b, h) + aoff + m * 2048 + k * 1024); } while (0)
#define PG8_LDB(dst, b, h) do { _Pragma("unroll") for (int n = 0; n < 2; ++n) _Pragma("unroll") for (int k = 0; k < 2; ++k) dst[n][k] = *(const LAS bf16x8*)(lds + PG8_SB(b, h) + boff + n * 2048 + k * 1024); } while (0)
#define PG8_MMA(ai, bj, At, Bt) do { __builtin_amdgcn_s_setprio(1); _Pragma("unroll") for (int m = 0; m < 4; ++m) _Pragma("unroll") for (int n = 0; n < 2; ++n) _Pragma("unroll") for (int k = 0; k < 2; ++k) \
        acc[ai][bj][m][n] = __builtin_amdgcn_mfma_f32_16x16x32_bf16(Bt[n][k], At[m][k], acc[ai][bj][m][n], 0, 0, 0); __builtin_amdgcn_s_setprio(0); } while (0)
#define PG8_WAIT_V(n) asm volatile("s_waitcnt vmcnt(" #n ")" ::: "memory")
#define PG8_WAIT_L(n) asm volatile("s_waitcnt lgkmcnt(" #n ")" ::: "memory")
#define PG8_BAR __builtin_amdgcn_s_barrier()
#define PG8_SCHED __builtin_amdgcn_sched_barrier(0)
    Unit cur, nxt; int ui = 0;
    if (!S.next(0, cur)) return;
    f32x4 acc[2][2][4][2];
#pragma unroll
    for (int a = 0; a < 2; ++a)
#pragma unroll
        for (int b = 0; b < 2; ++b)
#pragma unroll
            for (int m = 0; m < 4; ++m)
#pragma unroll
                for (int n = 0; n < 2; ++n) acc[a][b][m][n] = (f32x4){0.f, 0.f, 0.f, 0.f};
    bf16x8 At[4][2], B0[2][2], B1[2][2];
    unsigned cO[2][2], nO[2][2];
    S.a_offs(cur, Rr, Cc, cO);
    const char* cB = S.b_ptr(cur); const char* nB = cB;
    PG8_STAGE_B(PG8_SB(0, 0), cB); PG8_STAGE_B(PG8_SB(0, 1), cB + hstepB); PG8_STAGE_A(PG8_SA(0, 0), cO[0], 0); PG8_STAGE_A(PG8_SA(0, 1), cO[1], 0);
    if (wr == 1) PG8_BAR;
    PG8_WAIT_V(2); PG8_BAR;
    PG8_STAGE_B(PG8_SB(1, 0), cB + kstep); PG8_STAGE_A(PG8_SA(1, 0), cO[0], kstep); PG8_STAGE_B(PG8_SB(1, 1), cB + hstepB + kstep);
    PG8_WAIT_V(6); PG8_BAR;
    for (;;) {
        const bool has_next = S.next(ui + 1, nxt);
        if (has_next) { S.a_offs(nxt, Rr, Cc, nO); nB = S.b_ptr(nxt); }
        else { nO[0][0] = cO[0][0]; nO[0][1] = cO[0][1]; nO[1][0] = cO[1][0]; nO[1][1] = cO[1][1]; nB = cB; }
        for (int t = 0; t < nt; t += 2) {
            const bool last = (t == nt - 2);
            const size_t k1 = (size_t)(t + 1) * kstep;
            const size_t k2 = last ? (size_t)0 : (size_t)(t + 2) * kstep, k3 = k2 + kstep;
            unsigned o2[2][2];
            o2[0][0] = last ? nO[0][0] : cO[0][0]; o2[0][1] = last ? nO[0][1] : cO[0][1]; o2[1][0] = last ? nO[1][0] : cO[1][0]; o2[1][1] = last ? nO[1][1] : cO[1][1];
            const char* b2 = (last ? nB : cB) + k2; const char* b3 = b2 + kstep;
            PG8_LDB(B0, 0, 0); PG8_LDB(B1, 0, 1); PG8_SCHED; PG8_LDA(At, 0, 0); PG8_STAGE_A(PG8_SA(1, 1), cO[1], k1);
            PG8_WAIT_V(8); PG8_WAIT_L(0); PG8_BAR; PG8_MMA(0, 0, At, B0); PG8_MMA(0, 1, At, B1); PG8_BAR; PG8_SCHED;
            PG8_LDA(At, 0, 1); PG8_STAGE_B(PG8_SB(0, 0), b2); PG8_STAGE_B(PG8_SB(0, 1), b2 + hstepB); PG8_STAGE_A(PG8_SA(0, 0), o2[0], k2);
            PG8_WAIT_V(8); PG8_WAIT_L(0); PG8_BAR; PG8_MMA(1, 0, At, B0); PG8_MMA(1, 1, At, B1); PG8_BAR; PG8_SCHED;
            PG8_LDB(B0, 1, 0); PG8_LDB(B1, 1, 1); PG8_SCHED; PG8_LDA(At, 1, 0); PG8_STAGE_A(PG8_SA(0, 1), o2[1], k2);
            PG8_WAIT_V(8); PG8_WAIT_L(0); PG8_BAR; PG8_MMA(0, 0, At, B0); PG8_MMA(0, 1, At, B1); PG8_BAR; PG8_SCHED;
            PG8_LDA(At, 1, 1); PG8_STAGE_B(PG8_SB(1, 0), b3); PG8_STAGE_B(PG8_SB(1, 1), b3 + hstepB); PG8_STAGE_A(PG8_SA(1, 0), o2[0], k3);
            PG8_WAIT_V(8); PG8_WAIT_L(0); PG8_BAR; PG8_MMA(1, 0, At, B0); PG8_MMA(1, 1, At, B1); PG8_BAR; PG8_SCHED;
        }
        if constexpr (ALIGN_EPI) { if (wr == 0) PG8_BAR; }
        E(acc, cur, wr, wc, fr, fq);
        if (!has_next) break;
#pragma unroll
        for (int a = 0; a < 2; ++a)
#pragma unroll
            for (int b = 0; b < 2; ++b)
#pragma unroll
                for (int m = 0; m < 4; ++m)
#pragma unroll
                    for (int n = 0; n < 2; ++n) acc[a][b][m][n] = (f32x4){0.f, 0.f, 0.f, 0.f};
        cur = nxt; cB = nB; cO[0][0] = nO[0][0]; cO[0][1] = nO[0][1]; cO[1][0] = nO[1][0]; cO[1][1] = nO[1][1]; ++ui;
        if constexpr (ALIGN_EPI) { if (wr == 1) PG8_BAR; }
    }
    PG8_WAIT_V(0);
    if constexpr (!ALIGN_EPI) { if (wr == 0) PG8_BAR; }
    PG8_BAR;
#undef PG8_SA
#undef PG8_SB
#undef PG8_STAGE_A
#undef PG8_STAGE_B
#undef PG8_LDA
#undef PG8_LDB
#undef PG8_MMA
#undef PG8_WAIT_V
#undef PG8_WAIT_L
#undef PG8_BAR
#undef PG8_SCHED
}
}


#define XB_TMO      128
#define XB_XCNT(j)  (256  + 64 * (j))
#define XB_XSUB(j)  (1280 + 64 * (j))
#define XB_XGEN(j)  (2304 + 64 * (j))
#define XB_TOP      3328
#define XB_TOPGEN   3392
#define XCD_BAR_WORDS 3456
#define XB_SPIN_CAP (1u << 22)
__device__ __forceinline__ unsigned xb_ld(unsigned* p)              { return __hip_atomic_load(p, __ATOMIC_RELAXED, __HIP_MEMORY_SCOPE_AGENT); }
__device__ __forceinline__ unsigned xb_add(unsigned* p, unsigned v) { return __hip_atomic_fetch_add(p, v, __ATOMIC_RELAXED, __HIP_MEMORY_SCOPE_AGENT); }
__device__ __forceinline__ unsigned xb_xcc_id() { return (unsigned)__builtin_amdgcn_s_getreg((3 << 11) | 20) & 0xFu; }
#define XB_SPIN(cond, bar) do { unsigned _sp = 0; while (cond) { __builtin_amdgcn_s_sleep(1); \
    if ((++_sp & 255u) == 0u) { if (xb_ld(&(bar)[XB_TMO])) break; if (_sp > XB_SPIN_CAP) { atomicAdd(&(bar)[XB_TMO], 1u); break; } } } } while (0)
struct XcdBarrier { unsigned* bar; unsigned x; volatile LAS unsigned* st; };
__device__ __forceinline__ XcdBarrier xcd_barrier_post(unsigned* bar, volatile LAS unsigned* st) {
    XcdBarrier b; b.bar = bar; b.x = xb_xcc_id(); b.st = st;
    if (threadIdx.x == 0) (void)xb_add(&bar[XB_XCNT(b.x)], 1u);
    return b;
}
__device__ __forceinline__ void xcd_barrier_complete(unsigned* bar, unsigned x, unsigned& nloc, unsigned& nx) {
    const unsigned G = gridDim.x * gridDim.y * gridDim.z;
    unsigned sum, cnt, mine, sp = 0u;
    for (;;) {
        sum = 0u; cnt = 0u; mine = 0u;
#pragma unroll
        for (unsigned j = 0; j < 16; ++j) { const unsigned c = xb_ld(&bar[XB_XCNT(j)]); sum += c; cnt += (c > 0u) ? 1u : 0u; mine = (j == x) ? c : mine; }
        if (sum == G) break;
        __builtin_amdgcn_s_sleep(1);
        if ((++sp & 255u) == 0u) { if (xb_ld(&bar[XB_TMO])) break; if (sp > XB_SPIN_CAP) { atomicAdd(&bar[XB_TMO], 1u); break; } }
    }
    nloc = mine > 0u ? mine : 1u; nx = cnt > 0u ? cnt : 1u;
}
__device__ __forceinline__ void xcd_barrier(const XcdBarrier& b) {
    asm volatile("s_waitcnt vmcnt(0)" ::: "memory");
    __syncthreads();
    if (threadIdx.x == 0) {
        unsigned* bar = b.bar;
        __builtin_amdgcn_s_waitcnt(0);
        unsigned nloc = b.st[0], nx = b.st[1];
        if (nloc == 0u) { xcd_barrier_complete(bar, b.x, nloc, nx); b.st[0] = nloc; b.st[1] = nx; }
        const unsigned old = xb_add(&bar[XB_XSUB(b.x)], 1u);
        const unsigned gen = old / nloc;
        if (old + 1u == (gen + 1u) * nloc) {
            __builtin_amdgcn_fence(__ATOMIC_RELEASE, "agent");
            asm volatile("s_waitcnt vmcnt(0)" ::: "memory");
            const unsigned og = xb_add(&bar[XB_TOP], 1u);
            const unsigned tg = og / nx;
            if (og + 1u == (tg + 1u) * nx) xb_add(&bar[XB_TOPGEN], 1u);
            else XB_SPIN(xb_ld(&bar[XB_TOPGEN]) == tg, bar);
            __builtin_amdgcn_fence(__ATOMIC_ACQUIRE, "agent");
            xb_add(&bar[XB_XGEN(b.x)], 1u);
            asm volatile("s_waitcnt vmcnt(0)" ::: "memory");
        } else {
            XB_SPIN(xb_ld(&bar[XB_XGEN(b.x)]) == gen, bar);
            __builtin_amdgcn_fence(__ATOMIC_ACQUIRE, "agent");
            asm volatile("s_waitcnt vmcnt(0)" ::: "memory");
        }
    }
    __syncthreads();
}

constexpr int RING_BYTES = 131072;
constexpr int LC_TILE_E = RING_BYTES;
constexpr int LC_TSTART = LC_TILE_E + 1280;
constexpr int LC_CNT = LC_TSTART + 128;
constexpr int LC_MISC = LC_CNT + 64;
constexpr int LC_ROWOFF = LC_MISC + 128;
constexpr int LDS_BYTES = 147456;
static_assert(LC_ROWOFF + 10 * 256 * 4 <= LDS_BYTES, "LDS map");

struct Args { const float* in[30]; float* out; unsigned char* ws; };
typedef const __attribute__((address_space(4))) Args CArgs;
__device__ __forceinline__ CArgs* get_args() { CArgs* p = (CArgs*)__builtin_amdgcn_kernarg_segment_ptr(); asm volatile("" : "+s"(p)); return p; }

struct Frame {
    LAS unsigned char* lds; int tid, lane, wave, G, gw, NGW;
};

__device__ __forceinline__ float* xres_row(CArgs& A, int row) { return row < RC ? (float*)(A.ws + WS_XRC) + (size_t)row * D : A.out + (size_t)(row - RC) * D; }
__device__ __forceinline__ const float* xin_row(CArgs& A, int row) { return row < RC ? A.in[2] + (size_t)row * D : A.in[0] + (size_t)(row - RC) * D; }
__device__ __forceinline__ int row_bidx(int row) { return row < RC ? 8 : ((row - RC) >> 12); }

__device__ __forceinline__ void sincos_d(float ang, float& s, float& c) { const double a = (double)ang; s = (float)sin(a); c = (float)cos(a); }

__device__ __forceinline__ void transpose_item(const float* W, int N, int Kdst, bf16_t* WT, int k0, int n0, int drow0, LAS float* scr, int lane) {
#pragma unroll 8
    for (int i = 0; i < 32; ++i) { const int kk = 2 * i + (lane >> 5); scr[kk * 33 + (lane & 31)] = W[(size_t)(k0 + kk) * N + n0 + (lane & 31)]; }
    LDS_WAIT(); asm volatile("" ::: "memory");
    const int c = lane & 7;
#pragma unroll
    for (int j = 0; j < 4; ++j) { const int n = (lane >> 3) + 8 * j; const LAS float* s = scr + (8 * c) * 33 + n;
        u32x4 o; o.x = pk2(s[0 * 33], s[1 * 33]); o.y = pk2(s[2 * 33], s[3 * 33]); o.z = pk2(s[4 * 33], s[5 * 33]); o.w = pk2(s[6 * 33], s[7 * 33]);
        *(u32x4*)(WT + (size_t)(drow0 + n) * Kdst + k0 + 8 * c) = o; }
    LDS_WAIT(); asm volatile("" ::: "memory");
}
__device__ __forceinline__ void phase_weights(Frame& F, int l) {
    CArgs& A = *get_args();
    LAS float* scr = (LAS float*)(F.lds + F.wave * 16384);
    unsigned char* ws = A.ws;
    constexpr int I_IN = 16 * 80, I_OUT = 16 * 32, I_E = 16 * 32, I_GLU = 4 * 8, I_POOL = 8;
    constexpr int NITEMS = I_IN + I_OUT + NE * 3 * I_E + I_GLU + I_POOL;
    for (int it = F.gw; it < NITEMS; it += F.NGW) {
        int r = it;
        if (r < I_IN) { const int kb = r / 80, nb = r % 80; transpose_item(A.in[8] + (size_t)l * D * INW, INW, D, (bf16_t*)(ws + WS_WIN), 64 * kb, 32 * nb, 32 * nb, scr, F.lane); continue; } r -= I_IN;
        if (r < I_OUT) { const int kb = r / 32, nb = r % 32; transpose_item(A.in[9] + (size_t)l * D * D, D, D, (bf16_t*)(ws + WS_WOUT), 64 * kb, 32 * nb, 32 * nb, scr, F.lane); continue; } r -= I_OUT;
        if (r < NE * 3 * I_E) { const int e = r / (3 * I_E), q = (r % (3 * I_E)) / I_E, s = r % I_E, kb = s / 32, nb = s % 32, n0 = 32 * nb;
            const size_t wo = ((size_t)l * NE + e) * D * D;
            if (q == 0) transpose_item(A.in[26] + wo, D, D, (bf16_t*)(ws + WS_W13) + (size_t)e * 2048 * D, 64 * kb, n0, 256 * (n0 >> 7) + (n0 & 127), scr, F.lane);
            else if (q == 1) transpose_item(A.in[27] + wo, D, D, (bf16_t*)(ws + WS_W13) + (size_t)e * 2048 * D, 64 * kb, n0, 256 * (n0 >> 7) + 128 + (n0 & 127), scr, F.lane);
            else transpose_item(A.in[28] + wo, D, D, (bf16_t*)(ws + WS_W2) + (size_t)e * D * D, 64 * kb, n0, n0, scr, F.lane);
            continue; } r -= NE * 3 * I_E;
        if (r < I_GLU) { const int kb = r / 8, nb = r % 8; transpose_item(A.in[18] + (size_t)l * 256 * 256, 256, 256, (bf16_t*)(ws + WS_GLUT), 64 * kb, 32 * nb, 32 * nb, scr, F.lane); continue; } r -= I_GLU;
        { const int g = r / 2, nb = r % 2; transpose_item(A.in[22] + ((size_t)l * 4 + g) * 64 * 64, 64, 64, (bf16_t*)(ws + WS_POOLT) + g * 64 * 64, 0, 32 * nb, 32 * nb, scr, F.lane); }
    }
    __syncthreads();
}
__device__ __forceinline__ void phase_tables(Frame& F) {
    CArgs& A = *get_args();
    __syncthreads();
    LAS float* sc = (LAS float*)F.lds;
    LAS float* part = (LAS float*)(F.lds + 40960);
    float* MOD = (float*)(A.ws + WS_MOD);
    if ((int)blockIdx.x < 192) {
        for (int i = F.tid; i < 9 * 1024; i += NTHR) { const int r = i >> 10, k = i & 1023; const float v = r < 8 ? A.in[1][r * 1024 + k] : A.in[3][k]; sc[i] = siluf_(v); }
        __syncthreads();
        for (int it = blockIdx.x; it < 192; it += F.G) {
            const int l = it / 96, cg = it % 96, col = F.tid & 63, ks = F.tid >> 6;
            const float* W = A.in[4] + (size_t)l * D * 6144 + cg * 64 + col;
            float acc[9];
#pragma unroll
            for (int r = 0; r < 9; ++r) acc[r] = 0.f;
            for (int kk = 0; kk < 128; ++kk) { const int k = ks * 128 + kk; const float w = W[(size_t)k * 6144];
#pragma unroll
                for (int r = 0; r < 9; ++r) acc[r] += sc[r * 1024 + k] * w; }
#pragma unroll
            for (int r = 0; r < 9; ++r) part[(ks * 9 + r) * 64 + col] = acc[r];
            __syncthreads();
            for (int idx = F.tid; idx < 576; idx += NTHR) { const int r = idx >> 6, c = idx & 63; float s = A.in[5][l * 6144 + cg * 64 + c];
#pragma unroll
                for (int k8 = 0; k8 < 8; ++k8) s += part[(k8 * 9 + r) * 64 + c];
                MOD[(l * 9 + r) * 6144 + cg * 64 + c] = s; }
            __syncthreads();
        }
    }
    f32x2* ROT = (f32x2*)(A.ws + WS_ROT);
    for (int idx = blockIdx.x * NTHR + F.tid; idx < NPOS * 32; idx += F.G * NTHR) {
        const int pos = idx >> 5, i = idx & 31; const float inv = powf(10000.0f, -(float)i / 32.0f); const float ang = (float)pos * inv; float s, c; sincos_d(ang, s, c); ROT[idx] = (f32x2){c, s};
    }
    __syncthreads();
}

struct RowComb { float g1, g2; const bf16_t* y1; const bf16_t* y2; };
__device__ __forceinline__ void load_row(const float* p, int lane, f32x4 (&v)[4]) {
#pragma unroll
    for (int j = 0; j < 4; ++j) v[j] = ((const f32x4*)p)[lane + 64 * j];
}
__device__ __forceinline__ void store_row(float* p, int lane, const f32x4 (&v)[4]) {
#pragma unroll
    for (int j = 0; j < 4; ++j) ((f32x4*)p)[lane + 64 * j] = v[j];
}
__device__ __forceinline__ void moe_combine(CArgs& A, int lp, int row, int lane, const LAS int* tstart, f32x4 (&v)[4]) {
    const int* TOKE = (const int*)(A.ws + WS_TOKE); const int* TOKP = (const int*)(A.ws + WS_TOKP); const float* TOKG = (const float*)(A.ws + WS_TOKG);
    const int e1 = TOKE[row * 2], e2 = TOKE[row * 2 + 1], p1 = TOKP[row * 2], p2 = TOKP[row * 2 + 1];
    const float g1 = TOKG[row * 2], g2 = TOKG[row * 2 + 1];
    const size_t s1 = (size_t)tstart[e1] * 256 + p1, s2 = (size_t)tstart[e2] * 256 + p2;
    const bf16_t* Y = (const bf16_t*)(A.ws + WS_Y);
    const float* gt = (const float*)(A.ws + WS_MOD) + (size_t)(lp * 9 + row_bidx(row)) * 6144 + 5 * 1024;
#pragma unroll
    for (int j = 0; j < 4; ++j) { const u32x2 a = ((const u32x2*)(Y + s1 * 1024))[lane + 64 * j], b = ((const u32x2*)(Y + s2 * 1024))[lane + 64 * j]; const f32x4 g = ((const f32x4*)gt)[lane + 64 * j];
        v[j].x += g.x * (g1 * bflo(a.x) + g2 * bflo(b.x)); v[j].y += g.y * (g1 * bfhi(a.x) + g2 * bfhi(b.x));
        v[j].z += g.z * (g1 * bflo(a.y) + g2 * bflo(b.y)); v[j].w += g.w * (g1 * bfhi(a.y) + g2 * bfhi(b.y)); }
}
__device__ __forceinline__ void build_tstart(Frame& F, int lp) {
    LAS int* tstart = (LAS int*)(F.lds + LC_TSTART); LAS int* cnt = (LAS int*)(F.lds + LC_CNT);
    const unsigned* gcnt = (const unsigned*)(get_args()->ws + WS_CTL) + CW_GCNT + lp * 16;
    __syncthreads();
    if (F.tid == 0) { int s = 0; for (int e = 0; e < NE; ++e) { const int c = (int)__hip_atomic_load(gcnt + e, __ATOMIC_RELAXED, __HIP_MEMORY_SCOPE_AGENT); cnt[e] = c; tstart[e] = s; s += (c + 255) >> 8; } tstart[NE] = s; }
    __syncthreads();
}
__device__ __forceinline__ float row_rstd(const f32x4 (&v)[4]) {
    float ss = 0.f;
#pragma unroll
    for (int j = 0; j < 4; ++j) ss += (v[j].x * v[j].x + v[j].y * v[j].y) + (v[j].z * v[j].z + v[j].w * v[j].w);
    return 1.0f / sqrtf(wave_sum(ss) * (1.0f / D) + 1e-6f);
}
__device__ __forceinline__ void norm_mod_store(const f32x4 (&v)[4], float rstd, const float* nw, const float* sc, const float* sh, bf16_t* orow, int lane, f32x4 (*keep)[4]) {
#pragma unroll
    for (int j = 0; j < 4; ++j) { const f32x4 w = ((const f32x4*)nw)[lane + 64 * j], s = ((const f32x4*)sc)[lane + 64 * j], b = ((const f32x4*)sh)[lane + 64 * j];
        const f32x4 h = v[j] * rstd * w * (s + 1.0f) + b; if (keep) (*keep)[j] = h;
        u32x2 o; o.x = pk2(h.x, h.y); o.y = pk2(h.z, h.w); ((u32x2*)orow)[lane + 64 * j] = o; }
}
__device__ __forceinline__ void phase_prenorm(Frame& F, int l) {
    CArgs& A = *get_args();
    if (l > 0) build_tstart(F, l - 1);
    const LAS int* tstart = (const LAS int*)(F.lds + LC_TSTART);
    const float* MOD = (const float*)(A.ws + WS_MOD);
    bf16_t* XN = (bf16_t*)(A.ws + WS_XN);
    for (int row = F.gw; row < RT; row += F.NGW) {
        f32x4 v[4];
        if (l == 0) load_row(xin_row(A, row), F.lane, v);
        else { float* xr = xres_row(A, row); load_row(xr, F.lane, v); moe_combine(A, l - 1, row, F.lane, tstart, v); store_row(xr, F.lane, v); }
        const float rstd = row_rstd(v);
        const float* m = MOD + (size_t)(l * 9 + row_bidx(row)) * 6144;
        norm_mod_store(v, rstd, A.in[6] + l * D, m + 1024, m, XN + (size_t)row * D, F.lane, nullptr);
    }
}
__device__ __forceinline__ void phase_final(Frame& F) {
    CArgs& A = *get_args();
    build_tstart(F, DEPTH - 1);
    const LAS int* tstart = (const LAS int*)(F.lds + LC_TSTART);
    for (int row = RC + F.gw; row < RT; row += F.NGW) {
        f32x4 v[4]; float* xr = xres_row(A, row); load_row(xr, F.lane, v); moe_combine(A, DEPTH - 1, row, F.lane, tstart, v);
        const float rstd = row_rstd(v);
#pragma unroll
        for (int j = 0; j < 4; ++j) { const f32x4 w = ((const f32x4*)A.in[29])[F.lane + 64 * j]; v[j] = v[j] * rstd * w; }
        store_row(xr, F.lane, v);
    }
}
constexpr int RW_STRIDE = 20;
__device__ __forceinline__ void phase_router(Frame& F, int l) {
    CArgs& A = *get_args();
    __syncthreads();
    LAS float* rw = (LAS float*)F.lds;
    LAS int* lcnt = (LAS int*)(F.lds + 1024 * RW_STRIDE * 4);
    LAS int* rec = lcnt + 32;
    for (int i = F.tid; i < 1024 * 16; i += NTHR) rw[(i >> 4) * RW_STRIDE + (i & 15)] = A.in[24][i];
    if (F.tid < 32) lcnt[F.tid] = 0;
    __syncthreads();
    const float* MOD = (const float*)(A.ws + WS_MOD);
    bf16_t* FB = (bf16_t*)(A.ws + WS_XN);
    int* TOKE = (int*)(A.ws + WS_TOKE); int* TOKP = (int*)(A.ws + WS_TOKP); float* TOKG = (float*)(A.ws + WS_TOKG); int* LIST = (int*)(A.ws + WS_LIST);
    float bias[16];
#pragma unroll
    for (int e = 0; e < 16; ++e) bias[e] = A.in[25][e];
    const int row0 = (l == DEPTH - 1) ? RC : 0;
    int nrec = 0;
    for (int row = row0 + F.gw; row < RT; row += F.NGW) {
        f32x4 v[4], f[4]; load_row(xres_row(A, row), F.lane, v);
        const float rstd = row_rstd(v);
        const float* m = MOD + (size_t)(l * 9 + row_bidx(row)) * 6144;
        norm_mod_store(v, rstd, A.in[7] + l * D, m + 4 * 1024, m + 3 * 1024, FB + (size_t)row * D, F.lane, &f);
        float lg[16];
#pragma unroll
        for (int e = 0; e < 16; ++e) lg[e] = 0.f;
#pragma unroll
        for (int j = 0; j < 4; ++j)
#pragma unroll
            for (int q = 0; q < 4; ++q) { const int k = 4 * F.lane + 256 * j + q; const float fv = f[j][q]; const LAS f32x4* wr = (const LAS f32x4*)(rw + k * RW_STRIDE);
#pragma unroll
                for (int e4 = 0; e4 < 4; ++e4) { const f32x4 w = wr[e4]; lg[e4 * 4 + 0] += fv * w.x; lg[e4 * 4 + 1] += fv * w.y; lg[e4 * 4 + 2] += fv * w.z; lg[e4 * 4 + 3] += fv * w.w; } }
#pragma unroll
        for (int e = 0; e < 16; ++e) lg[e] = wave_sum(lg[e]);
        float mx = lg[0];
#pragma unroll
        for (int e = 1; e < 16; ++e) mx = fmaxf(mx, lg[e]);
        float pr[16], sel[16], ps = 0.f;
#pragma unroll
        for (int e = 0; e < 16; ++e) { pr[e] = __expf(lg[e] - mx); ps += pr[e]; }
        const float ips = 1.0f / ps;
#pragma unroll
        for (int e = 0; e < 16; ++e) { pr[e] *= ips; sel[e] = pr[e] + bias[e]; }
        int bg = 0; float bs = -INFINITY;
#pragma unroll
        for (int g = 0; g < 4; ++g) { float f1 = -INFINITY, f2 = -INFINITY;
#pragma unroll
            for (int q = 0; q < 4; ++q) { const float x = sel[g * 4 + q]; if (x > f1) { f2 = f1; f1 = x; } else if (x > f2) f2 = x; }
            const float gs = f1 + f2; if (gs > bs) { bs = gs; bg = g; } }
        float s4[4], p4[4];
#pragma unroll
        for (int q = 0; q < 4; ++q) { s4[q] = sel[q]; p4[q] = pr[q]; }
#pragma unroll
        for (int g = 1; g < 4; ++g) if (bg == g) {
#pragma unroll
            for (int q = 0; q < 4; ++q) { s4[q] = sel[g * 4 + q]; p4[q] = pr[g * 4 + q]; } }
        int i1 = 0; float b1 = s4[0], q1 = p4[0];
#pragma unroll
        for (int q = 1; q < 4; ++q) if (s4[q] > b1) { b1 = s4[q]; i1 = q; q1 = p4[q]; }
        int i2 = -1; float b2 = -INFINITY, q2 = 0.f;
#pragma unroll
        for (int q = 0; q < 4; ++q) if (q != i1 && s4[q] > b2) { b2 = s4[q]; i2 = q; q2 = p4[q]; }
        const int e1 = bg * 4 + i1, e2 = bg * 4 + i2; const float gsum = q1 + q2;
        if (F.lane == 0) {
            const int lp1 = atomicAdd((int*)(lcnt + e1), 1), lp2 = atomicAdd((int*)(lcnt + e2), 1);
            LAS int* r5 = rec + (F.wave * 20 + nrec) * 5; r5[0] = row; r5[1] = e1; r5[2] = lp1; r5[3] = e2; r5[4] = lp2;
            TOKG[row * 2] = q1 / gsum; TOKG[row * 2 + 1] = q2 / gsum;
        }
        ++nrec;
    }
    __syncthreads();
    unsigned* gcnt = (unsigned*)(A.ws + WS_CTL) + CW_GCNT + l * 16;
    if (F.tid < 16) lcnt[16 + F.tid] = (int)__hip_atomic_fetch_add(gcnt + F.tid, (unsigned)lcnt[F.tid], __ATOMIC_RELAXED, __HIP_MEMORY_SCOPE_AGENT);
    __syncthreads();
    if (F.lane == 0) for (int i = 0; i < nrec; ++i) { const LAS int* r5 = rec + (F.wave * 20 + i) * 5; const int row = r5[0], e1 = r5[1], e2 = r5[3], p1 = lcnt[16 + e1] + r5[2], p2 = lcnt[16 + e2] + r5[4];
        TOKE[row * 2] = e1; TOKE[row * 2 + 1] = e2; TOKP[row * 2] = p1; TOKP[row * 2 + 1] = p2; LIST[(size_t)e1 * RT + p1] = row; LIST[(size_t)e2 * RT + p2] = row; }
    __syncthreads();
}

__device__ __forceinline__ void phase_gemm_in(Frame& F) {
    CArgs& A = *get_args();
    pg8::DenseOrder S; S.init(RT / 256, INW / 256, F.G, (int)blockIdx.x, 0, D, A.ws + WS_WIN);
    pg8::EpiBf16 E{(bf16_t*)(A.ws + WS_Z), INW};
    pg8::gemm_phase<pg8::EpiBf16, pg8::DenseOrder, true>(F.lds, (const char*)(A.ws + WS_XN), D, S, E);
}
__device__ __forceinline__ void phase_gemm_out(Frame& F, int l) {
    CArgs& A = *get_args();
    const bool lastl = (l == DEPTH - 1);
    pg8::DenseOrder S; S.init(lastl ? RL / 256 : RT / 256, D / 256, F.G, (int)blockIdx.x, lastl ? 8 : 0, D, A.ws + WS_WOUT);
    float* xrc = (float*)(A.ws + WS_XRC);
    pg8::EpiRes E{l == 0 ? A.in[2] : xrc, l == 0 ? A.in[0] : A.out, xrc, A.out, (const float*)(A.ws + WS_MOD) + (size_t)l * 9 * 6144};
    pg8::gemm_phase<pg8::EpiRes, pg8::DenseOrder, true>(F.lds, (const char*)(A.ws + WS_XN), D, S, E);
}
__device__ __forceinline__ int build_moe_tables(Frame& F, int l, int nN, bool gather) {
    CArgs& A = *get_args();
    build_tstart(F, l);
    const LAS int* tstart = (const LAS int*)(F.lds + LC_TSTART); const LAS int* cnt = (const LAS int*)(F.lds + LC_CNT);
    LAS int* tile_e = (LAS int*)(F.lds + LC_TILE_E); LAS unsigned* rowoff = (LAS unsigned*)(F.lds + LC_ROWOFF);
    const int ntiles = tstart[NE];
    for (int t = F.tid; t < ntiles; t += NTHR) { int e = 0;
#pragma unroll
        for (int q = 1; q < NE; ++q) if (t >= tstart[q]) e = q;
        tile_e[t] = e; }
    __syncthreads();
    if (gather) {
        const int* LIST = (const int*)(A.ws + WS_LIST);
        for (int i = 0; i < 10; ++i) { const long L = (long)i * F.G + blockIdx.x; if (L >= (long)ntiles * nN) break;
            const int tile = (int)(L / nN), e = tile_e[tile], lt = tile - tstart[e];
            for (int r = F.tid; r < 256; r += NTHR) { const int j = lt * 256 + r; const int tok = j < cnt[e] ? LIST[(size_t)e * RT + j] : 0; rowoff[i * 256 + r] = (unsigned)tok * (unsigned)(D * 2); } }
        __syncthreads();
    }
    return ntiles;
}
__device__ __forceinline__ void phase_moe1(Frame& F, int l) {
    CArgs& A = *get_args();
    const int ntiles = build_moe_tables(F, l, 8, true);
    pg8::MoeOrder S{ntiles, 8, F.G, (int)blockIdx.x, D, (const char*)(A.ws + WS_W13), (size_t)2048 * D * 2, (const LAS int*)(F.lds + LC_TILE_E), (const LAS unsigned*)(F.lds + LC_ROWOFF)};
    pg8::EpiSwiGLU E{(bf16_t*)(A.ws + WS_Z)};
    pg8::gemm_phase<pg8::EpiSwiGLU, pg8::MoeOrder, true>(F.lds, (const char*)(A.ws + WS_XN), D, S, E);
}
__device__ __forceinline__ void phase_moe2(Frame& F, int l) {
    CArgs& A = *get_args();
    const int ntiles = build_moe_tables(F, l, 4, false);
    pg8::MoeOrder S{ntiles, 4, F.G, (int)blockIdx.x, D, (const char*)(A.ws + WS_W2), (size_t)D * D * 2, (const LAS int*)(F.lds + LC_TILE_E), nullptr};
    pg8::EpiBf16 E{(bf16_t*)(A.ws + WS_Y), D};
    pg8::gemm_phase<pg8::EpiBf16, pg8::MoeOrder, true>(F.lds, (const char*)(A.ws + WS_Z), D, S, E);
}

constexpr bool FAST_POOL = true, FAST_RET = true, FAST_S5 = true;
constexpr size_t WS_KV = WS_Y;
constexpr size_t WS_HLOC = WS_Y + 68 * MiB;
constexpr size_t WS_HIN = WS_Y + 104 * MiB;
constexpr size_t WS_S5W1 = WS_S5M;
constexpr size_t WS_S5W2 = WS_S5M + 2 * MiB;
constexpr int S5T = 16, NCR = RT / S5T;
constexpr int NCH = 34;

__device__ __forceinline__ f32x4 mfma16(bf16x8 nside, bf16x8 mside, f32x4 acc) { return __builtin_amdgcn_mfma_f32_16x16x32_bf16(nside, mside, acc, 0, 0, 0); }
__device__ __forceinline__ bf16x8 ldfrag(const LAS bf16_t* base, int ld, int k0, int lane) { return *(const LAS bf16x8*)(base + (lane & 15) * ld + k0 + 8 * (lane >> 4)); }
__device__ __forceinline__ bf16x8 gfrag(const bf16_t* base, size_t ld, int k0, int lane) { return *(const bf16x8*)(base + (size_t)(lane & 15) * ld + k0 + 8 * (lane >> 4)); }
__device__ __forceinline__ float log2_gamma(CArgs& A, int l, int dir, int hd) { const float dl = A.in[20][(l * 2 + dir) * 8 + hd]; return (fminf(dl, 0.f) - log1pf(expf(-fabsf(dl)))) * 1.4426950408889634f; }
__device__ __forceinline__ int ret_row0(int b, int c) { return c < 2 ? b * CTXL + 128 * c : RC + b * SEQ + 128 * (c - 2); }
__device__ __forceinline__ int ret_pos0(int c) { return c < 2 ? 128 * c : CTXL + 128 * (c - 2); }
__device__ __forceinline__ void unpack8(u32x4 w, float (&f)[8]) { f[0] = bflo(w.x); f[1] = bfhi(w.x); f[2] = bflo(w.y); f[3] = bfhi(w.y); f[4] = bflo(w.z); f[5] = bfhi(w.z); f[6] = bflo(w.w); f[7] = bfhi(w.w); }

__device__ __forceinline__ void pool_item(Frame& F, CArgs& A, int l, int rowbase, int j0, int n) {
    LAS bf16_t* Ps = (LAS bf16_t*)F.lds;
    LAS bf16_t* Pl = (LAS bf16_t*)(F.lds + 40960);
    const bf16_t* Z = (const bf16_t*)(A.ws + WS_Z);
    __syncthreads();
    for (int idx = F.tid; idx < 80 * 32; idx += NTHR) { const int r = idx >> 5, ch = idx & 31, jj = j0 - 8 + r;
        u32x4 v = (u32x4){0u, 0u, 0u, 0u}; if (jj >= 0 && jj < n) v = *(const u32x4*)(Z + (size_t)(rowbase + jj) * INW + OFF_P + ch * 8);
        *(LAS u32x4*)(Ps + r * 256 + ch * 8) = v; }
    __syncthreads();
    { const int t = F.tid >> 3, cb = (F.tid & 7) * 32, j = j0 + t, g = cb >> 6, win = 2 << g;
        int lo = j - win / 2; if (lo < 0) lo = 0; int hi = j - win / 2 + win - 1; if (hi > n - 1) hi = n - 1;
        const float inv = 1.0f / (float)(hi - lo + 1);
#pragma unroll
        for (int c8 = 0; c8 < 4; ++c8) { float s[8];
#pragma unroll
            for (int e = 0; e < 8; ++e) s[e] = 0.f;
            for (int q = lo; q <= hi; ++q) { float f[8]; unpack8(*(const LAS u32x4*)(Ps + (q - j0 + 8) * 256 + cb + c8 * 8), f);
#pragma unroll
                for (int e = 0; e < 8; ++e) s[e] += f[e]; }
            float f0[8]; unpack8(*(const LAS u32x4*)(Ps + (t + 8) * 256 + cb + c8 * 8), f0);
            u32x4 o; o.x = pk2(s[0] * inv - f0[0], s[1] * inv - f0[1]); o.y = pk2(s[2] * inv - f0[2], s[3] * inv - f0[3]); o.z = pk2(s[4] * inv - f0[4], s[5] * inv - f0[5]); o.w = pk2(s[6] * inv - f0[6], s[7] * inv - f0[7]);
            *(LAS u32x4*)(Pl + t * 264 + cb + c8 * 8) = o; } }
    __syncthreads();
    const bf16_t* PT = (const bf16_t*)(A.ws + WS_POOLT); bf16_t* MIX = (bf16_t*)(A.ws + WS_XN);
    const int mt = F.wave & 3, lane = F.lane;
#pragma unroll
    for (int gi = 0; gi < 2; ++gi) { const int g = (F.wave >> 2) * 2 + gi;
        const bf16x8 a0 = ldfrag(Pl + mt * 16 * 264 + g * 64, 264, 0, lane), a1 = ldfrag(Pl + mt * 16 * 264 + g * 64, 264, 32, lane);
#pragma unroll
        for (int nt = 0; nt < 4; ++nt) { f32x4 acc = (f32x4){0.f, 0.f, 0.f, 0.f};
            acc = mfma16(gfrag(PT + g * 4096 + nt * 16 * 64, 64, 0, lane), a0, acc); acc = mfma16(gfrag(PT + g * 4096 + nt * 16 * 64, 64, 32, lane), a1, acc);
            const int ch = g * 64 + nt * 16 + 4 * (lane >> 4); const f32x4 sc = *(const f32x4*)(A.in[23] + l * 256 + ch);
            u32x2 o; o.x = pk2(acc[0] * sc.x, acc[1] * sc.y); o.y = pk2(acc[2] * sc.z, acc[3] * sc.w);
            *(u32x2*)(MIX + (size_t)(rowbase + j0 + mt * 16 + (lane & 15)) * D + 768 + ch) = o; } }
}
__device__ __forceinline__ void phase_pool(Frame& F, int l) {
    CArgs& A = *get_args();
    const int nlat = RL / 64, nctx = (l == DEPTH - 1) ? 0 : NB * 4;
    for (int it = blockIdx.x; it < nlat + nctx; it += F.G) {
        if (it < nlat) pool_item(F, A, l, RC + it * 64, 0, 64);
        else { const int q = it - nlat; pool_item(F, A, l, (q >> 2) * CTXL, (q & 3) * 64, CTXL); }
    }
    __syncthreads();
}

__device__ __forceinline__ void rot16(const bf16_t* src, const f32x2* ROT, int pos, int q, float scale, float (&lo)[8], float (&hi)[8]) {
    float a[8], b[8]; unpack8(*(const u32x4*)(src + 8 * q), a); unpack8(*(const u32x4*)(src + 32 + 8 * q), b);
    const f32x4* cs = (const f32x4*)(ROT + (size_t)pos * 32 + 8 * q);
#pragma unroll
    for (int e2 = 0; e2 < 4; ++e2) { const f32x4 w = cs[e2];
        lo[2 * e2] = (a[2 * e2] * w.x - b[2 * e2] * w.y) * scale; hi[2 * e2] = (a[2 * e2] * w.y + b[2 * e2] * w.x) * scale;
        lo[2 * e2 + 1] = (a[2 * e2 + 1] * w.z - b[2 * e2 + 1] * w.w) * scale; hi[2 * e2 + 1] = (a[2 * e2 + 1] * w.w + b[2 * e2 + 1] * w.z) * scale; }
}
__device__ __forceinline__ void phase_ret_kv(Frame& F, int l) {
    CArgs& A = *get_args();
    const bf16_t* Z = (const bf16_t*)(A.ws + WS_Z); const f32x2* ROT = (const f32x2*)(A.ws + WS_ROT); float* KV = (float*)(A.ws + WS_KV);
    LAS bf16_t* Kt = (LAS bf16_t*)F.lds;
    LAS bf16_t* Vt = (LAS bf16_t*)(F.lds + 2 * 64 * 136 * 2);
    const int i = F.tid >> 2, q = F.tid & 3, lane = F.lane;
    for (int it = blockIdx.x; it < NB * NCH * 8; it += F.G) {
        const int hd = it & 7, bc = it >> 3, c = bc % NCH, b = bc / NCH;
        const float lgf = log2_gamma(A, l, 0, hd), lgb = log2_gamma(A, l, 1, hd);
        const int row = ret_row0(b, c) + i, pf = ret_pos0(c) + i, pb = c < 2 ? CTXL - 1 - (128 * c + i) : CTXL + SEQ - 1 - (128 * (c - 2) + i);
        const bf16_t* zr = Z + (size_t)row * INW + hd * 64;
        __syncthreads();
        { float lo[8], hi[8];
            rot16(zr + OFF_K, ROT, pf, q, 0.125f, lo, hi);
#pragma unroll
            for (int e = 0; e < 8; ++e) { Kt[(8 * q + e) * 136 + i] = (bf16_t)f2bf(lo[e]); Kt[(32 + 8 * q + e) * 136 + i] = (bf16_t)f2bf(hi[e]); }
            rot16(zr + OFF_K, ROT, pb, q, 0.125f, lo, hi);
#pragma unroll
            for (int e = 0; e < 8; ++e) { Kt[(64 + 8 * q + e) * 136 + i] = (bf16_t)f2bf(lo[e]); Kt[(64 + 32 + 8 * q + e) * 136 + i] = (bf16_t)f2bf(hi[e]); }
            float v0[8], v1[8]; unpack8(*(const u32x4*)(zr + OFF_V + 16 * q), v0); unpack8(*(const u32x4*)(zr + OFF_V + 16 * q + 8), v1);
            const float wf = exp2f((float)(127 - i) * lgf), wb = exp2f((float)i * lgb);
#pragma unroll
            for (int e = 0; e < 8; ++e) { Vt[(16 * q + e) * 136 + i] = (bf16_t)f2bf(v0[e] * wf); Vt[(16 * q + 8 + e) * 136 + i] = (bf16_t)f2bf(v1[e] * wf);
                Vt[(64 + 16 * q + e) * 136 + i] = (bf16_t)f2bf(v0[e] * wb); Vt[(64 + 16 * q + 8 + e) * 136 + i] = (bf16_t)f2bf(v1[e] * wb); } }
        __syncthreads();
        const int dir = F.wave >> 2, mt = F.wave & 3;
        bf16x8 vf[4];
#pragma unroll
        for (int ks = 0; ks < 4; ++ks) vf[ks] = ldfrag(Vt + (dir * 64 + mt * 16) * 136, 136, ks * 32, lane);
        float* out = KV + ((size_t)(((b * 8 + hd) * 2 + dir) * NCH + c)) * 4096 + (mt * 16 + (lane & 15)) * 64 + 4 * (lane >> 4);
#pragma unroll
        for (int nt = 0; nt < 4; ++nt) { f32x4 acc = (f32x4){0.f, 0.f, 0.f, 0.f};
#pragma unroll
            for (int ks = 0; ks < 4; ++ks) acc = mfma16(ldfrag(Kt + (dir * 64 + nt * 16) * 136, 136, ks * 32, lane), vf[ks], acc);
            *(f32x4*)(out + nt * 16) = acc; }
    }
    __syncthreads();
}
__device__ __forceinline__ void ret_scan(CArgs& A, int l, int gidx, int gstride) {
    float* KV = (float*)(A.ws + WS_KV);
    for (int idx = gidx; idx < NB * 8 * 2 * 1024; idx += gstride) {
        const int e4 = idx & 1023, chain = idx >> 10, dir = chain & 1, hd = (chain >> 1) & 7;
        const float cdec = exp2f(128.0f * log2_gamma(A, l, dir, hd));
        f32x4* base = (f32x4*)(KV + (size_t)chain * NCH * 4096) + e4;
        f32x4 s = (f32x4){0.f, 0.f, 0.f, 0.f};
#pragma unroll 2
        for (int k = 0; k < NCH; ++k) { const int c = dir == 0 ? k : (k < 2 ? 1 - k : NCH + 1 - k);
            f32x4* p = base + (size_t)c * 1024; const f32x4 loc = *p; *p = s; s = s * cdec + loc; }
    }
}
__device__ __forceinline__ void phase_ret_out(Frame& F, int l) {
    CArgs& A = *get_args();
    const bf16_t* Z = (const bf16_t*)(A.ws + WS_Z); const f32x2* ROT = (const f32x2*)(A.ws + WS_ROT); const float* KV = (const float*)(A.ws + WS_KV); bf16_t* MIX = (bf16_t*)(A.ws + WS_XN);
    LAS bf16_t* Qs = (LAS bf16_t*)F.lds;
    LAS bf16_t* Ks = Qs + 128 * 72;
    LAS bf16_t* Vt = Ks + 128 * 72;
    LAS bf16_t* Ss = Vt + 64 * 136;
    LAS bf16_t* Sn = Ss + 128 * 136;
    const int i = F.tid >> 2, q = F.tid & 3, lane = F.lane, fr = lane & 15, fq = lane >> 4, i0 = F.wave * 16;
    const int c_lo = (l == DEPTH - 1) ? 2 : 0, nch = NCH - c_lo;
    for (int it = blockIdx.x; it < NB * nch * 8; it += F.G) {
        const int hd = it & 7, bc = it >> 3, c = c_lo + bc % nch, b = bc / nch;
        const int row0 = ret_row0(b, c);
        const bf16_t* zr = Z + (size_t)(row0 + i) * INW + hd * 64;
        __syncthreads();
        { float v0[8], v1[8]; unpack8(*(const u32x4*)(zr + OFF_V + 16 * q), v0); unpack8(*(const u32x4*)(zr + OFF_V + 16 * q + 8), v1);
#pragma unroll
            for (int e = 0; e < 8; ++e) { Vt[(16 * q + e) * 136 + i] = (bf16_t)f2bf(v0[e]); Vt[(16 * q + 8 + e) * 136 + i] = (bf16_t)f2bf(v1[e]); } }
        f32x4 o[4];
#pragma unroll
        for (int t = 0; t < 4; ++t) o[t] = (f32x4){0.f, 0.f, 0.f, 0.f};
#pragma unroll 1
        for (int dir = 0; dir < 2; ++dir) {
            const float lg = log2_gamma(A, l, dir, hd);
            const int pos = dir == 0 ? ret_pos0(c) + i : (c < 2 ? CTXL - 1 - (128 * c + i) : CTXL + SEQ - 1 - (128 * (c - 2) + i));
            if (dir == 1) __syncthreads();
            { float lo[8], hi[8];
                rot16(zr + OFF_Q, ROT, pos, q, 1.0f, lo, hi);
                u32x4 w; w.x = pk2(lo[0], lo[1]); w.y = pk2(lo[2], lo[3]); w.z = pk2(lo[4], lo[5]); w.w = pk2(lo[6], lo[7]); *(LAS u32x4*)(Qs + i * 72 + 8 * q) = w;
                w.x = pk2(hi[0], hi[1]); w.y = pk2(hi[2], hi[3]); w.z = pk2(hi[4], hi[5]); w.w = pk2(hi[6], hi[7]); *(LAS u32x4*)(Qs + i * 72 + 32 + 8 * q) = w;
                rot16(zr + OFF_K, ROT, pos, q, 0.125f, lo, hi);
                w.x = pk2(lo[0], lo[1]); w.y = pk2(lo[2], lo[3]); w.z = pk2(lo[4], lo[5]); w.w = pk2(lo[6], lo[7]); *(LAS u32x4*)(Ks + i * 72 + 8 * q) = w;
                w.x = pk2(hi[0], hi[1]); w.y = pk2(hi[2], hi[3]); w.z = pk2(hi[4], hi[5]); w.w = pk2(hi[6], hi[7]); *(LAS u32x4*)(Ks + i * 72 + 32 + 8 * q) = w; }
            { const float* kv = KV + ((size_t)(((b * 8 + hd) * 2 + dir) * NCH + c)) * 4096 + (F.tid >> 3) * 64 + 8 * (F.tid & 7);
                const f32x4 s0 = *(const f32x4*)kv, s1 = *(const f32x4*)(kv + 4);
                u32x4 w; w.x = pk2(s0.x, s0.y); w.y = pk2(s0.z, s0.w); w.z = pk2(s1.x, s1.y); w.w = pk2(s1.z, s1.w); *(LAS u32x4*)(Sn + (F.tid >> 3) * 72 + 8 * (F.tid & 7)) = w; }
            __syncthreads();
            const bf16x8 qa0 = ldfrag(Qs + i0 * 72, 72, 0, lane), qa1 = ldfrag(Qs + i0 * 72, 72, 32, lane);
            const int ii = i0 + fr;
#pragma unroll
            for (int nt = 0; nt < 8; ++nt) { f32x4 s = (f32x4){0.f, 0.f, 0.f, 0.f};
                s = mfma16(ldfrag(Ks + nt * 16 * 72, 72, 0, lane), qa0, s); s = mfma16(ldfrag(Ks + nt * 16 * 72, 72, 32, lane), qa1, s);
                float d[4];
#pragma unroll
                for (int j = 0; j < 4; ++j) { const int jj = nt * 16 + 4 * fq + j; const int dl = dir == 0 ? ii - jj : jj - ii; const bool keep = dir == 0 ? dl >= 0 : dl > 0; d[j] = keep ? s[j] * exp2f((float)dl * lg) : 0.f; }
                u32x2 w; w.x = pk2(d[0], d[1]); w.y = pk2(d[2], d[3]); *(LAS u32x2*)(Ss + ii * 136 + nt * 16 + 4 * fq) = w; }
            LDS_WAIT(); asm volatile("" ::: "memory");
            const float qdec = exp2f((float)(dir == 0 ? ii + 1 : 128 - ii) * lg);
            bf16x8 sa[4];
#pragma unroll
            for (int ks = 0; ks < 4; ++ks) sa[ks] = ldfrag(Ss + i0 * 136, 136, ks * 32, lane);
#pragma unroll
            for (int t = 0; t < 4; ++t) { f32x4 a1 = (f32x4){0.f, 0.f, 0.f, 0.f}, a2 = (f32x4){0.f, 0.f, 0.f, 0.f};
#pragma unroll
                for (int ks = 0; ks < 4; ++ks) a1 = mfma16(ldfrag(Vt + t * 16 * 136, 136, ks * 32, lane), sa[ks], a1);
                a2 = mfma16(ldfrag(Sn + t * 16 * 72, 72, 0, lane), qa0, a2); a2 = mfma16(ldfrag(Sn + t * 16 * 72, 72, 32, lane), qa1, a2);
                o[t] = o[t] + a1 + a2 * qdec; }
        }
        float s1 = 0.f;
#pragma unroll
        for (int t = 0; t < 4; ++t) s1 += (o[t][0] + o[t][1]) + (o[t][2] + o[t][3]);
        s1 += __shfl_xor(s1, 16); s1 += __shfl_xor(s1, 32);
        const float mu = s1 * (1.0f / 64.0f); float s2 = 0.f;
#pragma unroll
        for (int t = 0; t < 4; ++t) { o[t] = o[t] - mu; s2 += (o[t][0] * o[t][0] + o[t][1] * o[t][1]) + (o[t][2] * o[t][2] + o[t][3] * o[t][3]); }
        s2 += __shfl_xor(s2, 16); s2 += __shfl_xor(s2, 32);
        const float rstd = 1.0f / sqrtf(s2 * (1.0f / 64.0f) + 1e-5f);
        const size_t orow = (size_t)(row0 + i0 + fr);
#pragma unroll
        for (int t = 0; t < 4; ++t) { const int ch = hd * 64 + t * 16 + 4 * fq; const f32x4 gw = *(const f32x4*)(A.in[21] + l * 512 + ch);
            const u32x2 gg = *(const u32x2*)(Z + orow * INW + OFF_G + ch);
            u32x2 w; w.x = pk2(o[t][0] * rstd * gw.x * siluf_(bflo(gg.x)), o[t][1] * rstd * gw.y * siluf_(bfhi(gg.x))); w.y = pk2(o[t][2] * rstd * gw.z * siluf_(bflo(gg.y)), o[t][3] * rstd * gw.w * siluf_(bfhi(gg.y)));
            *(u32x2*)(MIX + orow * D + 256 + ch) = w; }
    }
    __syncthreads();
}

__device__ __forceinline__ void s5_build_group(Frame& F, CArgs& A, int l, int g) {
    LAS float* AP = (LAS float*)F.lds;
    LAS float* BB = AP + 2 * 17 * 64 * 2;
    LAS float* CC = BB + 2 * 64 * 16 * 2;
    LAS float* KK = CC + 2 * 16 * 64 * 2;
    __syncthreads();
    if (F.tid < 128) { const int dir = F.tid >> 6, p = F.tid & 63, pg = (l * 2 + dir) * 16 + g;
        const float are = A.in[10][pg * 64 + p], aim = A.in[11][pg * 64 + p], dt = expf(A.in[12][pg]);
        const float mag = expf(dt * are); float sn, cs; sincos_d(dt * aim, sn, cs);
        const float abr = mag * cs, abi = mag * sn, inv = 1.0f / (are * are + aim * aim);
        const float fre = ((abr - 1.0f) * are + abi * aim) * inv, fim = (abi * are - (abr - 1.0f) * aim) * inv;
        float pr = 1.f, pi = 0.f;
        for (int t = 0; t <= 16; ++t) { AP[((dir * 17 + t) * 64 + p) * 2] = pr; AP[((dir * 17 + t) * 64 + p) * 2 + 1] = pi; const float nr = pr * abr - pi * abi, ni = pr * abi + pi * abr; pr = nr; pi = ni; }
        for (int h = 0; h < 16; ++h) { const float br = A.in[13][(pg * 64 + p) * 16 + h], bi = A.in[14][(pg * 64 + p) * 16 + h];
            BB[((dir * 64 + p) * 16 + h) * 2] = fre * br - fim * bi; BB[((dir * 64 + p) * 16 + h) * 2 + 1] = fre * bi + fim * br;
            CC[((dir * 16 + h) * 64 + p) * 2] = A.in[15][(pg * 16 + h) * 64 + p]; CC[((dir * 16 + h) * 64 + p) * 2 + 1] = A.in[16][(pg * 16 + h) * 64 + p]; } }
    __syncthreads();
    for (int idx = F.tid; idx < 2 * 16 * 256; idx += NTHR) { const int hi = idx & 15, ho = (idx >> 4) & 15, tau = (idx >> 8) & 15, dir = idx >> 12; float s = 0.f;
        for (int p = 0; p < 64; ++p) { const float ar = AP[((dir * 17 + tau) * 64 + p) * 2], ai = AP[((dir * 17 + tau) * 64 + p) * 2 + 1], br = BB[((dir * 64 + p) * 16 + hi) * 2], bi = BB[((dir * 64 + p) * 16 + hi) * 2 + 1];
            const float mr = ar * br - ai * bi, mi = ar * bi + ai * br; s += CC[((dir * 16 + ho) * 64 + p) * 2] * mr - CC[((dir * 16 + ho) * 64 + p) * 2 + 1] * mi; }
        KK[idx] = s; }
    __syncthreads();
    bf16_t* W1 = (bf16_t*)(A.ws + WS_S5W1) + (size_t)g * 256 * 256; bf16_t* W2 = (bf16_t*)(A.ws + WS_S5W2) + (size_t)g * 256 * 512;
    for (int idx = F.tid; idx < 256 * 256; idx += NTHR) { const int k = idx & 255, n = idx >> 8, j = k >> 4, hi = k & 15;
        { const int dir = n >> 7, im = (n >> 6) & 1, p = n & 63, tau = dir == 0 ? 15 - j : j;
            const float ar = AP[((dir * 17 + tau) * 64 + p) * 2], ai = AP[((dir * 17 + tau) * 64 + p) * 2 + 1], br = BB[((dir * 64 + p) * 16 + hi) * 2], bi = BB[((dir * 64 + p) * 16 + hi) * 2 + 1];
            W1[idx] = (bf16_t)f2bf(im ? ar * bi + ai * br : ar * br - ai * bi); }
        { const int t = n >> 4, ho = n & 15; float v;
            if (j < t) v = KK[((0 * 16 + (t - j)) * 16 + ho) * 16 + hi]; else if (j > t) v = KK[((1 * 16 + (j - t)) * 16 + ho) * 16 + hi];
            else v = KK[((0 * 16 + 0) * 16 + ho) * 16 + hi] + KK[((1 * 16 + 0) * 16 + ho) * 16 + hi] + (ho == hi ? A.in[17][l * 256 + g * 16 + ho] : 0.f);
            W2[(size_t)n * 512 + k] = (bf16_t)f2bf(v); }
        { const int t = n >> 4, ho = n & 15, dir = k >> 7, im = (k >> 6) & 1, p = k & 63, tau = dir == 0 ? t + 1 : 16 - t;
            const float ar = AP[((dir * 17 + tau) * 64 + p) * 2], ai = AP[((dir * 17 + tau) * 64 + p) * 2 + 1], cr = CC[((dir * 16 + ho) * 64 + p) * 2], ci = CC[((dir * 16 + ho) * 64 + p) * 2 + 1];
            W2[(size_t)n * 512 + 256 + k] = (bf16_t)f2bf(im ? -(cr * ai + ci * ar) : cr * ar - ci * ai); } }
    __syncthreads();
}
__device__ __forceinline__ void phase_s5_local(Frame& F, int l) {
    CArgs& A = *get_args();
    const bf16_t* Z = (const bf16_t*)(A.ws + WS_Z); const bf16_t* W1 = (const bf16_t*)(A.ws + WS_S5W1); float* HLOC = (float*)(A.ws + WS_HLOC);
    const int lane = F.lane, fr = lane & 15, fq = lane >> 4;
    for (int it = F.gw; it < (NCR / 16) * 16; it += F.NGW) { const int g = it & 15, mtile = it >> 4, cr = mtile * 16 + fr;
        bf16x8 ua[8];
#pragma unroll
        for (int ks = 0; ks < 8; ++ks) ua[ks] = *(const bf16x8*)(Z + (size_t)(cr * 16 + 2 * ks + (fq >> 1)) * INW + OFF_U + g * 16 + 8 * (fq & 1));
        const bf16_t* w = W1 + (size_t)g * 65536; float* out = HLOC + ((size_t)cr * 16 + g) * 256 + 4 * fq;
#pragma unroll 4
        for (int nt = 0; nt < 16; ++nt) { f32x4 acc = (f32x4){0.f, 0.f, 0.f, 0.f};
#pragma unroll
            for (int ks = 0; ks < 8; ++ks) acc = mfma16(gfrag(w + nt * 16 * 256, 256, ks * 32, lane), ua[ks], acc);
            *(f32x4*)(out + nt * 16) = acc; }
    }
}
__device__ __forceinline__ void s5_scan(CArgs& A, int l, int chain, int p) {
    const int dir = chain & 1, g = (chain >> 1) & 15, b = chain >> 5, pg = (l * 2 + dir) * 16 + g;
    const float are = A.in[10][pg * 64 + p], aim = A.in[11][pg * 64 + p], dt = expf(A.in[12][pg]);
    const float mag = expf(dt * are); float sn, cs; sincos_d(dt * aim, sn, cs);
    float ar = mag * cs, ai = mag * sn;
#pragma unroll
    for (int s = 0; s < 4; ++s) { const float nr = ar * ar - ai * ai, ni = 2.f * ar * ai; ar = nr; ai = ni; }
    const float* HLOC = (const float*)(A.ws + WS_HLOC); bf16_t* HIN = (bf16_t*)(A.ws + WS_HIN);
    const int ncc = CTXL / S5T, ncl = SEQ / S5T;
    float hr = 0.f, hi = 0.f;
#pragma unroll 8
    for (int k = 0; k < ncc + ncl; ++k) {
        int cr;
        if (dir == 0) cr = k < ncc ? b * ncc + k : RC / S5T + b * ncl + (k - ncc);
        else cr = k < ncc ? b * ncc + (ncc - 1 - k) : RC / S5T + b * ncl + (ncl - 1 - (k - ncc));
        const size_t o = ((size_t)cr * 16 + g) * 256 + dir * 128 + p;
        const float lr = HLOC[o], li = HLOC[o + 64];
        HIN[o] = (bf16_t)f2bf(hr); HIN[o + 64] = (bf16_t)f2bf(hi);
        const float nr = ar * hr - ai * hi + lr, ni = ar * hi + ai * hr + li; hr = nr; hi = ni;
    }
}
__device__ __forceinline__ void phase_s5_out(Frame& F, int l) {
    CArgs& A = *get_args();
    const bf16_t* Z = (const bf16_t*)(A.ws + WS_Z); const bf16_t* W2 = (const bf16_t*)(A.ws + WS_S5W2); const bf16_t* HIN = (const bf16_t*)(A.ws + WS_HIN);
    const bf16_t* GT = (const bf16_t*)(A.ws + WS_GLUT); bf16_t* MIX = (bf16_t*)(A.ws + WS_XN);
    LAS bf16_t* Zs = (LAS bf16_t*)F.lds;
    const int lane = F.lane, fr = lane & 15, fq = lane >> 4;
    for (int it = blockIdx.x; it < RT / 128; it += F.G) {
        __syncthreads();
        const int cr = it * 8 + (fr & 7);
#pragma unroll 1
        for (int gi = 0; gi < 2; ++gi) { const int g = F.wave * 2 + gi;
            f32x4 acc[16];
#pragma unroll
            for (int nt = 0; nt < 16; ++nt) acc[nt] = (f32x4){0.f, 0.f, 0.f, 0.f};
            const bf16_t* w = W2 + (size_t)g * 256 * 512;
#pragma unroll 2
            for (int ks = 0; ks < 16; ++ks) {
                const bf16x8 a = ks < 8 ? *(const bf16x8*)(Z + (size_t)(cr * 16 + 2 * ks + (fq >> 1)) * INW + OFF_U + g * 16 + 8 * (fq & 1))
                                        : *(const bf16x8*)(HIN + ((size_t)cr * 16 + g) * 256 + (ks - 8) * 32 + 8 * fq);
#pragma unroll
                for (int nt = 0; nt < 16; ++nt) acc[nt] = mfma16(gfrag(w + nt * 16 * 512, 512, ks * 32, lane), a, acc[nt]);
            }
            if (fr < 8) {
#pragma unroll
                for (int nt = 0; nt < 16; ++nt) { u32x2 o; o.x = pk2(gelu_tanh(acc[nt][0]), gelu_tanh(acc[nt][1])); o.y = pk2(gelu_tanh(acc[nt][2]), gelu_tanh(acc[nt][3]));
                    *(LAS u32x2*)(Zs + (fr * 16 + nt) * 264 + g * 16 + 4 * fq) = o; } }
        }
        __syncthreads();
        bf16x8 za[8];
#pragma unroll
        for (int ks = 0; ks < 8; ++ks) za[ks] = ldfrag(Zs + F.wave * 16 * 264, 264, ks * 32, lane);
        const size_t orow = (size_t)it * 128 + F.wave * 16 + fr;
#pragma unroll 4
        for (int nt = 0; nt < 16; ++nt) { f32x4 acc = (f32x4){0.f, 0.f, 0.f, 0.f};
#pragma unroll
            for (int ks = 0; ks < 8; ++ks) acc = mfma16(gfrag(GT + nt * 16 * 256, 256, ks * 32, lane), za[ks], acc);
            const int ch = nt * 16 + 4 * fq; const f32x4 gb = *(const f32x4*)(A.in[19] + l * 256 + ch);
            const u32x2 zz = *(const LAS u32x2*)(Zs + (F.wave * 16 + fr) * 264 + ch);
            u32x2 o; o.x = pk2(bflo(zz.x) * sigmoidf_(acc[0] + gb.x), bfhi(zz.x) * sigmoidf_(acc[1] + gb.y)); o.y = pk2(bflo(zz.y) * sigmoidf_(acc[2] + gb.z), bfhi(zz.y) * sigmoidf_(acc[3] + gb.w));
            *(u32x2*)(MIX + orow * D + ch) = o; }
    }
    __syncthreads();
}

__device__ __forceinline__ int scan_row(int b, int dir, int s) {
    if (s < CTXL) { const int i = dir == 0 ? s : CTXL - 1 - s; return b * CTXL + i; }
    const int t = s - CTXL; return RC + b * SEQ + (dir == 0 ? t : SEQ - 1 - t);
}
__device__ __forceinline__ void naive_s5_item(CArgs& a, int l, int b, int g, int p) {
    const bf16_t* Z = (const bf16_t*)(a.ws + WS_Z); float* S5Y = (float*)(a.ws + WS_S5Y);
    for (int dir = 0; dir < 2; ++dir) {
        const int pg = ((l * 2 + dir) * 16 + g);
        const float are = a.in[10][pg * 64 + p], aim = a.in[11][pg * 64 + p], dt = expf(a.in[12][pg]);
        const float mag = expf(dt * are); float sn, cs; sincos_d(dt * aim, sn, cs);
        const float abr = mag * cs, abi = mag * sn, inv = 1.0f / (are * are + aim * aim);
        const float fre = ((abr - 1.0f) * are + abi * aim) * inv, fim = (abi * are - (abr - 1.0f) * aim) * inv;
        float bbr[16], bbi[16], cr[16], ci[16];
#pragma unroll
        for (int h = 0; h < 16; ++h) { const float br = a.in[13][(pg * 64 + p) * 16 + h], bi = a.in[14][(pg * 64 + p) * 16 + h];
            bbr[h] = fre * br - fim * bi; bbi[h] = fre * bi + fim * br; cr[h] = a.in[15][(pg * 16 + h) * 64 + p]; ci[h] = a.in[16][(pg * 16 + h) * 64 + p]; }
        float hr = 0.f, hi = 0.f;
        for (int s = 0; s < NPOS; ++s) {
            const int row = scan_row(b, dir, s);
            const u32x4 u0 = *(const u32x4*)(Z + (size_t)row * INW + OFF_U + g * 16), u1 = *(const u32x4*)(Z + (size_t)row * INW + OFF_U + g * 16 + 8);
            float u[16]; u[0] = bflo(u0.x); u[1] = bfhi(u0.x); u[2] = bflo(u0.y); u[3] = bfhi(u0.y); u[4] = bflo(u0.z); u[5] = bfhi(u0.z); u[6] = bflo(u0.w); u[7] = bfhi(u0.w);
            u[8] = bflo(u1.x); u[9] = bfhi(u1.x); u[10] = bflo(u1.y); u[11] = bfhi(u1.y); u[12] = bflo(u1.z); u[13] = bfhi(u1.z); u[14] = bflo(u1.w); u[15] = bfhi(u1.w);
            float sr = 0.f, si = 0.f;
#pragma unroll
            for (int h = 0; h < 16; ++h) { sr += bbr[h] * u[h]; si += bbi[h] * u[h]; }
            const float nr = abr * hr - abi * hi + sr, ni = abr * hi + abi * hr + si; hr = nr; hi = ni;
            float mine = 0.f;
#pragma unroll
            for (int h = 0; h < 16; ++h) { const float y = wave_sum(cr[h] * hr - ci[h] * hi); if (p == h) mine = y; }
            if (p < 16) { float* d = S5Y + (size_t)row * 256 + g * 16 + p; if (dir == 0) *d = mine; else *d += mine; }
        }
    }
}
__device__ __forceinline__ void naive_ret_item(CArgs& a, int l, int b, int hd, int lane) {
    const bf16_t* Z = (const bf16_t*)(a.ws + WS_Z); float* RO = (float*)(a.ws + WS_RO); const f32x2* ROT = (const f32x2*)(a.ws + WS_ROT);
    for (int dir = 0; dir < 2; ++dir) {
        const float dl = a.in[20][(l * 2 + dir) * 8 + hd];
        const float lgam = fminf(dl, 0.f) - log1pf(expf(-fabsf(dl)));
        const float gam = expf(lgam);
        float S[64];
#pragma unroll
        for (int d = 0; d < 64; ++d) S[d] = 0.f;
        for (int s = 0; s < NPOS; ++s) {
            const int row = scan_row(b, dir, s);
            const bf16_t* zr = Z + (size_t)row * INW + hd * 64;
            const float qo = bf2f(zr[OFF_Q + lane]), ko = bf2f(zr[OFF_K + lane]) * 0.125f, v = bf2f(zr[OFF_V + lane]);
            const f32x2 csn = ROT[s * 32 + (lane & 31)];
            const float qp = __shfl_xor(qo, 32), kp = __shfl_xor(ko, 32);
            const float q = lane < 32 ? qo * csn.x - qp * csn.y : qp * csn.y + qo * csn.x;
            const float k = lane < 32 ? ko * csn.x - kp * csn.y : kp * csn.y + ko * csn.x;
            float o = 0.f;
            if (dir == 0) {
#pragma unroll
                for (int d = 0; d < 64; ++d) { S[d] = gam * S[d] + __shfl(k, d) * v; o += __shfl(q, d) * S[d]; }
            } else {
#pragma unroll
                for (int d = 0; d < 64; ++d) { o += __shfl(q, d) * S[d]; S[d] = gam * S[d] + __shfl(k, d) * v; }
                o *= gam;
            }
            float* d = RO + (size_t)row * 512 + hd * 64 + lane; if (dir == 0) *d = o; else *d += o;
        }
    }
}
__device__ __forceinline__ void phase_naive_scan(Frame& F, int l) {
    if (F.wave != 0) return;
    const int i = blockIdx.x;
    if (i < 128) { if (!FAST_S5) naive_s5_item(*get_args(), l, i >> 4, i & 15, F.lane); }
    else if (i < 192) { if (!FAST_RET) naive_ret_item(*get_args(), l, (i - 128) >> 3, (i - 128) & 7, F.lane); }
}
__device__ __forceinline__ void phase_naive_out(Frame& F, int l) {
    if (FAST_S5 && FAST_RET && FAST_POOL) return;
    CArgs& a = *get_args();
    LAS float* wsm = (LAS float*)(F.lds + F.wave * 2048);
    const bf16_t* Z = (const bf16_t*)(a.ws + WS_Z); bf16_t* MIX = (bf16_t*)(a.ws + WS_XN);
    const int lane = F.lane;
    for (int row = F.gw; row < RT; row += F.NGW) {
        if (!FAST_S5) {
        float zz[4];
#pragma unroll
        for (int q = 0; q < 4; ++q) { const int c = lane + 64 * q; const float u = bf2f(Z[(size_t)row * INW + OFF_U + c]);
            const float y = ((const float*)(a.ws + WS_S5Y))[(size_t)row * 256 + c] + a.in[17][l * 256 + c] * u; zz[q] = gelu_tanh(y); wsm[c] = zz[q]; }
        LDS_WAIT(); asm volatile("" ::: "memory");
#pragma unroll
        for (int q = 0; q < 4; ++q) { const int c = lane + 64 * q; float s = a.in[19][l * 256 + c]; const float* W = a.in[18] + (size_t)l * 256 * 256 + c;
            for (int k = 0; k < 256; ++k) s += wsm[k] * W[k * 256];
            MIX[(size_t)row * D + c] = (bf16_t)f2bf(zz[q] * sigmoidf_(s)); }
        }
        if (!FAST_RET)
        for (int hd = 0; hd < 8; ++hd) {
            const float o = ((const float*)(a.ws + WS_RO))[(size_t)row * 512 + hd * 64 + lane];
            const float mu = wave_sum(o) * (1.0f / 64.0f); const float dv = o - mu; const float var = wave_sum(dv * dv) * (1.0f / 64.0f);
            const float g = bf2f(Z[(size_t)row * INW + OFF_G + hd * 64 + lane]);
            MIX[(size_t)row * D + 256 + hd * 64 + lane] = (bf16_t)f2bf(dv / sqrtf(var + 1e-5f) * a.in[21][l * 512 + hd * 64 + lane] * siluf_(g));
        }
        if (!FAST_POOL) {
        int base, j, n;
        if (row < RC) { j = row & (CTXL - 1); base = row - j; n = CTXL; } else { const int t = (row - RC) & (SEQ - 1); j = t & 63; base = row - j; n = 64; }
        LDS_WAIT(); asm volatile("" ::: "memory");
#pragma unroll
        for (int g = 0; g < 4; ++g) { const int c = g * 64 + lane, win = 2 << g;
            int lo = j - win / 2; if (lo < 0) lo = 0; int hi = j - win / 2 + win - 1; if (hi > n - 1) hi = n - 1;
            float s = 0.f; for (int q = lo; q <= hi; ++q) s += bf2f(Z[(size_t)(base + q) * INW + OFF_P + c]);
            wsm[c] = s / (float)(hi - lo + 1) - bf2f(Z[(size_t)row * INW + OFF_P + c]); }
        LDS_WAIT(); asm volatile("" ::: "memory");
#pragma unroll
        for (int g = 0; g < 4; ++g) { const float* W = a.in[22] + ((size_t)l * 4 + g) * 64 * 64 + lane; float o = 0.f;
            for (int k = 0; k < 64; ++k) o += wsm[g * 64 + k] * W[k * 64];
            MIX[(size_t)row * D + 768 + g * 64 + lane] = (bf16_t)f2bf(o * a.in[23][l * 256 + g * 64 + lane]); }
        }
        LDS_WAIT(); asm volatile("" ::: "memory");
    }
}

__global__ void __launch_bounds__(NTHR, 2) mk_fwd(Args args) {
    extern __shared__ __attribute__((aligned(16))) unsigned char lds_raw[];
#define MKF() Frame F; { int t_ = threadIdx.x; asm volatile("" : "+v"(t_)); F.lds = (LAS unsigned char*)lds_raw; F.tid = t_; F.lane = t_ & 63; F.wave = __builtin_amdgcn_readfirstlane(t_ >> 6); \
        F.G = gridDim.x; F.gw = blockIdx.x * NWAVES + F.wave; F.NGW = F.G * NWAVES; }
    volatile LAS unsigned* MISC = (volatile LAS unsigned*)((LAS unsigned char*)lds_raw + LC_MISC);
    if (threadIdx.x < 32) MISC[threadIdx.x] = 0u;
    __syncthreads();
    XcdBarrier bar = xcd_barrier_post((unsigned*)(get_args()->ws + WS_CTL) + CW_BAR, MISC + 8);
#define GRID_BAR() xcd_barrier(bar)
    { MKF(); phase_tables(F); phase_weights(F, 0); }
    if (FAST_S5) { MKF(); for (int g = blockIdx.x; g < 16; g += F.G) s5_build_group(F, *get_args(), 0, g); }
    cooperative_groups::this_grid().sync();
    for (int l = 0; l < DEPTH; ++l) {
        { MKF(); if (l > 0) phase_weights(F, l); phase_prenorm(F, l); }
        if (FAST_S5 && l > 0) { MKF(); for (int g = blockIdx.x; g < 16; g += F.G) s5_build_group(F, *get_args(), l, g); }
        GRID_BAR();
        { MKF(); phase_gemm_in(F); } GRID_BAR();
        if (FAST_RET) { MKF(); phase_ret_kv(F, l); }
        if (FAST_S5) { MKF(); phase_s5_local(F, l); }
        if (FAST_RET || FAST_S5) GRID_BAR();
        { MKF();
            if (FAST_S5) { if (F.wave == 0) for (int ch = blockIdx.x; ch < NB * 16 * 2; ch += F.G) s5_scan(*get_args(), l, ch, F.lane); }
            if (FAST_RET) { if (!FAST_S5 || F.wave != 0) ret_scan(*get_args(), l, (blockIdx.x * (FAST_S5 ? 7 : 8) + (FAST_S5 ? F.wave - 1 : F.wave)) * 64 + F.lane, F.G * (FAST_S5 ? 7 : 8) * 64); }
            phase_naive_scan(F, l); }
        GRID_BAR();
        if (FAST_RET) { MKF(); phase_ret_out(F, l); }
        if (FAST_S5) { MKF(); phase_s5_out(F, l); }
        if (FAST_POOL) { MKF(); phase_pool(F, l); }
        { MKF(); phase_naive_out(F, l); }
        GRID_BAR();
        { MKF(); phase_gemm_out(F, l); } GRID_BAR();
        { MKF(); phase_router(F, l); } GRID_BAR();
        { MKF(); phase_moe1(F, l); } GRID_BAR();
        { MKF(); phase_moe2(F, l); } GRID_BAR();
    }
    { MKF(); phase_final(F); }
}

extern "C" void kernel_launch(void* const* d_in, const int* in_sizes, int n_in, void* d_out, int out_size, void* d_ws, size_t ws_size, hipStream_t stream) {
    static int grid = 0;
    if (grid == 0) {
        if (n_in != 30 || out_size != RL * D || ws_size < WS_END) { fprintf(stderr, "kernel_launch: unexpected shapes (n_in %d out %d ws %zu)\n", n_in, out_size, ws_size); grid = -1; return; }
        int dev = 0, cus = 0, per_cu = 0;
        (void)hipGetDevice(&dev); (void)hipDeviceGetAttribute(&cus, hipDeviceAttributeMultiprocessorCount, dev);
        (void)hipFuncSetAttribute((const void*)mk_fwd, hipFuncAttributeMaxDynamicSharedMemorySize, LDS_BYTES);
        (void)hipOccupancyMaxActiveBlocksPerMultiprocessor(&per_cu, (const void*)mk_fwd, NTHR, LDS_BYTES);
        (void)hipGetLastError();
        if (per_cu < 1) { fprintf(stderr, "kernel_launch: occupancy query says %d blocks per CU\n", per_cu); grid = -1; return; }
        grid = cus;
        fprintf(stderr, "kernel_launch: cus %d per_cu %d grid %d ws %zu\n", cus, per_cu, grid, ws_size);
    }
    if (grid < 0) return;
    (void)hipMemsetAsync((char*)d_ws + WS_CTL, 0, CTL_BYTES, stream);
    Args a{}; for (int i = 0; i < 30; ++i) a.in[i] = (const float*)d_in[i];
    a.out = (float*)d_out; a.ws = (unsigned char*)d_ws;
    void* kargs[] = {&a};
    hipError_t e = hipLaunchCooperativeKernel((const void*)mk_fwd, dim3(grid), dim3(NTHR), kargs, LDS_BYTES, stream);
    if (e != hipSuccess) fprintf(stderr, "kernel_launch: cooperative launch failed: %s (grid %d)\n", hipGetErrorString(e), grid);
}
```

```cpp
#include <hip/hip_runtime.h>
#include <hip/hip_cooperative_groups.h>
#include <cstdio>
#include <cstdint>

#define LAS __attribute__((address_space(3)))
typedef unsigned short bf16_t;
typedef short bf16x8 __attribute__((ext_vector_type(8)));
typedef float f32x4 __attribute__((ext_vector_type(4)));
typedef float f32x2 __attribute__((ext_vector_type(2)));
typedef unsigned u32x4 __attribute__((ext_vector_type(4)));
typedef unsigned u32x2 __attribute__((ext_vector_type(2)));

constexpr int D = 1024, NB = 8, SEQ = 4096, CTXL = 256, DEPTH = 2, INW = 2560;
constexpr int RC = NB * CTXL, RL = NB * SEQ, RT = RC + RL;
constexpr int NE = 16;
constexpr int OFF_U = 0, OFF_Q = 256, OFF_K = 768, OFF_V = 1280, OFF_G = 1792, OFF_P = 2304;
constexpr int MAXTILES = 288, NPOS = CTXL + SEQ;
constexpr int NWAVES = 8, NTHR = 512;

constexpr size_t MiB = 1u << 20;
constexpr size_t WS_CTL = 0, CTL_BYTES = 1 * MiB;
constexpr size_t WS_MOD = 1 * MiB;
constexpr size_t WS_ROT = 2 * MiB;
constexpr size_t WS_TOKE = 4 * MiB;
constexpr size_t WS_TOKP = 4 * MiB + 512 * 1024;
constexpr size_t WS_TOKG = 5 * MiB;
constexpr size_t WS_LIST = 5 * MiB + 512 * 1024;
constexpr size_t WS_GLUT = 7 * MiB + 768 * 1024;
constexpr size_t WS_POOLT = 7 * MiB + 896 * 1024;
constexpr size_t WS_S5M = 8 * MiB;
constexpr size_t WS_WIN = 16 * MiB;
constexpr size_t WS_WOUT = 21 * MiB;
constexpr size_t WS_W13 = 24 * MiB;
constexpr size_t WS_W2 = 88 * MiB;
constexpr size_t WS_XB = 120 * MiB;
constexpr size_t WS_Z = 188 * MiB;
constexpr size_t WS_Y = 358 * MiB;
constexpr size_t WS_XRC = 502 * MiB;
constexpr size_t WS_YO = 510 * MiB;
constexpr size_t WS_END = 578 * MiB;
constexpr size_t WS_S5Y = WS_Y + 104 * MiB;
constexpr size_t WS_RO = WS_Y + 34 * MiB;
constexpr size_t WS_POOLED = WS_Y + 102 * MiB;
constexpr size_t WS_KV = WS_Y;
constexpr size_t WS_HLOC = WS_Y + 68 * MiB;
constexpr size_t WS_ZB = WS_Y + 68 * MiB;
constexpr size_t WS_A2 = WS_Y + 104 * MiB;
constexpr int CW_BAR = 4096, CW_GCNT = 8192;

__device__ __forceinline__ float wave_sum(float v) {
#pragma unroll
    for (int o = 1; o < 64; o <<= 1) v += __shfl_xor(v, o);
    return v;
}
typedef __bf16 bf16x2_t __attribute__((ext_vector_type(2)));
__device__ __forceinline__ unsigned pk2(float lo, float hi) { const bf16x2_t v = __builtin_convertvector((f32x2){lo, hi}, bf16x2_t); return __builtin_bit_cast(unsigned, v); }
__device__ __forceinline__ unsigned f2bf(float f) { return pk2(f, 0.f) & 0xffffu; }
__device__ __forceinline__ float bf2f(unsigned h) { return __builtin_bit_cast(float, h << 16); }
__device__ __forceinline__ float bflo(unsigned w) { return __builtin_bit_cast(float, w << 16); }
__device__ __forceinline__ float bfhi(unsigned w) { return __builtin_bit_cast(float, w & 0xffff0000u); }
__device__ __forceinline__ float sigmoidf_(float x) { return 1.0f / (1.0f + __expf(-x)); }
__device__ __forceinline__ float siluf_(float x) { return x / (1.0f + __expf(-x)); }
__device__ __forceinline__ float gelu_tanh(float x) { const float u = 0.7978845608028654f * (x + 0.044715f * x * x * x); return 0.5f * x * (1.0f + tanhf(u)); }
#define LDS_WAIT() asm volatile("s_waitcnt lgkmcnt(0)" ::: "memory")
#define VM_WAIT() asm volatile("s_waitcnt vmcnt(0)" ::: "memory")
#define LDS_BARRIER() do { asm volatile("s_waitcnt lgkmcnt(0)" ::: "memory"); __builtin_amdgcn_s_barrier(); asm volatile("" ::: "memory"); } while (0)
__device__ __forceinline__ f32x4 zero4() { float z = 0.f; asm volatile("" : "+v"(z)); return (f32x4){z, z, z, z}; }
__device__ __forceinline__ f32x4 mfma16(bf16x8 nside, bf16x8 mside, f32x4 acc) { return __builtin_amdgcn_mfma_f32_16x16x32_bf16(nside, mside, acc, 0, 0, 0); }
__device__ __forceinline__ bf16x8 ldfrag(const LAS bf16_t* base, int ld, int k0, int lane) { return *(const LAS bf16x8*)(base + (lane & 15) * ld + k0 + 8 * (lane >> 4)); }
__device__ __forceinline__ bf16x8 gfrag(const bf16_t* base, size_t ld, int k0, int lane) { return *(const bf16x8*)(base + (size_t)(lane & 15) * ld + k0 + 8 * (lane >> 4)); }

namespace pg8 {
constexpr int BM = 256, BK = 64, HALF = 128, HTB = HALF * BK * 2, STAGE_BYTES = 8 * HTB, NXCD = 8, WGM = 8;
__host__ __device__ __forceinline__ int lds_byte(int r, int c) { const int st = (r >> 4) * 2 + (c >> 5), rr = r & 15, cc = c & 31, ob = rr * 64 + cc * 2; return st * 1024 + (ob ^ (((ob >> 9) & 1) << 5)); }
__host__ __device__ __forceinline__ void stage_rc(int b, int& R, int& C) { const int st = b / 1024, sb = b % 1024, swz = sb ^ (((sb >> 9) & 1) << 5); R = (st >> 1) * 16 + swz / 64; C = (st & 1) * 32 + (swz % 64) / 2; }
__host__ __device__ __forceinline__ int perm32(int rho) { const int n = rho >> 4, i = rho & 15; return 8 * (i >> 2) + 4 * n + (i & 3); }

struct Unit { int pm, pn, e, ui; };

__device__ __forceinline__ unsigned cvt_pk_bf16(float lo, float hi) { unsigned r; asm volatile("v_cvt_pk_bf16_f32 %0, %1, %2" : "=v"(r) : "v"(lo), "v"(hi)); return r; }

struct DenseOrder {
    int nM, nN, nwg, G, c, pm0, K; const char* Bt;
    __device__ void init(int nM_, int nN_, int G_, int c_, int pm0_, int K_, const void* Bt_) { nM = nM_; nN = nN_; nwg = nM * nN; G = G_; c = c_; pm0 = pm0_; K = K_; Bt = (const char*)Bt_; }
    __device__ bool next(int i, Unit& u) const {
        const long L = (long)i * G + c; if (L >= nwg) return false;
        int wgid = (int)L; { const int q = nwg / NXCD, r = nwg % NXCD, xcd = wgid % NXCD, off = wgid / NXCD; wgid = (xcd < r ? xcd * (q + 1) : r * (q + 1) + (xcd - r) * q) + off; }
        const int nig = WGM * nN, gid = wgid / nig, fm = gid * WGM, gsz = (nM - fm) < WGM ? (nM - fm) : WGM;
        u.pm = pm0 + fm + ((wgid % nig) % gsz); u.pn = (wgid % nig) / gsz; u.e = 0; u.ui = i; return true;
    }
    __device__ __forceinline__ void a_offs(const Unit& u, const int (&R)[2], const int (&C)[2], unsigned (&off)[2][2]) const {
#pragma unroll
        for (int h = 0; h < 2; ++h)
#pragma unroll
            for (int i = 0; i < 2; ++i) off[h][i] = (unsigned)((u.pm * BM + h * HALF + R[i]) * K + C[i]) * 2u;
    }
    __device__ __forceinline__ const char* b_ptr(const Unit& u) const { return Bt + (size_t)u.pn * BM * K * 2; }
};
struct MoeOrder {
    int ntiles, nN, G, c, K; const char* Bt; size_t bstride; const LAS int* tile_e; const LAS unsigned* rowoff;
    bool xcd_tiles;
    __device__ bool next(int i, Unit& u) const {
        const long L = (long)i * G + c; if (L >= (long)ntiles * nN) return false;
        if (xcd_tiles && (G & 7) == 0) { const int g = (int)(L >> 3), x = (int)(L & 7), oct = g / nN, gi = g % nN;
            int pn, t;
            if (nN == 8) { t = oct * 8 + 2 * (x & 3) + (gi >> 2); pn = 4 * (x >> 2) + (gi & 3); }
            else { t = oct * 8 + x; pn = gi; }
            if ((oct + 1) * 8 <= ntiles) { u.pn = pn; u.pm = t; u.e = tile_e[t]; u.ui = i; return true; } }
        u.pn = (int)(L % nN); u.pm = (int)(L / nN); u.e = tile_e[u.pm]; u.ui = i; return true;
    }
    __device__ __forceinline__ void a_offs(const Unit& u, const int (&R)[2], const int (&C)[2], unsigned (&off)[2][2]) const {
#pragma unroll
        for (int h = 0; h < 2; ++h)
#pragma unroll
            for (int i = 0; i < 2; ++i) off[h][i] = rowoff ? rowoff[u.ui * 256 + h * HALF + R[i]] + (unsigned)C[i] * 2u : (unsigned)((u.pm * BM + h * HALF + R[i]) * K + C[i]) * 2u;
    }
    __device__ __forceinline__ const char* b_ptr(const Unit& u) const { return Bt + (size_t)u.e * bstride + (size_t)u.pn * BM * K * 2; }
};

struct EpiBf16 {
    static constexpr bool PERM = true;
    bf16_t* O; int ldc;
    __device__ __forceinline__ void operator()(const f32x4 (&acc)[2][2][4][2], const Unit& u, int wr, int wc, int fr, int fq) const {
        const int row0 = u.pm * BM + wr * 64 + fr, col0 = u.pn * BM + wc * 32 + 8 * fq;
#pragma unroll
        for (int ai = 0; ai < 2; ++ai)
#pragma unroll
            for (int m = 0; m < 4; ++m) { bf16_t* rowp = O + (size_t)(row0 + ai * HALF + m * 16) * ldc + col0;
#pragma unroll
                for (int bj = 0; bj < 2; ++bj) { const f32x4 v0 = acc[ai][bj][m][0], v1 = acc[ai][bj][m][1];
                    u32x4 w; w.x = cvt_pk_bf16(v0[0], v0[1]); w.y = cvt_pk_bf16(v0[2], v0[3]); w.z = cvt_pk_bf16(v1[0], v1[1]); w.w = cvt_pk_bf16(v1[2], v1[3]);
                    *(u32x4*)(rowp + bj * HALF) = w; } }
    }
};
struct EpiSwiGLU {
    static constexpr bool PERM = true;
    bf16_t* O;
    __device__ __forceinline__ void operator()(const f32x4 (&acc)[2][2][4][2], const Unit& u, int wr, int wc, int fr, int fq) const {
        const int row0 = u.pm * BM + wr * 64 + fr, col0 = u.pn * HALF + wc * 32 + 8 * fq;
#pragma unroll
        for (int ai = 0; ai < 2; ++ai)
#pragma unroll
            for (int m = 0; m < 4; ++m) { bf16_t* rowp = O + (size_t)(row0 + ai * HALF + m * 16) * 1024 + col0;
                float h[8];
#pragma unroll
                for (int n = 0; n < 2; ++n)
#pragma unroll
                    for (int j = 0; j < 4; ++j) { const float a = acc[ai][0][m][n][j], b = acc[ai][1][m][n][j]; h[n * 4 + j] = a * __builtin_amdgcn_rcpf(1.0f + __builtin_amdgcn_exp2f(-1.4426950408889634f * a)) * b; }
                u32x4 w; w.x = cvt_pk_bf16(h[0], h[1]); w.y = cvt_pk_bf16(h[2], h[3]); w.z = cvt_pk_bf16(h[4], h[5]); w.w = cvt_pk_bf16(h[6], h[7]);
                *(u32x4*)rowp = w; }
    }
};
struct EpiRes {
    static constexpr bool PERM = false;
    const float* src_c; const float* src_l; float* dst_c; float* dst_l; const float* modl;
    __device__ __forceinline__ void operator()(const f32x4 (&acc)[2][2][4][2], const Unit& u, int wr, int wc, int fr, int fq) const {
        const bool isc = u.pm < 8; const int bidx = isc ? 8 : ((u.pm - 8) >> 4);
        const float* src = isc ? src_c : src_l; float* dst = isc ? dst_c : dst_l;
        const int rl0 = (isc ? u.pm * BM : (u.pm - 8) * BM) + wr * 64 + fr, col0 = u.pn * BM + wc * 32 + 4 * fq;
        const float* gate = modl + bidx * 6144 + 2048;
        f32x4 gv[2][2];
#pragma unroll
        for (int bj = 0; bj < 2; ++bj)
#pragma unroll
            for (int n = 0; n < 2; ++n) gv[bj][n] = *(const f32x4*)(gate + col0 + bj * HALF + n * 16);
#pragma unroll
        for (int ai = 0; ai < 2; ++ai)
#pragma unroll
            for (int m = 0; m < 4; ++m) { const size_t off = (size_t)(rl0 + ai * HALF + m * 16) * 1024 + col0;
#pragma unroll
                for (int bj = 0; bj < 2; ++bj)
#pragma unroll
                    for (int n = 0; n < 2; ++n) { const f32x4 s = *(const f32x4*)(src + off + bj * HALF + n * 16); *(f32x4*)(dst + off + bj * HALF + n * 16) = s + gv[bj][n] * acc[ai][bj][m][n]; } }
    }
};

struct S5Order {
    int G, c, K; const char* Bt; size_t bstride;
    __device__ bool next(int i, Unit& u) const { const long L = (long)i * G + c; if (L >= 9 * 16) return false; u.pm = (int)(L >> 4); u.e = (int)(L & 15); u.pn = 0; u.ui = i; return true; }
    __device__ __forceinline__ void a_offs(const Unit& u, const int (&R)[2], const int (&C)[2], unsigned (&off)[2][2]) const {
#pragma unroll
        for (int h = 0; h < 2; ++h)
#pragma unroll
            for (int i = 0; i < 2; ++i) off[h][i] = (unsigned)(((u.e * 2304 + u.pm * BM + h * HALF + R[i]) * 512 + C[i])) * 2u;
    }
    __device__ __forceinline__ const char* b_ptr(const Unit& u) const { return Bt + (size_t)u.e * bstride; }
};
struct EpiIn {
    static constexpr bool PERM = true;
    bf16_t* Zb; bf16_t* A2;
    __device__ __forceinline__ void operator()(const f32x4 (&acc)[2][2][4][2], const Unit& u, int wr, int wc, int fr, int fq) const {
        const int row0 = u.pm * BM + wr * 64 + fr, colt = wc * 32 + 8 * fq;
#pragma unroll
        for (int ai = 0; ai < 2; ++ai)
#pragma unroll
            for (int m = 0; m < 4; ++m) { const int row = row0 + ai * HALF + m * 16;
#pragma unroll
                for (int bj = 0; bj < 2; ++bj) { const f32x4 v0 = acc[ai][bj][m][0], v1 = acc[ai][bj][m][1]; const int c = colt + bj * HALF;
                    u32x4 w; w.x = cvt_pk_bf16(v0[0], v0[1]); w.y = cvt_pk_bf16(v0[2], v0[3]); w.z = cvt_pk_bf16(v1[0], v1[1]); w.w = cvt_pk_bf16(v1[2], v1[3]);
                    if (u.pn == 0) *(u32x4*)(A2 + ((size_t)((c >> 4) * 2304 + (row >> 4)) * 512 + (row & 15) * 16 + (c & 15))) = w;
                    else *(u32x4*)(Zb + (size_t)row * 2560 + u.pn * BM + c) = w; } }
    }
};
struct EpiHloc {
    static constexpr bool PERM = false;
    float* O; int ncr;
    __device__ __forceinline__ void operator()(const f32x4 (&acc)[2][2][4][2], const Unit& u, int wr, int wc, int fr, int fq) const {
        const int row0 = u.pm * BM + wr * 64 + fr, col0 = wc * 32 + 4 * fq;
#pragma unroll
        for (int ai = 0; ai < 2; ++ai)
#pragma unroll
            for (int m = 0; m < 4; ++m) { const int cr = row0 + ai * HALF + m * 16; if (cr < ncr) { float* rowp = O + ((size_t)u.e * 2304 + cr) * 256 + col0;
#pragma unroll
                for (int bj = 0; bj < 2; ++bj)
#pragma unroll
                    for (int n = 0; n < 2; ++n) *(f32x4*)(rowp + bj * HALF + n * 16) = acc[ai][bj][m][n]; } }
    }
};
__device__ __forceinline__ float gelu_tanh_f(float x) { const float u = 0.7978845608028654f * (x + 0.044715f * x * x * x); const float e = __builtin_amdgcn_exp2f(2.8853900817779268f * u); return x * (1.0f - __builtin_amdgcn_rcpf(1.0f + e)); }
struct EpiS5Z {
    static constexpr bool PERM = true;
    bf16_t* O; int ncr;
    __device__ __forceinline__ void operator()(const f32x4 (&acc)[2][2][4][2], const Unit& u, int wr, int wc, int fr, int fq) const {
        const int row0 = u.pm * BM + wr * 64 + fr, colt = wc * 32 + 8 * fq;
#pragma unroll
        for (int ai = 0; ai < 2; ++ai)
#pragma unroll
            for (int m = 0; m < 4; ++m) { const int cr = row0 + ai * HALF + m * 16; if (cr < ncr) {
#pragma unroll
                for (int bj = 0; bj < 2; ++bj) { const f32x4 v0 = acc[ai][bj][m][0], v1 = acc[ai][bj][m][1]; const int c = colt + bj * HALF;
                    u32x4 w; w.x = cvt_pk_bf16(gelu_tanh_f(v0[0]), gelu_tanh_f(v0[1])); w.y = cvt_pk_bf16(gelu_tanh_f(v0[2]), gelu_tanh_f(v0[3])); w.z = cvt_pk_bf16(gelu_tanh_f(v1[0]), gelu_tanh_f(v1[1])); w.w = cvt_pk_bf16(gelu_tanh_f(v1[2]), gelu_tanh_f(v1[3]));
                    *(u32x4*)(O + ((size_t)(cr * 16 + (c >> 4)) * 256 + u.e * 16 + (c & 15))) = w; } } }
    }
};
struct EpiGlu {
    static constexpr bool PERM = true;
    const bf16_t* ZB; bf16_t* MIXp; const float* bias;
    __device__ __forceinline__ void operator()(const f32x4 (&acc)[2][2][4][2], const Unit& u, int wr, int wc, int fr, int fq) const {
        const int row0 = u.pm * BM + wr * 64 + fr, colt = wc * 32 + 8 * fq;
#pragma unroll
        for (int bj = 0; bj < 2; ++bj) { const int c = colt + bj * HALF; const f32x4 b0 = *(const f32x4*)(bias + c), b1 = *(const f32x4*)(bias + c + 4);
#pragma unroll
            for (int ai = 0; ai < 2; ++ai)
#pragma unroll
                for (int m = 0; m < 4; ++m) { const size_t row = (size_t)(row0 + ai * HALF + m * 16); const u32x4 z = *(const u32x4*)(ZB + row * 256 + c);
                    const f32x4 v0 = acc[ai][bj][m][0] + b0, v1 = acc[ai][bj][m][1] + b1;
#define SG_(x) __builtin_amdgcn_rcpf(1.0f + __builtin_amdgcn_exp2f(-1.4426950408889634f * (x)))
                    u32x4 w; w.x = cvt_pk_bf16(bflo(z.x) * SG_(v0[0]), bfhi(z.x) * SG_(v0[1])); w.y = cvt_pk_bf16(bflo(z.y) * SG_(v0[2]), bfhi(z.y) * SG_(v0[3]));
                    w.z = cvt_pk_bf16(bflo(z.z) * SG_(v1[0]), bfhi(z.z) * SG_(v1[1])); w.w = cvt_pk_bf16(bflo(z.w) * SG_(v1[2]), bfhi(z.w) * SG_(v1[3]));
#undef SG_
                    *(u32x4*)(MIXp + row * 1024 + c) = w; } }
    }
};

template <class Epi, class Sched, bool ALIGN_EPI>
__device__ __forceinline__ void gemm_phase(LAS unsigned char* lds, const int tid_in, const char* Abase, const int K, const Sched& S, const Epi& E) {
    int tid_ = tid_in; asm volatile("" : "+v"(tid_));
    const int tid = tid_, wid = __builtin_amdgcn_readfirstlane(tid >> 6), lane = tid & 63, wr = wid >> 2, wc = wid & 3, fr = lane & 15, fq = lane >> 4;
    const int nt = K / BK;
    int Rr[2], Cc[2]; unsigned voffB[2];
#pragma unroll
    for (int i = 0; i < 2; ++i) { int R, C; stage_rc(tid * 16 + i * 8192, R, C); Rr[i] = R; Cc[i] = C; const int Rb = Epi::PERM ? ((R & ~31) + perm32(R & 31)) : R; voffB[i] = (unsigned)(Rb * K + C) * 2u; }
    const size_t kstep = (size_t)(BK * 2);
    const size_t hstepB = (size_t)HALF * K * 2;
    const unsigned ldsw = (unsigned)wid * 1024u;
    const int aoff = lds_byte(wr * 64 + fr, fq * 8), boff = lds_byte(wc * 32 + fr, fq * 8);
#define PG8_SA(b, h) (((b) * 2 + (h)) * HTB)
#define PG8_SB(b, h) ((4 + (b) * 2 + (h)) * HTB)
#define PG8_STAGE_B(bufoff, gbase) do { _Pragma("unroll") for (int _i = 0; _i < 2; ++_i) \
        __builtin_amdgcn_global_load_lds((const unsigned*)((const char*)(gbase) + voffB[_i]), (LAS unsigned*)(lds + (bufoff) + ldsw + _i * 8192), 16, 0, 0); } while (0)
#define PG8_STAGE_A(bufoff, offs, kb) do { _Pragma("unroll") for (int _i = 0; _i < 2; ++_i) \
        __builtin_amdgcn_global_load_lds((const unsigned*)(Abase + (kb) + (offs)[_i]), (LAS unsigned*)(lds + (bufoff) + ldsw + _i * 8192), 16, 0, 0); } while (0)
#define PG8_LDA(dst, b, h) do { _Pragma("unroll") for (int m = 0; m < 4; ++m) _Pragma("unroll") for (int k = 0; k < 2; ++k) dst[m][k] = *(const LAS bf16x8*)(lds + PG8_SA(b, h) + aoff + m * 2048 + k * 1024); } while (0)
#define PG8_LDB(dst, b, h) do { _Pragma("unroll") for (int n = 0; n < 2; ++n) _Pragma("unroll") for (int k = 0; k < 2; ++k) dst[n][k] = *(const LAS bf16x8*)(lds + PG8_SB(b, h) + boff + n * 2048 + k * 1024); } while (0)
#define PG8_MMA(ai, bj, At, Bt) do { __builtin_amdgcn_s_setprio(1); _Pragma("unroll") for (int m = 0; m < 4; ++m) _Pragma("unroll") for (int n = 0; n < 2; ++n) _Pragma("unroll") for (int k = 0; k < 2; ++k) \
        acc[ai][bj][m][n] = __builtin_amdgcn_mfma_f32_16x16x32_bf16(Bt[n][k], At[m][k], acc[ai][bj][m][n], 0, 0, 0); __builtin_amdgcn_s_setprio(0); } while (0)
#define PG8_WAIT_V(n) asm volatile("s_waitcnt vmcnt(" #n ")" ::: "memory")
#define PG8_WAIT_L(n) asm volatile("s_waitcnt lgkmcnt(" #n ")" ::: "memory")
#define PG8_BAR __builtin_amdgcn_s_barrier()
#define PG8_SCHED __builtin_amdgcn_sched_barrier(0)
    Unit cur, nxt; int ui = 0;
    if (!S.next(0, cur)) return;
    float z_ = 0.f; asm volatile("" : "+v"(z_));
    f32x4 acc[2][2][4][2];
#pragma unroll
    for (int a = 0; a < 2; ++a)
#pragma unroll
        for (int b = 0; b < 2; ++b)
#pragma unroll
            for (int m = 0; m < 4; ++m)
#pragma unroll
                for (int n = 0; n < 2; ++n) acc[a][b][m][n] = (f32x4){z_, z_, z_, z_};
    bf16x8 At[4][2], B0[2][2], B1[2][2];
    unsigned cO[2][2], nO[2][2];
    S.a_offs(cur, Rr, Cc, cO);
    const char* cB = S.b_ptr(cur); const char* nB = cB;
    PG8_STAGE_B(PG8_SB(0, 0), cB); PG8_STAGE_B(PG8_SB(0, 1), cB + hstepB); PG8_STAGE_A(PG8_SA(0, 0), cO[0], 0); PG8_STAGE_A(PG8_SA(0, 1), cO[1], 0);
    if (wr == 1) PG8_BAR;
    PG8_WAIT_V(2); PG8_BAR;
    PG8_STAGE_B(PG8_SB(1, 0), cB + kstep); PG8_STAGE_A(PG8_SA(1, 0), cO[0], kstep); PG8_STAGE_B(PG8_SB(1, 1), cB + hstepB + kstep);
    PG8_WAIT_V(6); PG8_BAR;
    for (;;) {
        const bool has_next = S.next(ui + 1, nxt);
        if (has_next) { S.a_offs(nxt, Rr, Cc, nO); nB = S.b_ptr(nxt); }
        else { nO[0][0] = cO[0][0]; nO[0][1] = cO[0][1]; nO[1][0] = cO[1][0]; nO[1][1] = cO[1][1]; nB = cB; }
#pragma unroll 1
        for (int t = 0; t < nt; t += 2) {
            const bool last = (t == nt - 2);
            const size_t k1 = (size_t)(t + 1) * kstep;
            const size_t k2 = last ? (size_t)0 : (size_t)(t + 2) * kstep, k3 = k2 + kstep;
            unsigned o2[2][2];
            o2[0][0] = last ? nO[0][0] : cO[0][0]; o2[0][1] = last ? nO[0][1] : cO[0][1]; o2[1][0] = last ? nO[1][0] : cO[1][0]; o2[1][1] = last ? nO[1][1] : cO[1][1];
            const char* b2 = (last ? nB : cB) + k2; const char* b3 = b2 + kstep;
            PG8_LDB(B0, 0, 0); PG8_LDB(B1, 0, 1); PG8_SCHED; PG8_LDA(At, 0, 0); PG8_STAGE_A(PG8_SA(1, 1), cO[1], k1);
            PG8_WAIT_V(8); PG8_WAIT_L(0); PG8_BAR; PG8_MMA(0, 0, At, B0); PG8_MMA(0, 1, At, B1); PG8_BAR; PG8_SCHED;
            PG8_LDA(At, 0, 1); PG8_STAGE_B(PG8_SB(0, 0), b2); PG8_STAGE_B(PG8_SB(0, 1), b2 + hstepB); PG8_STAGE_A(PG8_SA(0, 0), o2[0], k2);
            PG8_WAIT_V(8); PG8_WAIT_L(0); PG8_BAR; PG8_MMA(1, 0, At, B0); PG8_MMA(1, 1, At, B1); PG8_BAR; PG8_SCHED;
            PG8_LDB(B0, 1, 0); PG8_LDB(B1, 1, 1); PG8_SCHED; PG8_LDA(At, 1, 0); PG8_STAGE_A(PG8_SA(0, 1), o2[1], k2);
            PG8_WAIT_V(8); PG8_WAIT_L(0); PG8_BAR; PG8_MMA(0, 0, At, B0); PG8_MMA(0, 1, At, B1); PG8_BAR; PG8_SCHED;
            PG8_LDA(At, 1, 1); PG8_STAGE_B(PG8_SB(1, 0), b3); PG8_STAGE_B(PG8_SB(1, 1), b3 + hstepB); PG8_STAGE_A(PG8_SA(1, 0), o2[0], k3);
            PG8_WAIT_V(8); PG8_WAIT_L(0); PG8_BAR; PG8_MMA(1, 0, At, B0); PG8_MMA(1, 1, At, B1); PG8_BAR; PG8_SCHED;
        }
        if constexpr (ALIGN_EPI) { if (wr == 0) PG8_BAR; }
        E(acc, cur, wr, wc, fr, fq);
        if (!has_next) break;
#pragma unroll
        for (int a = 0; a < 2; ++a)
#pragma unroll
            for (int b = 0; b < 2; ++b)
#pragma unroll
                for (int m = 0; m < 4; ++m)
#pragma unroll
                    for (int n = 0; n < 2; ++n) acc[a][b][m][n] = (f32x4){z_, z_, z_, z_};
        cur = nxt; cB = nB; cO[0][0] = nO[0][0]; cO[0][1] = nO[0][1]; cO[1][0] = nO[1][0]; cO[1][1] = nO[1][1]; ++ui;
        if constexpr (ALIGN_EPI) { if (wr == 1) PG8_BAR; }
    }
    PG8_WAIT_V(0);
    if constexpr (!ALIGN_EPI) { if (wr == 0) PG8_BAR; }
    PG8_BAR;
#undef PG8_SA
#undef PG8_SB
#undef PG8_STAGE_A
#undef PG8_STAGE_B
#undef PG8_LDA
#undef PG8_LDB
#undef PG8_MMA
#undef PG8_WAIT_V
#undef PG8_WAIT_L
#undef PG8_BAR
#undef PG8_SCHED
}
}


#define XB_TMO      128
#define XB_XCNT(j)  (256  + 64 * (j))
#define XB_XSUB(j)  (1280 + 64 * (j))
#define XB_XGEN(j)  (2304 + 64 * (j))
#define XB_TOP      3328
#define XB_TOPGEN   3392
#define XCD_BAR_WORDS 3456
#define XB_SPIN_CAP (1u << 22)
__device__ __forceinline__ unsigned xb_ld(unsigned* p)              { return __hip_atomic_load(p, __ATOMIC_RELAXED, __HIP_MEMORY_SCOPE_AGENT); }
__device__ __forceinline__ unsigned xb_add(unsigned* p, unsigned v) { return __hip_atomic_fetch_add(p, v, __ATOMIC_RELAXED, __HIP_MEMORY_SCOPE_AGENT); }
__device__ __forceinline__ unsigned xb_xcc_id() { return (unsigned)__builtin_amdgcn_s_getreg((3 << 11) | 20) & 0xFu; }
#define XB_SPIN(cond, bar) do { unsigned _sp = 0; while (cond) { __builtin_amdgcn_s_sleep(1); \
    if ((++_sp & 255u) == 0u) { if (xb_ld(&(bar)[XB_TMO])) break; if (_sp > XB_SPIN_CAP) { atomicAdd(&(bar)[XB_TMO], 1u); break; } } } } while (0)
struct XcdBarrier { unsigned* bar; unsigned x; volatile LAS unsigned* st; };
__device__ __forceinline__ XcdBarrier xcd_barrier_post(unsigned* bar, volatile LAS unsigned* st, bool leader) {
    XcdBarrier b; b.bar = bar; b.x = xb_xcc_id(); b.st = st;
    if (leader) (void)xb_add(&bar[XB_XCNT(b.x)], 1u);
    return b;
}
__device__ __forceinline__ void xcd_barrier_complete(unsigned* bar, unsigned x, unsigned& nloc, unsigned& nx) {
    const unsigned G = gridDim.x * gridDim.y * gridDim.z;
    unsigned sum, cnt, mine, sp = 0u;
    for (;;) {
        sum = 0u; cnt = 0u; mine = 0u;
#pragma unroll
        for (unsigned j = 0; j < 16; ++j) { const unsigned c = xb_ld(&bar[XB_XCNT(j)]); sum += c; cnt += (c > 0u) ? 1u : 0u; mine = (j == x) ? c : mine; }
        if (sum == G) break;
        __builtin_amdgcn_s_sleep(1);
        if ((++sp & 255u) == 0u) { if (xb_ld(&bar[XB_TMO])) break; if (sp > XB_SPIN_CAP) { atomicAdd(&bar[XB_TMO], 1u); break; } }
    }
    nloc = mine > 0u ? mine : 1u; nx = cnt > 0u ? cnt : 1u;
}
__device__ __forceinline__ void xcd_barrier(const XcdBarrier& b, bool leader) {
    asm volatile("s_waitcnt vmcnt(0)" ::: "memory");
    __syncthreads();
    if (leader) {
        unsigned* bar = b.bar;
        __builtin_amdgcn_s_waitcnt(0);
        unsigned nloc = b.st[0], nx = b.st[1];
        if (nloc == 0u) { xcd_barrier_complete(bar, b.x, nloc, nx); b.st[0] = nloc; b.st[1] = nx; }
        const unsigned old = xb_add(&bar[XB_XSUB(b.x)], 1u);
        const unsigned gen = old / nloc;
        if (old + 1u == (gen + 1u) * nloc) {
            __builtin_amdgcn_fence(__ATOMIC_RELEASE, "agent");
            asm volatile("s_waitcnt vmcnt(0)" ::: "memory");
            const unsigned og = xb_add(&bar[XB_TOP], 1u);
            const unsigned tg = og / nx;
            if (og + 1u == (tg + 1u) * nx) xb_add(&bar[XB_TOPGEN], 1u);
            else XB_SPIN(xb_ld(&bar[XB_TOPGEN]) == tg, bar);
            __builtin_amdgcn_fence(__ATOMIC_ACQUIRE, "agent");
            xb_add(&bar[XB_XGEN(b.x)], 1u);
            asm volatile("s_waitcnt vmcnt(0)" ::: "memory");
        } else {
            XB_SPIN(xb_ld(&bar[XB_XGEN(b.x)]) == gen, bar);
            __builtin_amdgcn_fence(__ATOMIC_ACQUIRE, "agent");
            asm volatile("s_waitcnt vmcnt(0)" ::: "memory");
        }
    }
    __syncthreads();
}

constexpr int RING_BYTES = 131072;
constexpr int LC_TILE_E = RING_BYTES;
constexpr int LC_TSTART = LC_TILE_E + 1280;
constexpr int LC_CNT = LC_TSTART + 128;
constexpr int LC_ROWOFF = LC_CNT + 64;
constexpr int LDS_BYTES = 163840;
constexpr int LC_MISC = LDS_BYTES - 128;
static_assert(LC_ROWOFF + 10 * 256 * 4 <= LC_MISC, "LDS map");

struct Args { const float* in[30]; float* out; unsigned char* ws; };
typedef const __attribute__((address_space(4))) Args CArgs;
__device__ __forceinline__ CArgs* get_args() { CArgs* p = (CArgs*)__builtin_amdgcn_kernarg_segment_ptr(); asm volatile("" : "+s"(p)); return p; }

struct Frame {
    LAS unsigned char* lds; int tid, lane, wave, G, gw, NGW, bx;
};

static_assert(DEPTH == 2, "the residual-stream plumbing below (x = module input in layer 0 / its pre-norm update, bf16 latent stream XB afterwards) is written for two layers");
__device__ __forceinline__ bf16_t* xb_row(CArgs& A, int row) { return (bf16_t*)(A.ws + WS_XB) + (size_t)(row - RC) * D; }
__device__ __forceinline__ const float* xin_row(CArgs& A, int row) { return row < RC ? A.in[2] + (size_t)row * D : A.in[0] + (size_t)(row - RC) * D; }
__device__ __forceinline__ int row_bidx(int row) { return row < RC ? 8 : ((row - RC) >> 12); }

__device__ __forceinline__ float fexp2(float x) { return __builtin_amdgcn_exp2f(x); }
__device__ __forceinline__ float fexp(float x) { return __builtin_amdgcn_exp2f(x * 1.4426950408889634f); }
__device__ __forceinline__ float flog1p_small(float t) {
    return t < 0.03125f ? t * (1.0f + t * (-0.5f + t * (0.33333334f + t * (-0.25f + t * 0.2f)))) : __builtin_amdgcn_logf(1.0f + t) * 0.6931471805599453f;
}
__device__ __forceinline__ void sincos_d(float ang, float& s, float& c) {
    const float n = __builtin_rintf(ang * 0.15915494309189535f);
    float r = __builtin_fmaf(-n, 6.28125f, ang); r = __builtin_fmaf(-n, 1.9353071795864769e-3f, r); r = __builtin_fmaf(-n, 1.0253131677e-11f, r) ;
    const float rev = r * 0.15915494309189535f;
    s = __builtin_amdgcn_sinf(rev); c = __builtin_amdgcn_cosf(rev);
}

struct CvtItem { const float* src; bf16_t* dst; int N, Kdst; };
__device__ __forceinline__ bool cvt_decode(CArgs& A, int l, int it, CvtItem& c) {
    constexpr int I_IN = 16 * 80, I_OUT = 16 * 32, I_E = 16 * 32, I_GLU = 4 * 8, I_POOL = 8;
    constexpr int NITEMS = I_IN + I_OUT + NE * 3 * I_E + I_GLU + I_POOL;
    if (it >= NITEMS) return false;
    unsigned char* ws = A.ws; int r = it;
    if (r < I_IN) { const int kb = r / 80, nb = r % 80; c = {A.in[8] + (size_t)l * D * INW + (size_t)(64 * kb) * INW + 32 * nb, (bf16_t*)(ws + WS_WIN) + (size_t)(32 * nb) * D + 64 * kb, INW, D}; return true; } r -= I_IN;
    if (r < I_OUT) { const int kb = r / 32, nb = r % 32; c = {A.in[9] + (size_t)l * D * D + (size_t)(64 * kb) * D + 32 * nb, (bf16_t*)(ws + WS_WOUT) + (size_t)(32 * nb) * D + 64 * kb, D, D}; return true; } r -= I_OUT;
    if (r < NE * 3 * I_E) { const int e = r / (3 * I_E), q = (r % (3 * I_E)) / I_E, s = r % I_E, kb = s / 32, nb = s % 32, n0 = 32 * nb;
        const size_t wo = ((size_t)l * NE + e) * D * D + (size_t)(64 * kb) * D + n0;
        if (q == 0) c = {A.in[26] + wo, (bf16_t*)(ws + WS_W13) + (size_t)e * 2048 * D + (size_t)(256 * (n0 >> 7) + (n0 & 127)) * D + 64 * kb, D, D};
        else if (q == 1) c = {A.in[27] + wo, (bf16_t*)(ws + WS_W13) + (size_t)e * 2048 * D + (size_t)(256 * (n0 >> 7) + 128 + (n0 & 127)) * D + 64 * kb, D, D};
        else c = {A.in[28] + wo, (bf16_t*)(ws + WS_W2) + (size_t)e * D * D + (size_t)n0 * D + 64 * kb, D, D};
        return true; } r -= NE * 3 * I_E;
    if (r < I_GLU) { const int kb = r / 8, nb = r % 8; c = {A.in[18] + (size_t)l * 256 * 256 + (size_t)(64 * kb) * 256 + 32 * nb, (bf16_t*)(ws + WS_GLUT) + (size_t)(32 * nb) * 256 + 64 * kb, 256, 256}; return true; } r -= I_GLU;
    { const int g = r / 2, nb = r % 2; c = {A.in[22] + ((size_t)l * 4 + g) * 64 * 64 + 32 * nb, (bf16_t*)(ws + WS_POOLT) + g * 64 * 64 + (size_t)(32 * nb) * 64, 64, 64}; return true; }
}
__device__ __forceinline__ void cvt_load(const CvtItem& c, int lane, float (&v)[32]) {
#pragma unroll
    for (int i = 0; i < 32; ++i) v[i] = __builtin_nontemporal_load(c.src + (size_t)(2 * i + (lane >> 5)) * c.N + (lane & 31));
}
__device__ __forceinline__ void cvt_store(const CvtItem& c, int lane, const float (&v)[32], LAS float* scr) {
#pragma unroll
    for (int i = 0; i < 32; ++i) scr[(2 * i + (lane >> 5)) * 33 + (lane & 31)] = v[i];
    LDS_WAIT(); asm volatile("" ::: "memory");
    const int cc = lane & 7;
#pragma unroll
    for (int j = 0; j < 4; ++j) { const int n = (lane >> 3) + 8 * j; const LAS float* s = scr + (8 * cc) * 33 + n;
        u32x4 o; o.x = pk2(s[0 * 33], s[1 * 33]); o.y = pk2(s[2 * 33], s[3 * 33]); o.z = pk2(s[4 * 33], s[5 * 33]); o.w = pk2(s[6 * 33], s[7 * 33]);
        *(u32x4*)(c.dst + (size_t)n * c.Kdst + 8 * cc) = o; }
    LDS_WAIT(); asm volatile("" ::: "memory");
}
__device__ __forceinline__ void phase_weights(Frame& F, int l) {
    CArgs& A = *get_args();
    LAS float* scr = (LAS float*)(F.lds + F.wave * 16384);
    CvtItem ca, cb; float va[32], vb[32];
    constexpr int NIT_ = 16 * 80 + 16 * 32 + NE * 3 * 16 * 32 + 4 * 8 + 8;
    const int per = (NIT_ + F.G - 1) / F.G, base = F.bx * per, lim = (base + per < NIT_) ? base + per : NIT_;
    int it = base + F.wave;
    bool ha = it < lim && cvt_decode(A, l, it, ca); if (ha) cvt_load(ca, F.lane, va);
    while (ha) {
        const bool hb = it + NWAVES < lim && cvt_decode(A, l, it + NWAVES, cb); if (hb) cvt_load(cb, F.lane, vb);
        cvt_store(ca, F.lane, va, scr);
        if (!hb) break;
        it += 2 * NWAVES;
        ha = it < lim && cvt_decode(A, l, it, ca); if (ha) cvt_load(ca, F.lane, va);
        cvt_store(cb, F.lane, vb, scr);
    }
    __syncthreads();
}
__device__ __forceinline__ void phase_tables(Frame& F) {
    CArgs& A = *get_args();
    __syncthreads();
    LAS float* sc = (LAS float*)F.lds;
    LAS float* part = (LAS float*)(F.lds + 40960);
    float* MOD = (float*)(A.ws + WS_MOD);
    if (F.bx < 192) {
        for (int i = F.tid; i < 9 * 1024; i += NTHR) { const int r = i >> 10, k = i & 1023; const float v = r < 8 ? A.in[1][r * 1024 + k] : A.in[3][k]; sc[i] = siluf_(v); }
        __syncthreads();
        for (int it = F.bx; it < 192; it += F.G) {
            const int l = it / 96, cg = it % 96, cq = F.tid & 15, ks = F.tid >> 4;
            const float* W = A.in[4] + (size_t)l * D * 6144 + cg * 64 + cq * 4;
            f32x4 acc[9];
#pragma unroll
            for (int r = 0; r < 9; ++r) acc[r] = zero4();
#pragma unroll 1
            for (int half = 0; half < 2; ++half) { f32x4 w[16];
#pragma unroll
                for (int j = 0; j < 16; ++j) w[j] = __builtin_nontemporal_load((const f32x4*)(W + (size_t)(ks * 32 + half * 16 + j) * 6144));
#pragma unroll
                for (int j = 0; j < 16; ++j) { const int k = ks * 32 + half * 16 + j;
#pragma unroll
                    for (int r = 0; r < 9; ++r) acc[r] = acc[r] + w[j] * sc[r * 1024 + k]; } }
#pragma unroll
            for (int r = 0; r < 9; ++r) *(LAS f32x4*)(part + (ks * 9 + r) * 64 + cq * 4) = acc[r];
            __syncthreads();
            for (int idx = F.tid; idx < 576; idx += NTHR) { const int r = idx >> 6, c = idx & 63; float s = A.in[5][l * 6144 + cg * 64 + c];
#pragma unroll 8
                for (int k8 = 0; k8 < 32; ++k8) s += part[(k8 * 9 + r) * 64 + c];
                MOD[(l * 9 + r) * 6144 + cg * 64 + c] = s; }
            __syncthreads();
        }
    }
    f32x2* ROT = (f32x2*)(A.ws + WS_ROT);
    for (int idx = F.bx * NTHR + F.tid; idx < NPOS * 32; idx += F.G * NTHR) {
        const int pos = idx >> 5, i = idx & 31; const float inv = fexp2(-(float)i * (13.287712379549449f / 32.0f));   const float ang = (float)pos * inv; float s, c; sincos_d(ang, s, c); ROT[(pos << 5) + (((i >> 1) & 3) << 3) + ((i >> 3) << 1) + (i & 1)] = (f32x2){c, s};
    }
    __syncthreads();
}

struct RowComb { float g1, g2; const bf16_t* y1; const bf16_t* y2; };
__device__ __forceinline__ void load_row(const float* p, int lane, f32x4 (&v)[4]) {
#pragma unroll
    for (int j = 0; j < 4; ++j) v[j] = ((const f32x4*)p)[lane + 64 * j];
}
__device__ __forceinline__ void store_row(float* p, int lane, const f32x4 (&v)[4]) {
#pragma unroll
    for (int j = 0; j < 4; ++j) __builtin_nontemporal_store(v[j], (f32x4*)p + lane + 64 * j);
}
__device__ __forceinline__ void moe_combine(CArgs& A, int lp, int row, int lane, const LAS int* tstart, f32x4 (&v)[4]) {
    const int* TOKE = (const int*)(A.ws + WS_TOKE); const int* TOKP = (const int*)(A.ws + WS_TOKP); const float* TOKG = (const float*)(A.ws + WS_TOKG);
    const int e1 = TOKE[row * 2], e2 = TOKE[row * 2 + 1], p1 = TOKP[row * 2], p2 = TOKP[row * 2 + 1];
    const float g1 = TOKG[row * 2], g2 = TOKG[row * 2 + 1];
    const size_t s1 = (size_t)tstart[e1] * 256 + p1, s2 = (size_t)tstart[e2] * 256 + p2;
    const bf16_t* Y = (const bf16_t*)(A.ws + WS_Y);
    const float* gt = (const float*)(A.ws + WS_MOD) + (size_t)(lp * 9 + row_bidx(row)) * 6144 + 5 * 1024;
#pragma unroll
    for (int j = 0; j < 4; ++j) { const u32x2 a = ((const u32x2*)(Y + s1 * 1024))[lane + 64 * j], b = ((const u32x2*)(Y + s2 * 1024))[lane + 64 * j]; const f32x4 g = ((const f32x4*)gt)[lane + 64 * j];
        v[j].x += g.x * (g1 * bflo(a.x) + g2 * bflo(b.x)); v[j].y += g.y * (g1 * bfhi(a.x) + g2 * bfhi(b.x));
        v[j].z += g.z * (g1 * bflo(a.y) + g2 * bflo(b.y)); v[j].w += g.w * (g1 * bfhi(a.y) + g2 * bfhi(b.y)); }
}
__device__ __forceinline__ void add_mixer(CArgs& A, int l, int row, int lane, f32x4 (&v)[4]) {
    const bf16_t* y = (const bf16_t*)(A.ws + WS_YO) + (size_t)row * D;
    const float* gt = (const float*)(A.ws + WS_MOD) + (size_t)(l * 9 + row_bidx(row)) * 6144 + 2 * 1024;
#pragma unroll
    for (int j = 0; j < 4; ++j) { const u32x2 a = ((const u32x2*)y)[lane + 64 * j]; const f32x4 g = ((const f32x4*)gt)[lane + 64 * j];
        v[j].x += g.x * bflo(a.x); v[j].y += g.y * bfhi(a.x); v[j].z += g.z * bflo(a.y); v[j].w += g.w * bfhi(a.y); }
}
__device__ __forceinline__ void build_tstart(Frame& F, int lp) {
    LAS int* tstart = (LAS int*)(F.lds + LC_TSTART); LAS int* cnt = (LAS int*)(F.lds + LC_CNT);
    const unsigned* gcnt = (const unsigned*)(get_args()->ws + WS_CTL) + CW_GCNT + lp * 16;
    __syncthreads();
    if (F.tid == 0) { int s = 0; for (int e = 0; e < NE; ++e) { const int c = (int)__hip_atomic_load(gcnt + e, __ATOMIC_RELAXED, __HIP_MEMORY_SCOPE_AGENT); cnt[e] = c; tstart[e] = s; s += (c + 255) >> 8; } tstart[NE] = s; }
    __syncthreads();
}
__device__ __forceinline__ float row_rstd(const f32x4 (&v)[4]) {
    float ss = 0.f;
#pragma unroll
    for (int j = 0; j < 4; ++j) ss += (v[j].x * v[j].x + v[j].y * v[j].y) + (v[j].z * v[j].z + v[j].w * v[j].w);
    return 1.0f / sqrtf(wave_sum(ss) * (1.0f / D) + 1e-6f);
}
__device__ __forceinline__ void norm_mod_store(const f32x4 (&v)[4], float rstd, const float* nw, const float* sc, const float* sh, bf16_t* orow, int lane, f32x4 (*keep)[4]) {
#pragma unroll
    for (int j = 0; j < 4; ++j) { const f32x4 w = ((const f32x4*)nw)[lane + 64 * j], s = ((const f32x4*)sc)[lane + 64 * j], b = ((const f32x4*)sh)[lane + 64 * j];
        const f32x4 h = v[j] * rstd * w * (s + 1.0f) + b; if (keep) (*keep)[j] = h;
        u32x2 o; o.x = pk2(h.x, h.y); o.y = pk2(h.z, h.w); ((u32x2*)orow)[lane + 64 * j] = o; }
}
struct WideRow { u32x4 c0, c1; };
__device__ __forceinline__ void wide_load(WideRow& W, const bf16_t* row, int lane, bool nt) {
    const u32x4* p0 = (const u32x4*)(row + 8 * (lane >> 1) + 256 * (2 * (lane & 1))); const u32x4* p1 = p0 + 32;
    if (nt) { W.c0 = __builtin_nontemporal_load(p0); W.c1 = __builtin_nontemporal_load(p1); } else { W.c0 = *p0; W.c1 = *p1; }
}
__device__ __forceinline__ void wide_unpack(const WideRow& W, int lane, u32x2 (&o)[4]) {
    const bool odd = lane & 1;
    const unsigned s0 = odd ? W.c0.x : W.c0.z, s1 = odd ? W.c0.y : W.c0.w, s2 = odd ? W.c1.x : W.c1.z, s3 = odd ? W.c1.y : W.c1.w;
    const unsigned r0 = __shfl_xor(s0, 1), r1 = __shfl_xor(s1, 1), r2 = __shfl_xor(s2, 1), r3 = __shfl_xor(s3, 1);
    if (!odd) { o[0] = (u32x2){W.c0.x, W.c0.y}; o[1] = (u32x2){W.c1.x, W.c1.y}; o[2] = (u32x2){r0, r1}; o[3] = (u32x2){r2, r3}; }
    else      { o[0] = (u32x2){r0, r1}; o[1] = (u32x2){r2, r3}; o[2] = (u32x2){W.c0.z, W.c0.w}; o[3] = (u32x2){W.c1.z, W.c1.w}; }
}
__device__ __forceinline__ void wide_store(bf16_t* row, int lane, const u32x2 (&o)[4]) {
    const bool odd = lane & 1;
    const unsigned s0 = odd ? o[0].x : o[2].x, s1 = odd ? o[0].y : o[2].y, s2 = odd ? o[1].x : o[3].x, s3 = odd ? o[1].y : o[3].y;
    const unsigned r0 = __shfl_xor(s0, 1), r1 = __shfl_xor(s1, 1), r2 = __shfl_xor(s2, 1), r3 = __shfl_xor(s3, 1);
    u32x4 c0, c1;
    if (!odd) { c0 = (u32x4){o[0].x, o[0].y, r0, r1}; c1 = (u32x4){o[1].x, o[1].y, r2, r3}; }
    else      { c0 = (u32x4){r0, r1, o[2].x, o[2].y}; c1 = (u32x4){r2, r3, o[3].x, o[3].y}; }
    u32x4* p0 = (u32x4*)(row + 8 * (lane >> 1) + 256 * (2 * (lane & 1)));
    p0[0] = c0; p0[32] = c1;
}
struct RowRaw { f32x4 x[4]; WideRow xw, y, m1, m2; float g1, g2; int e1, e2, p1, p2; };
template <int MODE> __device__ __forceinline__ void row_issue1(RowRaw& R, CArgs& A, int l, int row, int lane) {
    if (MODE == 2) wide_load(R.xw, xb_row(A, row), lane, false);
    else { const float* src = xin_row(A, row);
#pragma unroll
        for (int j = 0; j < 4; ++j) R.x[j] = ((const f32x4*)src)[lane + 64 * j]; }
    if (MODE != 0) {
        wide_load(R.y, (const bf16_t*)(A.ws + WS_YO) + (size_t)row * D, lane, false);
        const int* TOKE = (const int*)(A.ws + WS_TOKE); const int* TOKP = (const int*)(A.ws + WS_TOKP); const float* TOKG = (const float*)(A.ws + WS_TOKG);
        R.e1 = TOKE[row * 2]; R.e2 = TOKE[row * 2 + 1]; R.p1 = TOKP[row * 2]; R.p2 = TOKP[row * 2 + 1]; R.g1 = TOKG[row * 2]; R.g2 = TOKG[row * 2 + 1];
    }
}
template <int MODE> __device__ __forceinline__ void row_issue2(RowRaw& R, CArgs& A, const LAS int* tstart, int lane) {
    if (MODE != 0) {
        const bf16_t* Y = (const bf16_t*)(A.ws + WS_Y);
        const size_t s1 = (size_t)tstart[R.e1] * 256 + R.p1, s2 = (size_t)tstart[R.e2] * 256 + R.p2;
        wide_load(R.m1, Y + s1 * 1024, lane, false); wide_load(R.m2, Y + s2 * 1024, lane, false);
    }
}
struct RowVec { f32x4 ws[4], sh[4], ga[4], gf[4]; };
template <int MODE> __device__ __forceinline__ void row_vecs(RowVec& V, CArgs& A, int l, int b, int lane) {
    const float* MOD = (const float*)(A.ws + WS_MOD);
    if (MODE != 2) { const float* m = MOD + (size_t)(l * 9 + b) * 6144; const float* nw = A.in[6] + l * D;
#pragma unroll
        for (int j = 0; j < 4; ++j) { const f32x4 w = ((const f32x4*)nw)[lane + 64 * j], s = ((const f32x4*)(m + 1024))[lane + 64 * j]; V.ws[j] = w * (s + 1.0f); V.sh[j] = ((const f32x4*)m)[lane + 64 * j]; }
    } else {
#pragma unroll
        for (int j = 0; j < 4; ++j) V.ws[j] = ((const f32x4*)A.in[29])[lane + 64 * j];
    }
    if (MODE != 0) { const int lp = MODE == 1 ? l - 1 : DEPTH - 1; const float* mp = MOD + (size_t)(lp * 9 + b) * 6144;
#pragma unroll
        for (int j = 0; j < 4; ++j) { V.ga[j] = ((const f32x4*)(mp + 2 * 1024))[lane + 64 * j]; V.gf[j] = ((const f32x4*)(mp + 5 * 1024))[lane + 64 * j]; }
    }
}
template <int MODE> __device__ __forceinline__ void row_finish(RowRaw& R, const RowVec& V, CArgs& A, int row, int lane) {
    f32x4 v[4];
    if (MODE == 2) { u32x2 xx[4]; wide_unpack(R.xw, lane, xx);
#pragma unroll
        for (int j = 0; j < 4; ++j) v[j] = (f32x4){bflo(xx[j].x), bfhi(xx[j].x), bflo(xx[j].y), bfhi(xx[j].y)}; }
    else {
#pragma unroll
        for (int j = 0; j < 4; ++j) v[j] = R.x[j]; }
    if (MODE != 0) {
        u32x2 yy[4], aa[4], bb[4]; wide_unpack(R.y, lane, yy); wide_unpack(R.m1, lane, aa); wide_unpack(R.m2, lane, bb);
#pragma unroll
        for (int j = 0; j < 4; ++j) { const f32x4 ga = V.ga[j], gf = V.gf[j];
            const u32x2 y = yy[j], a = aa[j], b = bb[j];
            v[j].x += ga.x * bflo(y.x) + gf.x * (R.g1 * bflo(a.x) + R.g2 * bflo(b.x)); v[j].y += ga.y * bfhi(y.x) + gf.y * (R.g1 * bfhi(a.x) + R.g2 * bfhi(b.x));
            v[j].z += ga.z * bflo(y.y) + gf.z * (R.g1 * bflo(a.y) + R.g2 * bflo(b.y)); v[j].w += ga.w * bfhi(y.y) + gf.w * (R.g1 * bfhi(a.y) + R.g2 * bfhi(b.y)); }
        if (MODE == 1 && row >= RC) { u32x2 xo[4];
#pragma unroll
            for (int j = 0; j < 4; ++j) { xo[j].x = pk2(v[j].x, v[j].y); xo[j].y = pk2(v[j].z, v[j].w); }
            wide_store(xb_row(A, row), lane, xo); }
    }
    const float rstd = row_rstd(v);
    if (MODE == 2) {
#pragma unroll
        for (int j = 0; j < 4; ++j) v[j] = v[j] * rstd * V.ws[j];
        store_row(A.out + (size_t)(row - RC) * D, lane, v);
    } else {
        bf16_t* orow = (bf16_t*)((unsigned char*)A.out) + (size_t)row * D; u32x2 oo[4];
#pragma unroll
        for (int j = 0; j < 4; ++j) { const f32x4 h = v[j] * rstd * V.ws[j] + V.sh[j]; oo[j].x = pk2(h.x, h.y); oo[j].y = pk2(h.z, h.w); }
        wide_store(orow, lane, oo);
    }
}
template <int MODE> __device__ __forceinline__ void row_phase(Frame& F, int l) {
    CArgs& A = *get_args();
    if (MODE != 0) build_tstart(F, MODE == 1 ? l - 1 : DEPTH - 1);
    const LAS int* tstart = (const LAS int*)(F.lds + LC_TSTART);
    const int r0 = MODE == 2 ? RC : 0, per = (RT - r0 + F.NGW - 1) / F.NGW;
    const int rb = r0 + F.gw * per, re = rb + per < RT ? rb + per : RT;
    RowVec V; int bprev = -1;
    for (int row = rb; row < re; row += 2) {
        const int rowB = row + 1; const bool hasB = rowB < re;
        RowRaw Ra, Rb;
        row_issue1<MODE>(Ra, A, l, row, F.lane); if (hasB) row_issue1<MODE>(Rb, A, l, rowB, F.lane);
        row_issue2<MODE>(Ra, A, tstart, F.lane); if (hasB) row_issue2<MODE>(Rb, A, tstart, F.lane);
        { const int b = row_bidx(row); if (b != bprev) { row_vecs<MODE>(V, A, l, b, F.lane); bprev = b; } }
        row_finish<MODE>(Ra, V, A, row, F.lane);
        if (hasB) { const int b = row_bidx(rowB); if (b != bprev) { row_vecs<MODE>(V, A, l, b, F.lane); bprev = b; } row_finish<MODE>(Rb, V, A, rowB, F.lane); }
    }
}
__device__ __forceinline__ void phase_prenorm(Frame& F, int l) { if (l == 0) row_phase<0>(F, l); else row_phase<1>(F, l); }
__device__ __forceinline__ void phase_final(Frame& F) { row_phase<2>(F, DEPTH - 1); }
constexpr size_t WS_RWP = WS_S5M + 6 * MiB;
constexpr size_t WS_WP = WS_S5M + 6 * MiB + 640 * 1024;
constexpr size_t WS_CB = WS_S5M + 6 * MiB + 704 * 1024;
__device__ __forceinline__ void router_precompute(Frame& F, int l) {
    CArgs& A = *get_args();
    const float* MOD = (const float*)(A.ws + WS_MOD);
    bf16_t* RWP = (bf16_t*)(A.ws + WS_RWP); float* WP = (float*)(A.ws + WS_WP); float* CB = (float*)(A.ws + WS_CB);
    for (int it = F.bx; it < 9 * 16; it += F.G) { const int b = it >> 4, e = it & 15;
        const float* m = MOD + (size_t)(l * 9 + b) * 6144;
        float s = 0.f;
        for (int k = F.tid; k < 1024; k += NTHR) { const float wp = A.in[7][l * D + k] * (1.0f + m[4 * 1024 + k]); if (e == 0) WP[b * 1024 + k] = wp;
            const float rw = A.in[24][k * 16 + e], v = wp * rw; const unsigned h = f2bf(v); const float r = v - bf2f(h);
            RWP[((size_t)(b * 2 + 0) * 16 + e) * 1024 + k] = (bf16_t)h; RWP[((size_t)(b * 2 + 1) * 16 + e) * 1024 + k] = (bf16_t)f2bf(r);
            s += m[3 * 1024 + k] * rw; }
        s = wave_sum(s);
        LAS float* red = (LAS float*)F.lds;
        __syncthreads(); if (F.lane == 0) red[F.wave] = s; __syncthreads();
        if (F.tid == 0) { float t = 0.f; for (int w = 0; w < NWAVES; ++w) t += red[w]; CB[b * 16 + e] = t; }
    }
}
__device__ __forceinline__ unsigned pk_hi(float a, float b, float& ra, float& rb) { const unsigned ha = f2bf(a), hb = f2bf(b); ra = a - bf2f(ha); rb = b - bf2f(hb); return ha | (hb << 16); }
struct RtRaw { f32x4 xa[4], xb[4]; u32x4 xw[4], yy[4]; };
__device__ __forceinline__ void rt_load(RtRaw& R, CArgs& A, int l, int T, int r, int kq, int w) {
    const int row = T * 16 + r;
    const bf16_t* yr = (const bf16_t*)(A.ws + WS_YO) + (size_t)row * D + 128 * w + 8 * kq;
    if (l == 0) { const float* xr = xin_row(A, row) + 128 * w + 8 * kq;
#pragma unroll
        for (int s = 0; s < 4; ++s) { R.xa[s] = *(const f32x4*)(xr + s * 32); R.xb[s] = *(const f32x4*)(xr + s * 32 + 4); R.yy[s] = *(const u32x4*)(yr + s * 32); }
    } else { const bf16_t* xr = xb_row(A, row) + 128 * w + 8 * kq;
#pragma unroll
        for (int s = 0; s < 4; ++s) { R.xw[s] = *(const u32x4*)(xr + s * 32); R.yy[s] = *(const u32x4*)(yr + s * 32); }
    }
}
__device__ __forceinline__ void phase_router(Frame& F, int l) {
    CArgs& A = *get_args();
    __syncthreads();
    LAS int* lcnt = (LAS int*)F.lds;
    LAS int* rec = lcnt + 64;
    LAS float* part = (LAS float*)(F.lds + 16384);
    if (F.tid < 64) lcnt[F.tid] = 0;
    __syncthreads();
    bf16_t* FB = (bf16_t*)((unsigned char*)A.out);
    int* TOKE = (int*)(A.ws + WS_TOKE); int* TOKP = (int*)(A.ws + WS_TOKP); float* TOKG = (float*)(A.ws + WS_TOKG); int* LIST = (int*)(A.ws + WS_LIST);
    const bf16_t* RWP = (const bf16_t*)(A.ws + WS_RWP); const float* WP = (const float*)(A.ws + WS_WP); const float* CB = (const float*)(A.ws + WS_CB);
    const float* MOD = (const float*)(A.ws + WS_MOD);
    const int lane = F.lane, r = lane & 15, kq = lane >> 4, w = F.wave;
    const int t0 = (l == DEPTH - 1) ? RC / 16 : 0, nt = RT / 16 - t0;
    const int tb = t0 + (int)((long)F.bx * nt / F.G), te = t0 + (int)((long)(F.bx + 1) * nt / F.G);
    RtRaw R;
    if (tb < te) rt_load(R, A, l, tb, r, kq, w);
    int par = 0, bprev = -1; f32x4 pg0[4], pg1[4]; bf16x8 pwh[4], pwl[4];
    for (int T = tb; T < te; ++T, par ^= 1) {
        const int row = T * 16 + r, b = row_bidx(T * 16);
        const RtRaw C = R;
        if (T + 1 < te) rt_load(R, A, l, T + 1, r, kq, w);
        if (b != bprev) {
            const float* ga = MOD + (size_t)(l * 9 + b) * 6144 + 2 * 1024 + 128 * w + 8 * kq;
            const bf16_t* bh = RWP + (size_t)(b * 2 + 0) * 16 * 1024 + 128 * w, * bl = RWP + (size_t)(b * 2 + 1) * 16 * 1024 + 128 * w;
#pragma unroll
            for (int s = 0; s < 4; ++s) { pg0[s] = *(const f32x4*)(ga + s * 32); pg1[s] = *(const f32x4*)(ga + s * 32 + 4); pwh[s] = gfrag(bh, 1024, s * 32, lane); pwl[s] = gfrag(bl, 1024, s * 32, lane); }
            bprev = b; }
        float x[4][8]; f32x4 acc = zero4(); float ss = 0.f;
#pragma unroll
        for (int s = 0; s < 4; ++s) {
            const f32x4 g0 = pg0[s], g1 = pg1[s]; const u32x4 yy = C.yy[s];
            f32x4 xa, xb;
            if (l == 0) { xa = C.xa[s]; xb = C.xb[s]; } else { const u32x4 xw = C.xw[s]; xa = (f32x4){bflo(xw.x), bfhi(xw.x), bflo(xw.y), bfhi(xw.y)}; xb = (f32x4){bflo(xw.z), bfhi(xw.z), bflo(xw.w), bfhi(xw.w)}; }
            x[s][0] = xa.x + g0.x * bflo(yy.x); x[s][1] = xa.y + g0.y * bfhi(yy.x); x[s][2] = xa.z + g0.z * bflo(yy.y); x[s][3] = xa.w + g0.w * bfhi(yy.y);
            x[s][4] = xb.x + g1.x * bflo(yy.z); x[s][5] = xb.y + g1.y * bfhi(yy.z); x[s][6] = xb.z + g1.z * bflo(yy.w); x[s][7] = xb.w + g1.w * bfhi(yy.w);
            u32x4 h, lo;
#pragma unroll
            for (int e2 = 0; e2 < 4; ++e2) { const float a = x[s][2 * e2], bb = x[s][2 * e2 + 1]; ss += a * a + bb * bb;
                const unsigned ua = __builtin_bit_cast(unsigned, a), ub = __builtin_bit_cast(unsigned, bb);
                h[e2] = __builtin_amdgcn_perm(ub, ua, 0x07060302u);
                lo[e2] = pk2(a - __builtin_bit_cast(float, ua & 0xffff0000u), bb - __builtin_bit_cast(float, ub & 0xffff0000u)); }
            const bf16x8 xh = __builtin_bit_cast(bf16x8, h), xl = __builtin_bit_cast(bf16x8, lo);
            const bf16x8 wh = pwh[s], wl = pwl[s];
            acc = __builtin_amdgcn_mfma_f32_16x16x32_bf16(wh, xh, acc, 0, 0, 0);
            acc = __builtin_amdgcn_mfma_f32_16x16x32_bf16(wl, xh, acc, 0, 0, 0);
            acc = __builtin_amdgcn_mfma_f32_16x16x32_bf16(wh, xl, acc, 0, 0, 0);
        }
        ss += __shfl_xor(ss, 16); ss += __shfl_xor(ss, 32);
        LAS float* pp = part + ((par * 8 + w) * 64 + lane) * 5;
        pp[0] = acc[0]; pp[1] = acc[1]; pp[2] = acc[2]; pp[3] = acc[3]; pp[4] = ss;
        LDS_BARRIER();
        f32x4 lgs = zero4(); float sst = 0.f;
#pragma unroll
        for (int ww = 0; ww < 8; ++ww) { const LAS float* qq = part + ((par * 8 + ww) * 64 + lane) * 5; lgs[0] += qq[0]; lgs[1] += qq[1]; lgs[2] += qq[2]; lgs[3] += qq[3]; sst += qq[4]; }
        const float rstd = 1.0f / sqrtf(sst * (1.0f / D) + 1e-6f);
        if (w == 0) {
            const f32x4 cb = *(const f32x4*)(CB + b * 16 + 4 * kq), bias = *(const f32x4*)(A.in[25] + 4 * kq);
            float lg[4], pr[4], sel[4];
#pragma unroll
            for (int j = 0; j < 4; ++j) lg[j] = rstd * lgs[j] + cb[j];
            float mx = fmaxf(fmaxf(lg[0], lg[1]), fmaxf(lg[2], lg[3])); mx = fmaxf(mx, __shfl_xor(mx, 16)); mx = fmaxf(mx, __shfl_xor(mx, 32));
            float ps = 0.f;
#pragma unroll
            for (int j = 0; j < 4; ++j) { pr[j] = __expf(lg[j] - mx); ps += pr[j]; }
            ps += __shfl_xor(ps, 16); ps += __shfl_xor(ps, 32);
            const float ips = 1.0f / ps;
            float f1 = -INFINITY, f2 = -INFINITY;
#pragma unroll
            for (int j = 0; j < 4; ++j) { pr[j] *= ips; sel[j] = pr[j] + bias[j]; const float xx = sel[j]; if (xx > f1) { f2 = f1; f1 = xx; } else if (xx > f2) f2 = xx; }
            const float gs = f1 + f2;
            int bg = 0; float bs = __shfl(gs, r);
#pragma unroll
            for (int g = 1; g < 4; ++g) { const float o = __shfl(gs, r + 16 * g); if (o > bs) { bs = o; bg = g; } }
            if (kq == bg) {
                int i1 = 0; float b1 = sel[0], q1 = pr[0];
#pragma unroll
                for (int j = 1; j < 4; ++j) if (sel[j] > b1) { b1 = sel[j]; i1 = j; q1 = pr[j]; }
                int i2 = -1; float b2 = -INFINITY, q2 = 0.f;
#pragma unroll
                for (int j = 0; j < 4; ++j) if (j != i1 && sel[j] > b2) { b2 = sel[j]; i2 = j; q2 = pr[j]; }
                const int e1 = bg * 4 + i1, e2 = bg * 4 + i2; const float gsum = q1 + q2;
                const int lp1 = atomicAdd((int*)(lcnt + e1), 1), lp2 = atomicAdd((int*)(lcnt + e2), 1), ri = atomicAdd((int*)(lcnt + 32), 1);
                LAS int* r5 = rec + ri * 5; r5[0] = row; r5[1] = e1; r5[2] = lp1; r5[3] = e2; r5[4] = lp2;
                TOKG[row * 2] = q1 / gsum; TOKG[row * 2 + 1] = q2 / gsum;
            }
        }
        const float* wp = WP + b * 1024 + 128 * w + 8 * kq; const float* sh = MOD + (size_t)(l * 9 + b) * 6144 + 3 * 1024 + 128 * w + 8 * kq;
        bf16_t* fo = FB + (size_t)row * D + 128 * w + 8 * kq;
#pragma unroll
        for (int s = 0; s < 4; ++s) {
            const f32x4 w0 = *(const f32x4*)(wp + s * 32), w1 = *(const f32x4*)(wp + s * 32 + 4), s0 = *(const f32x4*)(sh + s * 32), s1 = *(const f32x4*)(sh + s * 32 + 4);
            u32x4 o; o.x = pk2(x[s][0] * rstd * w0.x + s0.x, x[s][1] * rstd * w0.y + s0.y); o.y = pk2(x[s][2] * rstd * w0.z + s0.z, x[s][3] * rstd * w0.w + s0.w);
            o.z = pk2(x[s][4] * rstd * w1.x + s1.x, x[s][5] * rstd * w1.y + s1.y); o.w = pk2(x[s][6] * rstd * w1.z + s1.z, x[s][7] * rstd * w1.w + s1.w);
            *(u32x4*)(fo + s * 32) = o;
        }
    }
    __syncthreads();
    unsigned* gcnt = (unsigned*)(A.ws + WS_CTL) + CW_GCNT + l * 16;
    if (F.tid < 16) lcnt[16 + F.tid] = (int)__hip_atomic_fetch_add(gcnt + F.tid, (unsigned)lcnt[F.tid], __ATOMIC_RELAXED, __HIP_MEMORY_SCOPE_AGENT);
    __syncthreads();
    const int nrec = lcnt[32];
    for (int i = F.tid; i < nrec; i += NTHR) { const LAS int* r5 = rec + i * 5; const int row = r5[0], e1 = r5[1], e2 = r5[3], p1 = lcnt[16 + e1] + r5[2], p2 = lcnt[16 + e2] + r5[4];
        TOKE[row * 2] = e1; TOKE[row * 2 + 1] = e2; TOKP[row * 2] = p1; TOKP[row * 2 + 1] = p2; LIST[(size_t)e1 * RT + p1] = row; LIST[(size_t)e2 * RT + p2] = row; }
    __syncthreads();
}

__device__ __forceinline__ void phase_gemm_in(Frame& F) {
    CArgs& A = *get_args();
    pg8::DenseOrder S; S.init(RT / 256, INW / 256, F.G, F.bx, 0, D, A.ws + WS_WIN);
    pg8::EpiIn E{(bf16_t*)(A.ws + WS_Z), (bf16_t*)(A.ws + WS_A2)};
    pg8::gemm_phase<pg8::EpiIn, pg8::DenseOrder, true>(F.lds, F.tid, (const char*)((unsigned char*)A.out), D, S, E);
}
__device__ __forceinline__ void phase_gemm_out(Frame& F, int l) {
    CArgs& A = *get_args();
    const bool lastl = (l == DEPTH - 1);
    pg8::DenseOrder S; S.init(lastl ? RL / 256 : RT / 256, D / 256, F.G, F.bx, lastl ? 8 : 0, D, A.ws + WS_WOUT);
    pg8::EpiBf16 E{(bf16_t*)(A.ws + WS_YO), D};
    pg8::gemm_phase<pg8::EpiBf16, pg8::DenseOrder, true>(F.lds, F.tid, (const char*)((unsigned char*)A.out), D, S, E);
}
__device__ __forceinline__ int build_moe_tables(Frame& F, int l, int nN, bool gather) {
    CArgs& A = *get_args();
    build_tstart(F, l);
    const LAS int* tstart = (const LAS int*)(F.lds + LC_TSTART); const LAS int* cnt = (const LAS int*)(F.lds + LC_CNT);
    LAS int* tile_e = (LAS int*)(F.lds + LC_TILE_E); LAS unsigned* rowoff = (LAS unsigned*)(F.lds + LC_ROWOFF);
    const int ntiles = tstart[NE];
    for (int t = F.tid; t < ntiles; t += NTHR) { int e = 0;
#pragma unroll
        for (int q = 1; q < NE; ++q) if (t >= tstart[q]) e = q;
        tile_e[t] = e; }
    __syncthreads();
    if (gather) {
        const int* LIST = (const int*)(A.ws + WS_LIST);
        const pg8::MoeOrder So{ntiles, nN, F.G, F.bx, D, nullptr, 0, (const LAS int*)tile_e, nullptr, true};
        for (int i = 0; i < 10; ++i) { pg8::Unit u; if (!So.next(i, u)) break;
            const int tile = u.pm, e = tile_e[tile], lt = tile - tstart[e];
            for (int r = F.tid; r < 256; r += NTHR) { const int j = lt * 256 + r; const int tok = j < cnt[e] ? LIST[(size_t)e * RT + j] : 0; rowoff[i * 256 + r] = (unsigned)tok * (unsigned)(D * 2); } }
        __syncthreads();
    }
    return ntiles;
}
__device__ __forceinline__ void phase_moe1(Frame& F, int l) {
    CArgs& A = *get_args();
    const int ntiles = build_moe_tables(F, l, 8, true);
    pg8::MoeOrder S{ntiles, 8, F.G, F.bx, D, (const char*)(A.ws + WS_W13), (size_t)2048 * D * 2, (const LAS int*)(F.lds + LC_TILE_E), (const LAS unsigned*)(F.lds + LC_ROWOFF), true};
    pg8::EpiSwiGLU E{(bf16_t*)(A.ws + WS_Z)};
    pg8::gemm_phase<pg8::EpiSwiGLU, pg8::MoeOrder, true>(F.lds, F.tid, (const char*)((unsigned char*)A.out), D, S, E);
}
__device__ __forceinline__ void phase_moe2(Frame& F, int l) {
    CArgs& A = *get_args();
    const int ntiles = build_moe_tables(F, l, 4, false);
    pg8::MoeOrder S{ntiles, 4, F.G, F.bx, D, (const char*)(A.ws + WS_W2), (size_t)D * D * 2, (const LAS int*)(F.lds + LC_TILE_E), nullptr, true};
    pg8::EpiBf16 E{(bf16_t*)(A.ws + WS_Y), D};
    pg8::gemm_phase<pg8::EpiBf16, pg8::MoeOrder, true>(F.lds, F.tid, (const char*)(A.ws + WS_Z), D, S, E);
}

#ifndef PROBE_DUP
#define PROBE_DUP 0
#endif
#define DUP(bit) _Pragma("unroll") for (int rep_ = 0; rep_ < (((PROBE_DUP) >> (bit)) & 1) + 1; ++rep_)
constexpr size_t WS_S5W1 = WS_S5M;
constexpr size_t WS_S5W2 = WS_S5M + 2 * MiB;
constexpr int S5T = 16, NCR = RT / S5T;
constexpr int NCH = 34;

__device__ __forceinline__ float log2_gamma(CArgs& A, int l, int dir, int hd) { const float dl = A.in[20][(l * 2 + dir) * 8 + hd]; return (fminf(dl, 0.f) - flog1p_small(fexp(-fabsf(dl)))) * 1.4426950408889634f; }
__device__ __forceinline__ int ret_row0(int b, int c) { return c < 2 ? b * CTXL + 128 * c : RC + b * SEQ + 128 * (c - 2); }
__device__ __forceinline__ int ret_pos0(int c) { return c < 2 ? 128 * c : CTXL + 128 * (c - 2); }
__device__ __forceinline__ void unpack8(u32x4 w, float (&f)[8]) { f[0] = bflo(w.x); f[1] = bfhi(w.x); f[2] = bflo(w.y); f[3] = bfhi(w.y); f[4] = bflo(w.z); f[5] = bfhi(w.z); f[6] = bflo(w.w); f[7] = bfhi(w.w); }

__device__ __forceinline__ void pool_item(Frame& F, CArgs& A, int l, int rowbase, int j0, int n) {
    LAS bf16_t* Ps = (LAS bf16_t*)F.lds;
    LAS bf16_t* Pl = (LAS bf16_t*)(F.lds + 40960);
    const bf16_t* Z = (const bf16_t*)(A.ws + WS_Z);
    LDS_BARRIER();
    for (int idx = F.tid; idx < 80 * 32; idx += NTHR) { const int r = idx >> 5, ch = idx & 31, jj = j0 - 8 + r;
        u32x4 v = (u32x4){0u, 0u, 0u, 0u}; if (jj >= 0 && jj < n) v = *(const u32x4*)(Z + (size_t)(rowbase + jj) * INW + OFF_P + ch * 8);
        *(LAS u32x4*)(Ps + r * 256 + ch * 8) = v; }
    LDS_BARRIER();
    {
        const int ch = F.tid & 31, tr = F.tid >> 5, g = ch >> 3, win = 2 << g, hw = win >> 1;
        const LAS bf16_t* col = Ps + ch * 8;
        float s[8];
#pragma unroll
        for (int e = 0; e < 8; ++e) s[e] = 0.f;
        const int t0 = tr * 4;
        for (int qq = t0 - hw; qq < t0 - hw + win; ++qq) { float f[8]; unpack8(*(const LAS u32x4*)(col + (qq + 8) * 256), f);
#pragma unroll
            for (int e = 0; e < 8; ++e) s[e] += f[e]; }
#pragma unroll
        for (int tt = 0; tt < 4; ++tt) { const int t = t0 + tt, j = j0 + t;
            int lo = j - hw; if (lo < 0) lo = 0; int hi = j - hw + win - 1; if (hi > n - 1) hi = n - 1;
            const float inv = 1.0f / (float)(hi - lo + 1);
            float f0[8]; unpack8(*(const LAS u32x4*)(col + (t + 8) * 256), f0);
            u32x4 o; o.x = pk2(s[0] * inv - f0[0], s[1] * inv - f0[1]); o.y = pk2(s[2] * inv - f0[2], s[3] * inv - f0[3]); o.z = pk2(s[4] * inv - f0[4], s[5] * inv - f0[5]); o.w = pk2(s[6] * inv - f0[6], s[7] * inv - f0[7]);
            *(LAS u32x4*)(Pl + t * 264 + ch * 8) = o;
            if (tt < 3) { float fa[8], fb[8]; unpack8(*(const LAS u32x4*)(col + (t - hw + win + 8) * 256), fa); unpack8(*(const LAS u32x4*)(col + (t - hw + 8) * 256), fb);
#pragma unroll
                for (int e = 0; e < 8; ++e) s[e] += fa[e] - fb[e]; } } }
    LDS_BARRIER();
    const bf16_t* PT = (const bf16_t*)(A.ws + WS_POOLT); bf16_t* MIX = (bf16_t*)((unsigned char*)A.out);
    const int mt = F.wave & 3, lane = F.lane;
#pragma unroll
    for (int gi = 0; gi < 2; ++gi) { const int g = (F.wave >> 2) * 2 + gi;
        const bf16x8 a0 = ldfrag(Pl + mt * 16 * 264 + g * 64, 264, 0, lane), a1 = ldfrag(Pl + mt * 16 * 264 + g * 64, 264, 32, lane);
#pragma unroll
        for (int nt = 0; nt < 4; ++nt) { f32x4 acc = zero4();
            acc = mfma16(gfrag(PT + g * 4096 + nt * 16 * 64, 64, 0, lane), a0, acc); acc = mfma16(gfrag(PT + g * 4096 + nt * 16 * 64, 64, 32, lane), a1, acc);
            const int ch = g * 64 + nt * 16 + 4 * (lane >> 4); const f32x4 sc = *(const f32x4*)(A.in[23] + l * 256 + ch);
            u32x2 o; o.x = pk2(acc[0] * sc.x, acc[1] * sc.y); o.y = pk2(acc[2] * sc.z, acc[3] * sc.w);
            *(u32x2*)(MIX + (size_t)(rowbase + j0 + mt * 16 + (lane & 15)) * D + 768 + ch) = o; } }
}
__device__ __forceinline__ void phase_pool(Frame& F, int l) {
    CArgs& A = *get_args();
    const int nlat = RL / 64, nctx = (l == DEPTH - 1) ? 0 : NB * 4;
    for (int it = F.G - 1 - F.bx; it < nlat + nctx; it += F.G) {
        if (it < nlat) pool_item(F, A, l, RC + it * 64, 0, 64);
        else { const int q = it - nlat; pool_item(F, A, l, (q >> 2) * CTXL, (q & 3) * 64, CTXL); }
    }
    __syncthreads();
}

__device__ __forceinline__ void rot16(const bf16_t* src, const f32x2* ROT, int pos, int q, float scale, float (&lo)[8], float (&hi)[8]) {
    float a[8], b[8]; unpack8(*(const u32x4*)(src + 8 * q), a); unpack8(*(const u32x4*)(src + 32 + 8 * q), b);
    const f32x4* cs = (const f32x4*)(ROT + (size_t)pos * 32) + q;
#pragma unroll
    for (int e2 = 0; e2 < 4; ++e2) { const f32x4 w = cs[e2 * 4];
        lo[2 * e2] = (a[2 * e2] * w.x - b[2 * e2] * w.y) * scale; hi[2 * e2] = (a[2 * e2] * w.y + b[2 * e2] * w.x) * scale;
        lo[2 * e2 + 1] = (a[2 * e2 + 1] * w.z - b[2 * e2 + 1] * w.w) * scale; hi[2 * e2 + 1] = (a[2 * e2 + 1] * w.w + b[2 * e2 + 1] * w.z) * scale; }
}
__device__ __forceinline__ bf16x8 ldfrag_sw(const LAS bf16_t* base, int ld, int k0, int key, int lane) { return *(const LAS bf16x8*)(base + (lane & 15) * ld + ((k0 + 8 * (lane >> 4)) ^ (key << 4))); }
struct KvRaw { u32x4 k0, k1, v0, v1; f32x4 rf[4], rb[4]; };
__device__ __forceinline__ void kv_load(KvRaw& R, CArgs& A, int it, int iA, int qA) {
    const int hd = it & 7, bc = it >> 3, c = bc % NCH, b = bc / NCH;
    const bf16_t* Z = (const bf16_t*)(A.ws + WS_Z); const f32x2* ROT = (const f32x2*)(A.ws + WS_ROT);
    const bf16_t* za = Z + (size_t)(ret_row0(b, c) + iA) * INW + hd * 64;
    R.k0 = *(const u32x4*)(za + OFF_K + 8 * qA); R.k1 = *(const u32x4*)(za + OFF_K + 32 + 8 * qA);
    R.v0 = *(const u32x4*)(za + OFF_V + 16 * qA); R.v1 = *(const u32x4*)(za + OFF_V + 16 * qA + 8);
    const int pf = ret_pos0(c) + iA, pb = c < 2 ? CTXL - 1 - (128 * c + iA) : CTXL + SEQ - 1 - (128 * (c - 2) + iA);
    const f32x4* cf_ = (const f32x4*)(ROT + (size_t)pf * 32) + qA; const f32x4* cb_ = (const f32x4*)(ROT + (size_t)pb * 32) + qA;
#pragma unroll
    for (int e = 0; e < 4; ++e) { R.rf[e] = cf_[e * 4]; R.rb[e] = cb_[e * 4]; }
}
__device__ __forceinline__ void rot8(const u32x4 a8, const u32x4 b8, const f32x4 (&cs)[4], float scale, float (&l)[8], float (&h)[8]) {
    float a[8], b[8]; unpack8(a8, a); unpack8(b8, b);
#pragma unroll
    for (int e2 = 0; e2 < 4; ++e2) { const f32x4 w = cs[e2];
        l[2 * e2] = (a[2 * e2] * w.x - b[2 * e2] * w.y) * scale; h[2 * e2] = (a[2 * e2] * w.y + b[2 * e2] * w.x) * scale;
        l[2 * e2 + 1] = (a[2 * e2 + 1] * w.z - b[2 * e2 + 1] * w.w) * scale; h[2 * e2 + 1] = (a[2 * e2 + 1] * w.w + b[2 * e2 + 1] * w.z) * scale; }
}
__device__ __forceinline__ void phase_ret_kv(Frame& F, int l) {
    CArgs& A = *get_args();
    bf16_t* KV = (bf16_t*)(A.ws + WS_KV);
    LAS bf16_t* Kt = (LAS bf16_t*)F.lds;
    LAS bf16_t* Vt = (LAS bf16_t*)(F.lds + 2 * 64 * 136 * 2);
    const int iA = F.tid >> 2, qA = F.tid & 3, lane = F.lane, nit = NB * NCH * 8;
    const int hd = F.bx & 7;
    const float lgf = log2_gamma(A, l, 0, hd), lgb = log2_gamma(A, l, 1, hd);
    const float wf = fexp2((float)(127 - iA) * lgf), wb = fexp2((float)iA * lgb);
    const int ik = iA ^ (qA << 4);
    KvRaw R;
    if (F.bx < nit) kv_load(R, A, F.bx, iA, qA);
    for (int it = F.bx; it < nit; it += F.G) {
        const int bc = it >> 3, c = bc % NCH, b = bc / NCH;
        const KvRaw C = R;
        if (it + F.G < nit) kv_load(R, A, it + F.G, iA, qA);
        LDS_BARRIER();
        { float lo[8], hi[8];
            rot8(C.k0, C.k1, C.rf, 0.125f, lo, hi);
#pragma unroll
            for (int e = 0; e < 8; ++e) { Kt[(8 * qA + e) * 136 + ik] = (bf16_t)f2bf(lo[e]); Kt[(32 + 8 * qA + e) * 136 + ik] = (bf16_t)f2bf(hi[e]); }
            rot8(C.k0, C.k1, C.rb, 0.125f, lo, hi);
#pragma unroll
            for (int e = 0; e < 8; ++e) { Kt[(64 + 8 * qA + e) * 136 + ik] = (bf16_t)f2bf(lo[e]); Kt[(64 + 32 + 8 * qA + e) * 136 + ik] = (bf16_t)f2bf(hi[e]); }
            float v0[8], v1[8]; unpack8(C.v0, v0); unpack8(C.v1, v1);
#pragma unroll
            for (int e = 0; e < 8; ++e) { Vt[(16 * qA + e) * 136 + ik] = (bf16_t)f2bf(v0[e] * wf); Vt[(16 * qA + 8 + e) * 136 + ik] = (bf16_t)f2bf(v1[e] * wf);
                Vt[(64 + 16 * qA + e) * 136 + ik] = (bf16_t)f2bf(v0[e] * wb); Vt[(64 + 16 * qA + 8 + e) * 136 + ik] = (bf16_t)f2bf(v1[e] * wb); } }
        LDS_BARRIER();
        const int dir = F.wave >> 2, mt = F.wave & 3;
        bf16x8 vf[4];
#pragma unroll
        for (int ks = 0; ks < 4; ++ks) vf[ks] = ldfrag_sw(Vt + (dir * 64 + mt * 16) * 136, 136, ks * 32, mt, lane);
        bf16_t* out = KV + ((size_t)(((b * 8 + hd) * 2 + dir) * NCH + c)) * 4096 + (mt * 16 + (lane & 15)) * 64 + 4 * (lane >> 4);
#pragma unroll
        for (int nt = 0; nt < 4; ++nt) { f32x4 acc = zero4(); const int kkey = (2 * nt + ((lane & 15) >> 3)) & 3;
#pragma unroll
            for (int ks = 0; ks < 4; ++ks) acc = mfma16(ldfrag_sw(Kt + (dir * 64 + nt * 16) * 136, 136, ks * 32, kkey, lane), vf[ks], acc);
            u32x2 ww; ww.x = pk2(acc[0], acc[1]); ww.y = pk2(acc[2], acc[3]); *(u32x2*)(out + nt * 16) = ww; }
    }
    __syncthreads();
}
__device__ __forceinline__ void ret_scan(CArgs& A, int l, int gidx, int gstride) {
    bf16_t* KV = (bf16_t*)(A.ws + WS_KV);
    for (int idx = gidx; idx < NB * 8 * 2 * 1024; idx += gstride) {
        const int e4 = idx & 1023, chain = idx >> 10, dir = chain & 1, hd = (chain >> 1) & 7;
        const float cdec = fexp2(128.0f * log2_gamma(A, l, dir, hd));
        u32x2* base = (u32x2*)(KV + (size_t)chain * NCH * 4096) + e4;
        f32x4 s = zero4();
#pragma unroll
        for (int half = 0; half < 2; ++half) { u32x2 v[17];
#pragma unroll
            for (int j = 0; j < 17; ++j) { const int k = half * 17 + j, c = dir == 0 ? k : (k < 2 ? 1 - k : NCH + 1 - k); v[j] = base[(size_t)c * 1024]; }
#pragma unroll
            for (int j = 0; j < 17; ++j) { const int k = half * 17 + j, c = dir == 0 ? k : (k < 2 ? 1 - k : NCH + 1 - k);
                u32x2 o; o.x = pk2(s[0], s[1]); o.y = pk2(s[2], s[3]); base[(size_t)c * 1024] = o;
                s = s * cdec + (f32x4){bflo(v[j].x), bfhi(v[j].x), bflo(v[j].y), bfhi(v[j].y)}; } }
    }
}
struct RetRaw { u32x4 q0, q1, k0, k1, v0, v1, sf, sb; u32x2 gg[4]; };
__device__ __forceinline__ void ret_decode(int it, int c_lo, int nch, int& hd, int& c, int& b) { hd = it & 7; const int bc = it >> 3; c = c_lo + bc % nch; b = bc / nch; }
__device__ __forceinline__ void ret_load(RetRaw& R, CArgs& A, int it, int c_lo, int nch, int i, int q, int tid, int wave, int fr, int fq) {
    int hd, c, b; ret_decode(it, c_lo, nch, hd, c, b);
    const bf16_t* Z = (const bf16_t*)(A.ws + WS_Z); const bf16_t* KV = (const bf16_t*)(A.ws + WS_KV);
    const int row0 = ret_row0(b, c);
    const bf16_t* zr = Z + (size_t)(row0 + i) * INW + hd * 64;
    const int iA = tid >> 2, qA = tid & 3;
    const bf16_t* za = Z + (size_t)(row0 + iA) * INW + hd * 64;
    R.q0 = *(const u32x4*)(za + OFF_Q + 8 * qA); R.q1 = *(const u32x4*)(za + OFF_Q + 32 + 8 * qA);
    R.k0 = *(const u32x4*)(za + OFF_K + 8 * qA); R.k1 = *(const u32x4*)(za + OFF_K + 32 + 8 * qA);
    R.v0 = *(const u32x4*)(za + OFF_V + 16 * qA); R.v1 = *(const u32x4*)(za + OFF_V + 16 * qA + 8);
    const bf16_t* kvf = KV + ((size_t)(((b * 8 + hd) * 2 + 0) * NCH + c)) * 4096 + (tid >> 3) * 64 + 8 * (tid & 7);
    const bf16_t* kvb = kvf + (size_t)NCH * 4096;
    R.sf = *(const u32x4*)kvf; R.sb = *(const u32x4*)kvb;
    const size_t orow = (size_t)(row0 + wave * 16 + fr);
#pragma unroll
    for (int t = 0; t < 4; ++t) R.gg[t] = *(const u32x2*)(Z + orow * INW + OFF_G + hd * 64 + t * 16 + 4 * fq);
}
__device__ __forceinline__ void rot_pack(const u32x4 a8, const u32x4 b8, const f32x4 (&cs)[4], float scale, u32x4& lo, u32x4& hi) {
    float a[8], b[8], l[8], h[8]; unpack8(a8, a); unpack8(b8, b);
#pragma unroll
    for (int e2 = 0; e2 < 4; ++e2) { const f32x4 w = cs[e2];
        l[2 * e2] = (a[2 * e2] * w.x - b[2 * e2] * w.y) * scale; h[2 * e2] = (a[2 * e2] * w.y + b[2 * e2] * w.x) * scale;
        l[2 * e2 + 1] = (a[2 * e2 + 1] * w.z - b[2 * e2 + 1] * w.w) * scale; h[2 * e2 + 1] = (a[2 * e2 + 1] * w.w + b[2 * e2 + 1] * w.z) * scale; }
    lo.x = pk2(l[0], l[1]); lo.y = pk2(l[2], l[3]); lo.z = pk2(l[4], l[5]); lo.w = pk2(l[6], l[7]);
    hi.x = pk2(h[0], h[1]); hi.y = pk2(h[2], h[3]); hi.z = pk2(h[4], h[5]); hi.w = pk2(h[6], h[7]);
}
__device__ __forceinline__ void phase_ret_out(Frame& F, int l) {
    CArgs& A = *get_args();
    bf16_t* MIX = (bf16_t*)((unsigned char*)A.out);
    LAS bf16_t* Qs = (LAS bf16_t*)F.lds;
    LAS bf16_t* Ks = Qs + 2 * 128 * 72;
    LAS bf16_t* Vt = Ks + 2 * 128 * 72;
    LAS bf16_t* Ss = Vt + 64 * 136;
    LAS bf16_t* Sn = Ss + 128 * 136;
    static_assert((2 * 2 * 128 * 72 + 64 * 136 + 128 * 136 + 2 * 64 * 72) * 2 <= LC_MISC, "ret_out LDS");
    const int i = F.tid & 127, q = F.tid >> 7, lane = F.lane, fr = lane & 15, fq = lane >> 4, w = F.wave, i0 = w * 16;
    const int c_lo = (l == DEPTH - 1) ? 2 : 0, nch = NCH - c_lo, nit = NB * nch * 8;
    const int hd = F.bx & 7;
    const float lgf = log2_gamma(A, l, 0, hd), lgb = log2_gamma(A, l, 1, hd);
    const int iA = F.tid >> 2, qA = F.tid & 3;
    const float sqf = fexp2((float)iA * lgf), skf = 0.125f * fexp2(-(float)iA * lgf), sqb = fexp2(-(float)iA * lgb), skb = 0.125f * fexp2((float)iA * lgb);
    const float cff = fexp2(lgf), cfb = fexp2(128.0f * lgb);
    f32x4 gwv[4];
#pragma unroll
    for (int t = 0; t < 4; ++t) gwv[t] = *(const f32x4*)(A.in[21] + l * 512 + hd * 64 + t * 16 + 4 * fq);
    RetRaw R;
    f32x4 rf[4], rb[4];
#define RET_ROT_LOAD(IT) do { int h2_, c2_, b2_; ret_decode((IT), c_lo, nch, h2_, c2_, b2_); const f32x2* ROT = (const f32x2*)(A.ws + WS_ROT); \
        const int pf_ = ret_pos0(c2_) + iA, pb_ = c2_ < 2 ? CTXL - 1 - (128 * c2_ + iA) : CTXL + SEQ - 1 - (128 * (c2_ - 2) + iA); \
        const f32x4* cf_ = (const f32x4*)(ROT + (size_t)pf_ * 32) + qA; const f32x4* cb_ = (const f32x4*)(ROT + (size_t)pb_ * 32) + qA; \
        _Pragma("unroll") for (int e = 0; e < 4; ++e) { rf[e] = cf_[e * 4]; rb[e] = cb_[e * 4]; } } while (0)
    if (F.bx < nit) { ret_load(R, A, F.bx, c_lo, nch, i, q, F.tid, w, fr, fq); RET_ROT_LOAD(F.bx); }
    for (int it = F.bx; it < nit; it += F.G) {
        int hd_, c, b; ret_decode(it, c_lo, nch, hd_, c, b);
        const int row0 = ret_row0(b, c);
        const RetRaw C = R;
        if (it + F.G < nit) ret_load(R, A, it + F.G, c_lo, nch, i, q, F.tid, w, fr, fq);
        LDS_BARRIER();
        { float v0[8], v1[8]; unpack8(C.v0, v0); unpack8(C.v1, v1);
#pragma unroll
            for (int e = 0; e < 8; ++e) { Vt[(16 * qA + e) * 136 + (iA ^ (qA << 4))] = (bf16_t)f2bf(v0[e]); Vt[(16 * qA + 8 + e) * 136 + (iA ^ (qA << 4))] = (bf16_t)f2bf(v1[e]); } }
        { u32x4 lo, hi;
            rot_pack(C.q0, C.q1, rf, sqf, lo, hi); *(LAS u32x4*)(Qs + iA * 72 + 8 * qA) = lo; *(LAS u32x4*)(Qs + iA * 72 + 32 + 8 * qA) = hi;
            rot_pack(C.k0, C.k1, rf, skf, lo, hi); *(LAS u32x4*)(Ks + iA * 72 + 8 * qA) = lo; *(LAS u32x4*)(Ks + iA * 72 + 32 + 8 * qA) = hi;
            rot_pack(C.q0, C.q1, rb, sqb, lo, hi); *(LAS u32x4*)(Qs + (128 + iA) * 72 + 8 * qA) = lo; *(LAS u32x4*)(Qs + (128 + iA) * 72 + 32 + 8 * qA) = hi;
            rot_pack(C.k0, C.k1, rb, skb, lo, hi); *(LAS u32x4*)(Ks + (128 + iA) * 72 + 8 * qA) = lo; *(LAS u32x4*)(Ks + (128 + iA) * 72 + 32 + 8 * qA) = hi; }
        *(LAS u32x4*)(Sn + (F.tid >> 3) * 72 + 8 * (F.tid & 7)) = C.sf; *(LAS u32x4*)(Sn + (64 + (F.tid >> 3)) * 72 + 8 * (F.tid & 7)) = C.sb;
        if (it + F.G < nit) RET_ROT_LOAD(it + F.G);
        LDS_BARRIER();
        f32x4 o[4];
#pragma unroll
        for (int t = 0; t < 4; ++t) o[t] = zero4();
        const int ii = i0 + fr;
#pragma unroll
        for (int dir = 0; dir < 2; ++dir) {
            const LAS bf16_t* Qd = Qs + dir * 128 * 72; const LAS bf16_t* Kd = Ks + dir * 128 * 72; const LAS bf16_t* Sd = Sn + dir * 64 * 72;
            const bf16x8 qa0 = ldfrag(Qd + i0 * 72, 72, 0, lane), qa1 = ldfrag(Qd + i0 * 72, 72, 32, lane);
            const int nt_lo = dir == 0 ? 0 : (w & ~1), nt_hi = dir == 0 ? (w | 1) : 7, ks_lo = nt_lo >> 1, ks_hi = nt_hi >> 1;
#pragma unroll 2
            for (int nt = nt_lo; nt <= nt_hi; ++nt) { f32x4 s = zero4();
                s = mfma16(ldfrag(Kd + nt * 16 * 72, 72, 0, lane), qa0, s); s = mfma16(ldfrag(Kd + nt * 16 * 72, 72, 32, lane), qa1, s);
                float d[4];
#pragma unroll
                for (int j = 0; j < 4; ++j) { const int jj = nt * 16 + 4 * fq + j; const bool keep = dir == 0 ? jj <= ii : jj > ii; d[j] = keep ? s[j] : 0.f; }
                u32x2 ww; ww.x = pk2(d[0], d[1]); ww.y = pk2(d[2], d[3]); *(LAS u32x2*)(Ss + ii * 136 + nt * 16 + 4 * fq) = ww; }
            LDS_WAIT(); asm volatile("" ::: "memory");
            const float cf = dir == 0 ? cff : cfb;
            f32x4 a1[4];
#pragma unroll
            for (int t = 0; t < 4; ++t) a1[t] = zero4();
#pragma unroll 1
            for (int ks = ks_lo; ks <= ks_hi; ++ks) { const bf16x8 sa = ldfrag(Ss + i0 * 136, 136, ks * 32, lane);
#pragma unroll
                for (int t = 0; t < 4; ++t) a1[t] = mfma16(ldfrag_sw(Vt + t * 16 * 136, 136, ks * 32, t, lane), sa, a1[t]); }
            LDS_WAIT(); asm volatile("" ::: "memory");
#pragma unroll
            for (int t = 0; t < 4; ++t) { f32x4 a2 = zero4();
                a2 = mfma16(ldfrag(Sd + t * 16 * 72, 72, 0, lane), qa0, a2); a2 = mfma16(ldfrag(Sd + t * 16 * 72, 72, 32, lane), qa1, a2);
                o[t] = o[t] + a1[t] + a2 * cf; }
        }
        float s1 = 0.f;
#pragma unroll
        for (int t = 0; t < 4; ++t) s1 += (o[t][0] + o[t][1]) + (o[t][2] + o[t][3]);
        s1 += __shfl_xor(s1, 16); s1 += __shfl_xor(s1, 32);
        const float mu = s1 * (1.0f / 64.0f); float s2 = 0.f;
#pragma unroll
        for (int t = 0; t < 4; ++t) { o[t] = o[t] - mu; s2 += (o[t][0] * o[t][0] + o[t][1] * o[t][1]) + (o[t][2] * o[t][2] + o[t][3] * o[t][3]); }
        s2 += __shfl_xor(s2, 16); s2 += __shfl_xor(s2, 32);
        const float rstd = 1.0f / sqrtf(s2 * (1.0f / 64.0f) + 1e-5f);
        const size_t orow = (size_t)(row0 + i0 + fr);
#pragma unroll
        for (int t = 0; t < 4; ++t) { const int ch = hd * 64 + t * 16 + 4 * fq; const f32x4 gw = gwv[t];
            const u32x2 gg = C.gg[t];
            u32x2 ww; ww.x = pk2(o[t][0] * rstd * gw.x * siluf_(bflo(gg.x)), o[t][1] * rstd * gw.y * siluf_(bfhi(gg.x))); ww.y = pk2(o[t][2] * rstd * gw.z * siluf_(bflo(gg.y)), o[t][3] * rstd * gw.w * siluf_(bfhi(gg.y)));
            *(u32x2*)(MIX + orow * D + 256 + ch) = ww; }
    }
    __syncthreads();
}

__device__ __forceinline__ void s5_build_item(Frame& F, CArgs& A, int l, int g, int sub) {
    constexpr int PS = 130;
    LAS float* AP = (LAS float*)F.lds;
    LAS float* BB = AP + 2 * 17 * PS;
    LAS float* CC = BB + 2 * 64 * 16 * 2;
    LAS float* KK = CC + 2 * 16 * PS;
    __syncthreads();
    if (F.tid < 128) { const int dir = F.tid >> 6, p = F.tid & 63, pg = (l * 2 + dir) * 16 + g;
        const float are = A.in[10][pg * 64 + p], aim = A.in[11][pg * 64 + p], dt = fexp(A.in[12][pg]);
        const float mag = fexp(dt * are); float sn, cs; sincos_d(dt * aim, sn, cs);
        const float abr = mag * cs, abi = mag * sn, inv = 1.0f / (are * are + aim * aim);
        const float fre = ((abr - 1.0f) * are + abi * aim) * inv, fim = (abi * are - (abr - 1.0f) * aim) * inv;
        float pr = 1.f, pi = 0.f;
        for (int t = 0; t <= 16; ++t) { AP[(dir * 17 + t) * PS + p * 2] = pr; AP[(dir * 17 + t) * PS + p * 2 + 1] = pi; const float nr = pr * abr - pi * abi, ni = pr * abi + pi * abr; pr = nr; pi = ni; }
        for (int h = 0; h < 16; ++h) { const float br = A.in[13][(pg * 64 + p) * 16 + h], bi = A.in[14][(pg * 64 + p) * 16 + h];
            BB[((dir * 64 + p) * 16 + h) * 2] = fre * br - fim * bi; BB[((dir * 64 + p) * 16 + h) * 2 + 1] = fre * bi + fim * br;
            CC[(dir * 16 + h) * PS + p * 2] = A.in[15][(pg * 16 + h) * 64 + p]; CC[(dir * 16 + h) * PS + p * 2 + 1] = A.in[16][(pg * 16 + h) * 64 + p]; } }
    __syncthreads();
    { const int ho = F.tid & 15, tau = (F.tid >> 4) & 15, dir = F.tid >> 8;
        float s[16];
#pragma unroll
        for (int h = 0; h < 16; ++h) s[h] = 0.f;
        for (int p = 0; p < 64; ++p) { const f32x2 a = *(const LAS f32x2*)(AP + (dir * 17 + tau) * PS + p * 2), c = *(const LAS f32x2*)(CC + (dir * 16 + ho) * PS + p * 2);
            const float tr = c.x * a.x - c.y * a.y, ti = c.x * a.y + c.y * a.x; const LAS f32x4* bp = (const LAS f32x4*)(BB + (dir * 64 + p) * 32);
#pragma unroll
            for (int h2 = 0; h2 < 8; ++h2) { const f32x4 b = bp[h2]; s[2 * h2] += tr * b.x - ti * b.y; s[2 * h2 + 1] += tr * b.z - ti * b.w; } }
#pragma unroll
        for (int h = 0; h < 16; ++h) KK[((dir * 16 + tau) * 16 + ho) * 16 + h] = s[h]; }
    __syncthreads();
    bf16_t* W1 = (bf16_t*)(A.ws + WS_S5W1) + (size_t)g * 256 * 256; bf16_t* W2 = (bf16_t*)(A.ws + WS_S5W2) + (size_t)g * 256 * 512;
    for (int idx = F.tid; idx < 16 * 256; idx += NTHR) { const int k = idx & 255, n = sub * 16 + (idx >> 8), j = k >> 4, hi = k & 15;
        { const int dir = n >> 7, im = (n >> 6) & 1, p = n & 63, tau = dir == 0 ? 15 - j : j;
            const float ar = AP[(dir * 17 + tau) * PS + p * 2], ai = AP[(dir * 17 + tau) * PS + p * 2 + 1], br = BB[((dir * 64 + p) * 16 + hi) * 2], bi = BB[((dir * 64 + p) * 16 + hi) * 2 + 1];
            W1[(size_t)n * 256 + k] = (bf16_t)f2bf(im ? ar * bi + ai * br : ar * br - ai * bi); }
        { const int t = n >> 4, ho = n & 15; float v;
            if (j < t) v = KK[((0 * 16 + (t - j)) * 16 + ho) * 16 + hi]; else if (j > t) v = KK[((1 * 16 + (j - t)) * 16 + ho) * 16 + hi];
            else v = KK[((0 * 16 + 0) * 16 + ho) * 16 + hi] + KK[((1 * 16 + 0) * 16 + ho) * 16 + hi] + (ho == hi ? A.in[17][l * 256 + g * 16 + ho] : 0.f);
            W2[(size_t)n * 512 + k] = (bf16_t)f2bf(v); }
        { const int t = n >> 4, ho = n & 15, dir = k >> 7, im = (k >> 6) & 1, p = k & 63, tau = dir == 0 ? t + 1 : 16 - t;
            const float ar = AP[(dir * 17 + tau) * PS + p * 2], ai = AP[(dir * 17 + tau) * PS + p * 2 + 1], cr = CC[(dir * 16 + ho) * PS + p * 2], ci = CC[(dir * 16 + ho) * PS + p * 2 + 1];
            W2[(size_t)n * 512 + 256 + k] = (bf16_t)f2bf(im ? -(cr * ai + ci * ar) : cr * ar - ci * ai); } }
    __syncthreads();
}
__device__ __forceinline__ void phase_s5_local(Frame& F) {
    CArgs& A = *get_args();
    pg8::S5Order S{F.G, F.bx, 256, (const char*)(A.ws + WS_S5W1), (size_t)256 * 256 * 2};
    pg8::EpiHloc E{(float*)(A.ws + WS_HLOC), NCR};
    pg8::gemm_phase<pg8::EpiHloc, pg8::S5Order, true>(F.lds, F.tid, (const char*)(A.ws + WS_A2), 256, S, E);
}
__device__ __forceinline__ int s5_chain_cr(int b, int dir, int k) {
    constexpr int ncc = CTXL / S5T, ncl = SEQ / S5T;
    if (dir == 0) return k < ncc ? b * ncc + k : RC / S5T + b * ncl + (k - ncc);
    return k < ncc ? b * ncc + (ncc - 1 - k) : RC / S5T + b * ncl + (ncl - 1 - (k - ncc));
}
__device__ __forceinline__ void s5_scan_block(Frame& F, CArgs& A, int l, int chain) {
    LAS float* ex = (LAS float*)F.lds;
    const int dir = chain & 1, g = (chain >> 1) & 15, b = chain >> 5, pg = (l * 2 + dir) * 16 + g, p = F.lane, w = F.wave;
    const float are = A.in[10][pg * 64 + p], aim = A.in[11][pg * 64 + p], dt = fexp(A.in[12][pg]);
    const float mag = fexp(dt * are); float sn, cs; sincos_d(dt * aim, sn, cs);
    float ar = mag * cs, ai = mag * sn;
#pragma unroll
    for (int s = 0; s < 4; ++s) { const float nr = ar * ar - ai * ai, ni = 2.f * ar * ai; ar = nr; ai = ni; }
    const float* HLOC = (const float*)(A.ws + WS_HLOC); bf16_t* A2 = (bf16_t*)(A.ws + WS_A2);
    float lr[34], li[34];
#pragma unroll
    for (int j = 0; j < 34; ++j) { const int cr = s5_chain_cr(b, dir, w * 34 + j); const size_t o = ((size_t)g * 2304 + cr) * 256 + dir * 128 + p; lr[j] = HLOC[o]; li[j] = HLOC[o + 64]; }
    float hr = 0.f, hi = 0.f;
#pragma unroll
    for (int j = 0; j < 34; ++j) { const float nr = ar * hr - ai * hi + lr[j], ni = ar * hi + ai * hr + li[j]; hr = nr; hi = ni; }
    __syncthreads();
    ex[(w * 64 + p) * 2] = hr; ex[(w * 64 + p) * 2 + 1] = hi;
    __syncthreads();
    float br = ar, bi = ai;
#pragma unroll
    for (int s = 0; s < 5; ++s) { const float nr = br * br - bi * bi, ni = 2.f * br * bi; br = nr; bi = ni; }
    { const float x2r = ar * ar - ai * ai, x2i = 2.f * ar * ai; const float nr = br * x2r - bi * x2i, ni = br * x2i + bi * x2r; br = nr; bi = ni; }
    hr = 0.f; hi = 0.f;
    for (int ww = 0; ww < w; ++ww) { const float er = ex[(ww * 64 + p) * 2], ei = ex[(ww * 64 + p) * 2 + 1]; const float nr = br * hr - bi * hi + er, ni = br * hi + bi * hr + ei; hr = nr; hi = ni; }
#pragma unroll
    for (int j = 0; j < 34; ++j) { const int cr = s5_chain_cr(b, dir, w * 34 + j); const size_t o = ((size_t)g * 2304 + cr) * 512 + 256 + dir * 128 + p;
        A2[o] = (bf16_t)f2bf(hr); A2[o + 64] = (bf16_t)f2bf(hi);
        const float nr = ar * hr - ai * hi + lr[j], ni = ar * hi + ai * hr + li[j]; hr = nr; hi = ni; }
}
__device__ __forceinline__ void phase_s5_out(Frame& F) {
    CArgs& A = *get_args();
    pg8::S5Order S{F.G, F.bx, 512, (const char*)(A.ws + WS_S5W2), (size_t)256 * 512 * 2};
    pg8::EpiS5Z E{(bf16_t*)(A.ws + WS_ZB), NCR};
    pg8::gemm_phase<pg8::EpiS5Z, pg8::S5Order, true>(F.lds, F.tid, (const char*)(A.ws + WS_A2), 512, S, E);
}
__device__ __forceinline__ void phase_glu(Frame& F, int l) {
    CArgs& A = *get_args();
    pg8::DenseOrder S; S.init(RT / 256, 1, F.G, F.bx, 0, 256, A.ws + WS_GLUT);
    pg8::EpiGlu E{(const bf16_t*)(A.ws + WS_ZB), (bf16_t*)((unsigned char*)A.out), A.in[19] + l * 256};
    pg8::gemm_phase<pg8::EpiGlu, pg8::DenseOrder, true>(F.lds, F.tid, (const char*)(A.ws + WS_ZB), 256, S, E);
}

__device__ __forceinline__ int lane_id_now() { int l; asm volatile("v_mbcnt_lo_u32_b32 %0, -1, 0\n\tv_mbcnt_hi_u32_b32 %0, -1, %0" : "=v"(l)); return l; }
__global__ void __launch_bounds__(NTHR, 2) mk_fwd(Args args) {
    extern __shared__ __attribute__((aligned(16))) unsigned char lds_raw[];
#define MKF() Frame F; { int t_ = HW_TID(); asm volatile("" : "+v"(t_)); { unsigned lb_ = (unsigned)(uintptr_t)(LAS unsigned char*)lds_raw; asm volatile("" : "+s"(lb_)); F.lds = (LAS unsigned char*)(uintptr_t)lb_; } F.tid = t_; F.lane = t_ & 63; F.wave = __builtin_amdgcn_readfirstlane(t_ >> 6); \
        int b_ = blockIdx.x; asm volatile("" : "+s"(b_)); F.bx = b_; F.G = gridDim.x; F.gw = b_ * NWAVES + F.wave; F.NGW = F.G * NWAVES; }
    const int wv_ = __builtin_amdgcn_readfirstlane((int)threadIdx.x >> 6);
#define HW_TID() (wv_ * 64 + lane_id_now())
    volatile LAS unsigned* MISC = (volatile LAS unsigned*)((LAS unsigned char*)lds_raw + LC_MISC);
    if (HW_TID() < 32) MISC[HW_TID()] = 0u;
    __syncthreads();
    XcdBarrier bar = xcd_barrier_post((unsigned*)(get_args()->ws + WS_CTL) + CW_BAR, MISC + 8, HW_TID() == 0);
#ifndef PROBE_MASK
#define PROBE_MASK 0u
#endif
    unsigned long long pt_last = 0ull, pt_acc = 0ull; int pt_i = 0;
#define PROBE_TICK() do { if (PROBE_MASK) { const unsigned long long now_ = __builtin_amdgcn_s_memrealtime(); if ((PROBE_MASK >> pt_i) & 1u) pt_acc += now_ - pt_last; pt_last = now_; ++pt_i; } } while (0)
    if (PROBE_MASK) pt_last = __builtin_amdgcn_s_memrealtime();
#define GRID_BAR() do { xcd_barrier(bar, HW_TID() == 0); PROBE_TICK(); } while (0)
    DUP(9) { MKF(); phase_tables(F); }
    DUP(8) { MKF(); phase_weights(F, 0); }
    { MKF(); for (int it = F.bx; it < 256; it += F.G) s5_build_item(F, *get_args(), 0, it >> 4, it & 15); }
    { const bool never_ = (get_args()->ws == nullptr);
      if (never_) cooperative_groups::this_grid().sync(); else GRID_BAR(); }
#pragma unroll
    for (int l = 0; l < DEPTH; ++l) {
        if (l > 0) { DUP(8) { MKF(); phase_weights(F, l); } PROBE_TICK(); }
        for (int rep_ = 0; rep_ < ((((PROBE_DUP) >> 10) & 1) && l == 0 ? 2 : 1); ++rep_) { MKF(); phase_prenorm(F, l); }
        { MKF(); router_precompute(F, l); }
        if (l > 0) { MKF(); for (int it = F.bx; it < 256; it += F.G) s5_build_item(F, *get_args(), l, it >> 4, it & 15); }
        GRID_BAR();
        DUP(0) { MKF(); phase_gemm_in(F); } GRID_BAR();
        DUP(11) { MKF(); phase_s5_local(F); } PROBE_TICK();
        DUP(4) { MKF(); phase_ret_kv(F, l); }
        GRID_BAR();
        { MKF(); for (int ch = F.bx; ch < NB * 16 * 2; ch += F.G) s5_scan_block(F, *get_args(), l, ch); PROBE_TICK();
            ret_scan(*get_args(), l, F.bx * NTHR + F.tid, F.G * NTHR); }
        GRID_BAR();
        DUP(6) { MKF(); phase_s5_out(F); } PROBE_TICK();
        DUP(5) { MKF(); phase_ret_out(F, l); }
        GRID_BAR();
        DUP(12) { MKF(); phase_glu(F, l); } PROBE_TICK();
        DUP(7) { MKF(); phase_pool(F, l); }
        GRID_BAR();
        for (int rep_ = 0; rep_ < ((((PROBE_DUP) >> 1) & 1) && l == 0 ? 2 : 1); ++rep_) { MKF(); phase_gemm_out(F, l); } GRID_BAR();
        { MKF(); phase_router(F, l); } GRID_BAR();
        DUP(2) { MKF(); phase_moe1(F, l); } GRID_BAR();
        DUP(3) { MKF(); phase_moe2(F, l); } GRID_BAR();
    }
    { MKF(); phase_final(F); }
    if (PROBE_MASK) { __syncthreads(); PROBE_TICK();
        if (get_args()->ws && __builtin_amdgcn_readfirstlane((int)blockIdx.x) == 0) { const unsigned long long t0_ = __builtin_amdgcn_s_memrealtime(); while (__builtin_amdgcn_s_memrealtime() - t0_ < 8ull * pt_acc) __builtin_amdgcn_s_sleep(8); } }
}

extern "C" void kernel_launch(void* const* d_in, const int* in_sizes, int n_in, void* d_out, int out_size, void* d_ws, size_t ws_size, hipStream_t stream) {
    static int grid = 0;
    if (grid == 0) {
        if (n_in != 30 || out_size != RL * D || ws_size < WS_END) { fprintf(stderr, "kernel_launch: unexpected shapes (n_in %d out %d ws %zu)\n", n_in, out_size, ws_size); grid = -1; return; }
        int dev = 0, cus = 0, per_cu = 0;
        (void)hipGetDevice(&dev); (void)hipDeviceGetAttribute(&cus, hipDeviceAttributeMultiprocessorCount, dev);
        (void)hipFuncSetAttribute((const void*)mk_fwd, hipFuncAttributeMaxDynamicSharedMemorySize, LDS_BYTES);
        (void)hipOccupancyMaxActiveBlocksPerMultiprocessor(&per_cu, (const void*)mk_fwd, NTHR, LDS_BYTES);
        (void)hipGetLastError();
        if (cus % 8 != 0) { fprintf(stderr, "kernel_launch: %d CUs: this kernel needs a CU count that is a multiple of 8\n", cus); grid = -1; return; }
        if (per_cu < 1) { fprintf(stderr, "kernel_launch: occupancy query says %d blocks per CU\n", per_cu); grid = -1; return; }
        grid = cus;
        fprintf(stderr, "kernel_launch: cus %d per_cu %d grid %d ws %zu\n", cus, per_cu, grid, ws_size);
    }
    if (grid < 0) return;
    (void)hipMemsetAsync((char*)d_ws + WS_CTL, 0, CTL_BYTES, stream);
    Args a{}; for (int i = 0; i < 30; ++i) a.in[i] = (const float*)d_in[i];
    a.out = (float*)d_out; a.ws = (unsigned char*)d_ws;
    void* kargs[] = {&a};
    hipError_t e = hipLaunchCooperativeKernel((const void*)mk_fwd, dim3(grid), dim3(NTHR), kargs, LDS_BYTES, stream);
    if (e != hipSuccess) fprintf(stderr, "kernel_launch: cooperative launch failed: %s (grid %d)\n", hipGetErrorString(e), grid);
}
```

```cpp
#include <hip/hip_runtime.h>
#include <hip/hip_cooperative_groups.h>
#include <cstdio>
#include <cstdint>

#define LAS __attribute__((address_space(3)))
typedef unsigned short bf16_t;
typedef short bf16x8 __attribute__((ext_vector_type(8)));
typedef float f32x4 __attribute__((ext_vector_type(4)));
typedef float f32x2 __attribute__((ext_vector_type(2)));
typedef unsigned u32x4 __attribute__((ext_vector_type(4)));
typedef unsigned u32x2 __attribute__((ext_vector_type(2)));

constexpr int D = 1024, NB = 8, SEQ = 4096, CTXL = 256, DEPTH = 2, INW = 2560;
constexpr int RC = NB * CTXL, RL = NB * SEQ, RT = RC + RL;
constexpr int NE = 16;
constexpr int OFF_U = 0, OFF_Q = 256, OFF_K = 768, OFF_V = 1280, OFF_G = 1792, OFF_P = 2304;
constexpr int MAXTILES = 288, NPOS = CTXL + SEQ;
constexpr int NWAVES = 8, NTHR = 512;

constexpr size_t MiB = 1u << 20;
constexpr size_t WS_CTL = 0, CTL_BYTES = 1 * MiB;
constexpr size_t WS_MOD = 1 * MiB;
constexpr size_t WS_ROT = 2 * MiB;
constexpr size_t WS_TOKE = 4 * MiB;
constexpr size_t WS_TOKP = 4 * MiB + 512 * 1024;
constexpr size_t WS_TOKG = 5 * MiB;
constexpr size_t WS_LIST = 5 * MiB + 512 * 1024;
constexpr size_t WS_GLUT = 7 * MiB + 768 * 1024;
constexpr size_t WS_POOLT = 7 * MiB + 896 * 1024;
constexpr size_t WS_S5M = 8 * MiB;
constexpr size_t WS_WIN = 16 * MiB;
constexpr size_t WS_WOUT = 21 * MiB;
constexpr size_t WS_W13 = 24 * MiB;
constexpr size_t WS_W2 = 88 * MiB;
constexpr size_t WS_XB = 120 * MiB;
constexpr size_t WS_Z = 188 * MiB;
constexpr size_t WS_Y = 358 * MiB;
constexpr size_t WS_XRC = 502 * MiB;
constexpr size_t WS_YO = 510 * MiB;
constexpr size_t WS_END = 578 * MiB;
constexpr size_t WS_S5Y = WS_Y + 104 * MiB;
constexpr size_t WS_RO = WS_Y + 34 * MiB;
constexpr size_t WS_POOLED = WS_Y + 102 * MiB;
constexpr size_t WS_KV = WS_Y;
constexpr size_t WS_HLOC = WS_Y + 68 * MiB;
constexpr size_t WS_ZB = WS_Y + 68 * MiB;
constexpr size_t WS_A2 = WS_Y + 104 * MiB;
constexpr int CW_BAR = 4096, CW_GCNT = 8192;

__device__ __forceinline__ float wave_sum(float v) {
#pragma unroll
    for (int o = 1; o < 64; o <<= 1) v += __shfl_xor(v, o);
    return v;
}
typedef __bf16 bf16x2_t __attribute__((ext_vector_type(2)));
__device__ __forceinline__ unsigned pk2(float lo, float hi) { const bf16x2_t v = __builtin_convertvector((f32x2){lo, hi}, bf16x2_t); return __builtin_bit_cast(unsigned, v); }
__device__ __forceinline__ unsigned f2bf(float f) { return pk2(f, 0.f) & 0xffffu; }
__device__ __forceinline__ float bf2f(unsigned h) { return __builtin_bit_cast(float, h << 16); }
__device__ __forceinline__ float bflo(unsigned w) { return __builtin_bit_cast(float, w << 16); }
__device__ __forceinline__ float bfhi(unsigned w) { return __builtin_bit_cast(float, w & 0xffff0000u); }
__device__ __forceinline__ float sigmoidf_(float x) { return 1.0f / (1.0f + __expf(-x)); }
__device__ __forceinline__ float siluf_(float x) { return x / (1.0f + __expf(-x)); }
__device__ __forceinline__ float gelu_tanh(float x) { const float u = 0.7978845608028654f * (x + 0.044715f * x * x * x); return 0.5f * x * (1.0f + tanhf(u)); }
#define LDS_WAIT() asm volatile("s_waitcnt lgkmcnt(0)" ::: "memory")
#define VM_WAIT() asm volatile("s_waitcnt vmcnt(0)" ::: "memory")
#define LDS_BARRIER() do { asm volatile("s_waitcnt lgkmcnt(0)" ::: "memory"); __builtin_amdgcn_s_barrier(); asm volatile("" ::: "memory"); } while (0)
__device__ __forceinline__ f32x4 zero4() { float z = 0.f; asm volatile("" : "+v"(z)); return (f32x4){z, z, z, z}; }
__device__ __forceinline__ f32x4 mfma16(bf16x8 nside, bf16x8 mside, f32x4 acc) { return __builtin_amdgcn_mfma_f32_16x16x32_bf16(nside, mside, acc, 0, 0, 0); }
__device__ __forceinline__ bf16x8 ldfrag(const LAS bf16_t* base, int ld, int k0, int lane) { return *(const LAS bf16x8*)(base + (lane & 15) * ld + k0 + 8 * (lane >> 4)); }
__device__ __forceinline__ bf16x8 gfrag(const bf16_t* base, size_t ld, int k0, int lane) { return *(const bf16x8*)(base + (size_t)(lane & 15) * ld + k0 + 8 * (lane >> 4)); }

namespace pg8 {
constexpr int BM = 256, BK = 64, HALF = 128, HTB = HALF * BK * 2, STAGE_BYTES = 8 * HTB, NXCD = 8, WGM = 8;
__host__ __device__ __forceinline__ int lds_byte(int r, int c) { const int st = (r >> 4) * 2 + (c >> 5), rr = r & 15, cc = c & 31, ob = rr * 64 + cc * 2; return st * 1024 + (ob ^ (((ob >> 9) & 1) << 5)); }
__host__ __device__ __forceinline__ void stage_rc(int b, int& R, int& C) { const int st = b / 1024, sb = b % 1024, swz = sb ^ (((sb >> 9) & 1) << 5); R = (st >> 1) * 16 + swz / 64; C = (st & 1) * 32 + (swz % 64) / 2; }
__host__ __device__ __forceinline__ int perm32(int rho) { const int n = rho >> 4, i = rho & 15; return 8 * (i >> 2) + 4 * n + (i & 3); }

struct Unit { int pm, pn, e, ui; };

__device__ __forceinline__ unsigned cvt_pk_bf16(float lo, float hi) { unsigned r; asm volatile("v_cvt_pk_bf16_f32 %0, %1, %2" : "=v"(r) : "v"(lo), "v"(hi)); return r; }

struct DenseOrder {
    int nM, nN, nwg, G, c, pm0, K; const char* Bt;
    __device__ void init(int nM_, int nN_, int G_, int c_, int pm0_, int K_, const void* Bt_) { nM = nM_; nN = nN_; nwg = nM * nN; G = G_; c = c_; pm0 = pm0_; K = K_; Bt = (const char*)Bt_; }
    __device__ bool next(int i, Unit& u) const {
        const long L = (long)i * G + c; if (L >= nwg) return false;
        int wgid = (int)L; { const int q = nwg / NXCD, r = nwg % NXCD, xcd = wgid % NXCD, off = wgid / NXCD; wgid = (xcd < r ? xcd * (q + 1) : r * (q + 1) + (xcd - r) * q) + off; }
        const int nig = WGM * nN, gid = wgid / nig, fm = gid * WGM, gsz = (nM - fm) < WGM ? (nM - fm) : WGM;
        u.pm = pm0 + fm + ((wgid % nig) % gsz); u.pn = (wgid % nig) / gsz; u.e = 0; u.ui = i; return true;
    }
    __device__ __forceinline__ void a_offs(const Unit& u, const int (&R)[2], const int (&C)[2], unsigned (&off)[2][2]) const {
#pragma unroll
        for (int h = 0; h < 2; ++h)
#pragma unroll
            for (int i = 0; i < 2; ++i) off[h][i] = (unsigned)((u.pm * BM + h * HALF + R[i]) * K + C[i]) * 2u;
    }
    __device__ __forceinline__ const char* b_ptr(const Unit& u) const { return Bt + (size_t)u.pn * BM * K * 2; }
};
struct MoeOrder {
    int ntiles, nN, G, c, K; const char* Bt; size_t bstride; const LAS int* tile_e; const LAS unsigned* rowoff;
    bool xcd_tiles;
    __device__ bool next(int i, Unit& u) const {
        const long L = (long)i * G + c; if (L >= (long)ntiles * nN) return false;
        if (xcd_tiles && (G & 7) == 0) { const int g = (int)(L >> 3), x = (int)(L & 7), oct = g / nN, gi = g % nN;
            int pn, t;
            if (nN == 8) { t = oct * 8 + 2 * (x & 3) + (gi >> 2); pn = 4 * (x >> 2) + (gi & 3); }
            else { t = oct * 8 + x; pn = gi; }
            if ((oct + 1) * 8 <= ntiles) { u.pn = pn; u.pm = t; u.e = tile_e[t]; u.ui = i; return true; } }
        u.pn = (int)(L % nN); u.pm = (int)(L / nN); u.e = tile_e[u.pm]; u.ui = i; return true;
    }
    __device__ __forceinline__ void a_offs(const Unit& u, const int (&R)[2], const int (&C)[2], unsigned (&off)[2][2]) const {
#pragma unroll
        for (int h = 0; h < 2; ++h)
#pragma unroll
            for (int i = 0; i < 2; ++i) off[h][i] = rowoff ? rowoff[u.ui * 256 + h * HALF + R[i]] + (unsigned)C[i] * 2u : (unsigned)((u.pm * BM + h * HALF + R[i]) * K + C[i]) * 2u;
    }
    __device__ __forceinline__ const char* b_ptr(const Unit& u) const { return Bt + (size_t)u.e * bstride + (size_t)u.pn * BM * K * 2; }
};

struct EpiBf16 {
    static constexpr bool PERM = true;
    bf16_t* O; int ldc;
    __device__ __forceinline__ void operator()(const f32x4 (&acc)[2][2][4][2], const Unit& u, int wr, int wc, int fr, int fq) const {
        const int row0 = u.pm * BM + wr * 64 + fr, col0 = u.pn * BM + wc * 32 + 8 * fq;
#pragma unroll
        for (int ai = 0; ai < 2; ++ai)
#pragma unroll
            for (int m = 0; m < 4; ++m) { bf16_t* rowp = O + (size_t)(row0 + ai * HALF + m * 16) * ldc + col0;
#pragma unroll
                for (int bj = 0; bj < 2; ++bj) { const f32x4 v0 = acc[ai][bj][m][0], v1 = acc[ai][bj][m][1];
                    u32x4 w; w.x = cvt_pk_bf16(v0[0], v0[1]); w.y = cvt_pk_bf16(v0[2], v0[3]); w.z = cvt_pk_bf16(v1[0], v1[1]); w.w = cvt_pk_bf16(v1[2], v1[3]);
                    *(u32x4*)(rowp + bj * HALF) = w; } }
    }
};
struct EpiSwiGLU {
    static constexpr bool PERM = true;
    bf16_t* O;
    __device__ __forceinline__ void operator()(const f32x4 (&acc)[2][2][4][2], const Unit& u, int wr, int wc, int fr, int fq) const {
        const int row0 = u.pm * BM + wr * 64 + fr, col0 = u.pn * HALF + wc * 32 + 8 * fq;
#pragma unroll
        for (int ai = 0; ai < 2; ++ai)
#pragma unroll
            for (int m = 0; m < 4; ++m) { bf16_t* rowp = O + (size_t)(row0 + ai * HALF + m * 16) * 1024 + col0;
                float h[8];
#pragma unroll
                for (int n = 0; n < 2; ++n)
#pragma unroll
                    for (int j = 0; j < 4; ++j) { const float a = acc[ai][0][m][n][j], b = acc[ai][1][m][n][j]; h[n * 4 + j] = a * __builtin_amdgcn_rcpf(1.0f + __builtin_amdgcn_exp2f(-1.4426950408889634f * a)) * b; }
                u32x4 w; w.x = cvt_pk_bf16(h[0], h[1]); w.y = cvt_pk_bf16(h[2], h[3]); w.z = cvt_pk_bf16(h[4], h[5]); w.w = cvt_pk_bf16(h[6], h[7]);
                *(u32x4*)rowp = w; }
    }
};
struct EpiRes {
    static constexpr bool PERM = false;
    const float* src_c; const float* src_l; float* dst_c; float* dst_l; const float* modl;
    __device__ __forceinline__ void operator()(const f32x4 (&acc)[2][2][4][2], const Unit& u, int wr, int wc, int fr, int fq) const {
        const bool isc = u.pm < 8; const int bidx = isc ? 8 : ((u.pm - 8) >> 4);
        const float* src = isc ? src_c : src_l; float* dst = isc ? dst_c : dst_l;
        const int rl0 = (isc ? u.pm * BM : (u.pm - 8) * BM) + wr * 64 + fr, col0 = u.pn * BM + wc * 32 + 4 * fq;
        const float* gate = modl + bidx * 6144 + 2048;
        f32x4 gv[2][2];
#pragma unroll
        for (int bj = 0; bj < 2; ++bj)
#pragma unroll
            for (int n = 0; n < 2; ++n) gv[bj][n] = *(const f32x4*)(gate + col0 + bj * HALF + n * 16);
#pragma unroll
        for (int ai = 0; ai < 2; ++ai)
#pragma unroll
            for (int m = 0; m < 4; ++m) { const size_t off = (size_t)(rl0 + ai * HALF + m * 16) * 1024 + col0;
#pragma unroll
                for (int bj = 0; bj < 2; ++bj)
#pragma unroll
                    for (int n = 0; n < 2; ++n) { const f32x4 s = *(const f32x4*)(src + off + bj * HALF + n * 16); *(f32x4*)(dst + off + bj * HALF + n * 16) = s + gv[bj][n] * acc[ai][bj][m][n]; } }
    }
};

struct S5Order {
    int G, c, K; const char* Bt; size_t bstride;
    __device__ bool next(int i, Unit& u) const { const long L = (long)i * G + c; if (L >= 9 * 16) return false; u.pm = (int)(L >> 4); u.e = (int)(L & 15); u.pn = 0; u.ui = i; return true; }
    __device__ __forceinline__ void a_offs(const Unit& u, const int (&R)[2], const int (&C)[2], unsigned (&off)[2][2]) const {
#pragma unroll
        for (int h = 0; h < 2; ++h)
#pragma unroll
            for (int i = 0; i < 2; ++i) off[h][i] = (unsigned)(((u.e * 2304 + u.pm * BM + h * HALF + R[i]) * 512 + C[i])) * 2u;
    }
    __device__ __forceinline__ const char* b_ptr(const Unit& u) const { return Bt + (size_t)u.e * bstride; }
};
struct EpiIn {
    static constexpr bool PERM = true;
    bf16_t* Zb; bf16_t* A2;
    __device__ __forceinline__ void operator()(const f32x4 (&acc)[2][2][4][2], const Unit& u, int wr, int wc, int fr, int fq) const {
        const int row0 = u.pm * BM + wr * 64 + fr, colt = wc * 32 + 8 * fq;
#pragma unroll
        for (int ai = 0; ai < 2; ++ai)
#pragma unroll
            for (int m = 0; m < 4; ++m) { const int row = row0 + ai * HALF + m * 16;
#pragma unroll
                for (int bj = 0; bj < 2; ++bj) { const f32x4 v0 = acc[ai][bj][m][0], v1 = acc[ai][bj][m][1]; const int c = colt + bj * HALF;
                    u32x4 w; w.x = cvt_pk_bf16(v0[0], v0[1]); w.y = cvt_pk_bf16(v0[2], v0[3]); w.z = cvt_pk_bf16(v1[0], v1[1]); w.w = cvt_pk_bf16(v1[2], v1[3]);
                    if (u.pn == 0) *(u32x4*)(A2 + ((size_t)((c >> 4) * 2304 + (row >> 4)) * 512 + (row & 15) * 16 + (c & 15))) = w;
                    else *(u32x4*)(Zb + (size_t)row * 2560 + u.pn * BM + c) = w; } }
    }
};
struct EpiHloc {
    static constexpr bool PERM = false;
    float* O; int ncr;
    __device__ __forceinline__ void operator()(const f32x4 (&acc)[2][2][4][2], const Unit& u, int wr, int wc, int fr, int fq) const {
        const int row0 = u.pm * BM + wr * 64 + fr, col0 = wc * 32 + 4 * fq;
#pragma unroll
        for (int ai = 0; ai < 2; ++ai)
#pragma unroll
            for (int m = 0; m < 4; ++m) { const int cr = row0 + ai * HALF + m * 16; if (cr < ncr) { float* rowp = O + ((size_t)u.e * 2304 + cr) * 256 + col0;
#pragma unroll
                for (int bj = 0; bj < 2; ++bj)
#pragma unroll
                    for (int n = 0; n < 2; ++n) *(f32x4*)(rowp + bj * HALF + n * 16) = acc[ai][bj][m][n]; } }
    }
};
__device__ __forceinline__ float gelu_tanh_f(float x) { const float u = 0.7978845608028654f * (x + 0.044715f * x * x * x); const float e = __builtin_amdgcn_exp2f(2.8853900817779268f * u); return x * (1.0f - __builtin_amdgcn_rcpf(1.0f + e)); }
struct EpiS5Z {
    static constexpr bool PERM = true;
    bf16_t* O; int ncr;
    __device__ __forceinline__ void operator()(const f32x4 (&acc)[2][2][4][2], const Unit& u, int wr, int wc, int fr, int fq) const {
        const int row0 = u.pm * BM + wr * 64 + fr, colt = wc * 32 + 8 * fq;
#pragma unroll
        for (int ai = 0; ai < 2; ++ai)
#pragma unroll
            for (int m = 0; m < 4; ++m) { const int cr = row0 + ai * HALF + m * 16; if (cr < ncr) {
#pragma unroll
                for (int bj = 0; bj < 2; ++bj) { const f32x4 v0 = acc[ai][bj][m][0], v1 = acc[ai][bj][m][1]; const int c = colt + bj * HALF;
                    u32x4 w; w.x = cvt_pk_bf16(gelu_tanh_f(v0[0]), gelu_tanh_f(v0[1])); w.y = cvt_pk_bf16(gelu_tanh_f(v0[2]), gelu_tanh_f(v0[3])); w.z = cvt_pk_bf16(gelu_tanh_f(v1[0]), gelu_tanh_f(v1[1])); w.w = cvt_pk_bf16(gelu_tanh_f(v1[2]), gelu_tanh_f(v1[3]));
                    *(u32x4*)(O + ((size_t)(cr * 16 + (c >> 4)) * 256 + u.e * 16 + (c & 15))) = w; } } }
    }
};
struct EpiGlu {
    static constexpr bool PERM = true;
    const bf16_t* ZB; bf16_t* MIXp; const float* bias;
    __device__ __forceinline__ void operator()(const f32x4 (&acc)[2][2][4][2], const Unit& u, int wr, int wc, int fr, int fq) const {
        const int row0 = u.pm * BM + wr * 64 + fr, colt = wc * 32 + 8 * fq;
#pragma unroll
        for (int bj = 0; bj < 2; ++bj) { const int c = colt + bj * HALF; const f32x4 b0 = *(const f32x4*)(bias + c), b1 = *(const f32x4*)(bias + c + 4);
#pragma unroll
            for (int ai = 0; ai < 2; ++ai)
#pragma unroll
                for (int m = 0; m < 4; ++m) { const size_t row = (size_t)(row0 + ai * HALF + m * 16); const u32x4 z = *(const u32x4*)(ZB + row * 256 + c);
                    const f32x4 v0 = acc[ai][bj][m][0] + b0, v1 = acc[ai][bj][m][1] + b1;
#define SG_(x) __builtin_amdgcn_rcpf(1.0f + __builtin_amdgcn_exp2f(-1.4426950408889634f * (x)))
                    u32x4 w; w.x = cvt_pk_bf16(bflo(z.x) * SG_(v0[0]), bfhi(z.x) * SG_(v0[1])); w.y = cvt_pk_bf16(bflo(z.y) * SG_(v0[2]), bfhi(z.y) * SG_(v0[3]));
                    w.z = cvt_pk_bf16(bflo(z.z) * SG_(v1[0]), bfhi(z.z) * SG_(v1[1])); w.w = cvt_pk_bf16(bflo(z.w) * SG_(v1[2]), bfhi(z.w) * SG_(v1[3]));
#undef SG_
                    *(u32x4*)(MIXp + row * 1024 + c) = w; } }
    }
};

template <class Epi, class Sched, bool ALIGN_EPI>
__device__ __forceinline__ void gemm_phase(LAS unsigned char* lds, const int tid_in, const char* Abase, const int K, const Sched& S, const Epi& E) {
    int tid_ = tid_in; asm volatile("" : "+v"(tid_));
    const int tid = tid_, wid = __builtin_amdgcn_readfirstlane(tid >> 6), lane = tid & 63, wr = wid >> 2, wc = wid & 3, fr = lane & 15, fq = lane >> 4;
    const int nt = K / BK;
    int Rr[2], Cc[2]; unsigned voffB[2];
#pragma unroll
    for (int i = 0; i < 2; ++i) { int R, C; stage_rc(tid * 16 + i * 8192, R, C); Rr[i] = R; Cc[i] = C; const int Rb = Epi::PERM ? ((R & ~31) + perm32(R & 31)) : R; voffB[i] = (unsigned)(Rb * K + C) * 2u; }
    const size_t kstep = (size_t)(BK * 2);
    const size_t hstepB = (size_t)HALF * K * 2;
    const unsigned ldsw = (unsigned)wid * 1024u;
    const int aoff = lds_byte(wr * 64 + fr, fq * 8), boff = lds_byte(wc * 32 + fr, fq * 8);
#define PG8_SA(b, h) (((b) * 2 + (h)) * HTB)
#define PG8_SB(b, h) ((4 + (b) * 2 + (h)) * HTB)
#define PG8_STAGE_B(bufoff, gbase) do { _Pragma("unroll") for (int _i = 0; _i < 2; ++_i) \
        __builtin_amdgcn_global_load_lds((const unsigned*)((const char*)(gbase) + voffB[_i]), (LAS unsigned*)(lds + (bufoff) + ldsw + _i * 8192), 16, 0, 0); } while (0)
#define PG8_STAGE_A(bufoff, offs, kb) do { _Pragma("unroll") for (int _i = 0; _i < 2; ++_i) \
        __builtin_amdgcn_global_load_lds((const unsigned*)(Abase + (kb) + (offs)[_i]), (LAS unsigned*)(lds + (bufoff) + ldsw + _i * 8192), 16, 0, 0); } while (0)
#define PG8_LDA(dst, b, h) do { _Pragma("unroll") for (int m = 0; m < 4; ++m) _Pragma("unroll") for (int k = 0; k < 2; ++k) dst[m][k] = *(const LAS bf16x8*)(lds + PG8_SA(b, h) + aoff + m * 2048 + k * 1024); } while (0)
#define PG8_LDB(dst, b, h) do { _Pragma("unroll") for (int n = 0; n < 2; ++n) _Pragma("unroll") for (int k = 0; k < 2; ++k) dst[n][k] = *(const LAS bf16x8*)(lds + PG8_SB(b, h) + boff + n * 2048 + k * 1024); } while (0)
#define PG8_MMA(ai, bj, At, Bt) do { __builtin_amdgcn_s_setprio(1); _Pragma("unroll") for (int m = 0; m < 4; ++m) _Pragma("unroll") for (int n = 0; n < 2; ++n) _Pragma("unroll") for (int k = 0; k < 2; ++k) \
        acc[ai][bj][m][n] = __builtin_amdgcn_mfma_f32_16x16x32_bf16(Bt[n][k], At[m][k], acc[ai][bj][m][n], 0, 0, 0); __builtin_amdgcn_s_setprio(0); } while (0)
#define PG8_WAIT_V(n) asm volatile("s_waitcnt vmcnt(" #n ")" ::: "memory")
#define PG8_WAIT_L(n) asm volatile("s_waitcnt lgkmcnt(" #n ")" ::: "memory")
#define PG8_BAR __builtin_amdgcn_s_barrier()
#define PG8_SCHED __builtin_amdgcn_sched_barrier(0)
    Unit cur, nxt; int ui = 0;
    if (!S.next(0, cur)) return;
    float z_ = 0.f; asm volatile("" : "+v"(z_));
    f32x4 acc[2][2][4][2];
#pragma unroll
    for (int a = 0; a < 2; ++a)
#pragma unroll
        for (int b = 0; b < 2; ++b)
#pragma unroll
            for (int m = 0; m < 4; ++m)
#pragma unroll
                for (int n = 0; n < 2; ++n) acc[a][b][m][n] = (f32x4){z_, z_, z_, z_};
    bf16x8 At[4][2], B0[2][2], B1[2][2];
    unsigned cO[2][2], nO[2][2];
    S.a_offs(cur, Rr, Cc, cO);
    const char* cB = S.b_ptr(cur); const char* nB = cB;
    PG8_STAGE_B(PG8_SB(0, 0), cB); PG8_STAGE_B(PG8_SB(0, 1), cB + hstepB); PG8_STAGE_A(PG8_SA(0, 0), cO[0], 0); PG8_STAGE_A(PG8_SA(0, 1), cO[1], 0);
    if (wr == 1) PG8_BAR;
    PG8_WAIT_V(2); PG8_BAR;
    PG8_STAGE_B(PG8_SB(1, 0), cB + kstep); PG8_STAGE_A(PG8_SA(1, 0), cO[0], kstep); PG8_STAGE_B(PG8_SB(1, 1), cB + hstepB + kstep);
    PG8_WAIT_V(6); PG8_BAR;
    for (;;) {
        const bool has_next = S.next(ui + 1, nxt);
        if (has_next) { S.a_offs(nxt, Rr, Cc, nO); nB = S.b_ptr(nxt); }
        else { nO[0][0] = cO[0][0]; nO[0][1] = cO[0][1]; nO[1][0] = cO[1][0]; nO[1][1] = cO[1][1]; nB = cB; }
#pragma unroll 1
        for (int t = 0; t < nt; t += 2) {
            const bool last = (t == nt - 2);
            const size_t k1 = (size_t)(t + 1) * kstep;
            const size_t k2 = last ? (size_t)0 : (size_t)(t + 2) * kstep, k3 = k2 + kstep;
            unsigned o2[2][2];
            o2[0][0] = last ? nO[0][0] : cO[0][0]; o2[0][1] = last ? nO[0][1] : cO[0][1]; o2[1][0] = last ? nO[1][0] : cO[1][0]; o2[1][1] = last ? nO[1][1] : cO[1][1];
            const char* b2 = (last ? nB : cB) + k2; const char* b3 = b2 + kstep;
            PG8_LDB(B0, 0, 0); PG8_LDB(B1, 0, 1); PG8_SCHED; PG8_LDA(At, 0, 0); PG8_STAGE_A(PG8_SA(1, 1), cO[1], k1);
            PG8_WAIT_V(8); PG8_WAIT_L(0); PG8_BAR; PG8_MMA(0, 0, At, B0); PG8_MMA(0, 1, At, B1); PG8_BAR; PG8_SCHED;
            PG8_LDA(At, 0, 1); PG8_STAGE_B(PG8_SB(0, 0), b2); PG8_STAGE_B(PG8_SB(0, 1), b2 + hstepB); PG8_STAGE_A(PG8_SA(0, 0), o2[0], k2);
            PG8_WAIT_V(8); PG8_WAIT_L(0); PG8_BAR; PG8_MMA(1, 0, At, B0); PG8_MMA(1, 1, At, B1); PG8_BAR; PG8_SCHED;
            PG8_LDB(B0, 1, 0); PG8_LDB(B1, 1, 1); PG8_SCHED; PG8_LDA(At, 1, 0); PG8_STAGE_A(PG8_SA(0, 1), o2[1], k2);
            PG8_WAIT_V(8); PG8_WAIT_L(0); PG8_BAR; PG8_MMA(0, 0, At, B0); PG8_MMA(0, 1, At, B1); PG8_BAR; PG8_SCHED;
            PG8_LDA(At, 1, 1); PG8_STAGE_B(PG8_SB(1, 0), b3); PG8_STAGE_B(PG8_SB(1, 1), b3 + hstepB); PG8_STAGE_A(PG8_SA(1, 0), o2[0], k3);
            PG8_WAIT_V(8); PG8_WAIT_L(0); PG8_BAR; PG8_MMA(1, 0, At, B0); PG8_MMA(1, 1, At, B1); PG8_BAR; PG8_SCHED;
        }
        if constexpr (ALIGN_EPI) { if (wr == 0) PG8_BAR; }
        E(acc, cur, wr, wc, fr, fq);
        if (!has_next) break;
#pragma unroll
        for (int a = 0; a < 2; ++a)
#pragma unroll
            for (int b = 0; b < 2; ++b)
#pragma unroll
                for (int m = 0; m < 4; ++m)
#pragma unroll
                    for (int n = 0; n < 2; ++n) acc[a][b][m][n] = (f32x4){z_, z_, z_, z_};
        cur = nxt; cB = nB; cO[0][0] = nO[0][0]; cO[0][1] = nO[0][1]; cO[1][0] = nO[1][0]; cO[1][1] = nO[1][1]; ++ui;
        if constexpr (ALIGN_EPI) { if (wr == 1) PG8_BAR; }
    }
    PG8_WAIT_V(0);
    if constexpr (!ALIGN_EPI) { if (wr == 0) PG8_BAR; }
    PG8_BAR;
#undef PG8_SA
#undef PG8_SB
#undef PG8_STAGE_A
#undef PG8_STAGE_B
#undef PG8_LDA
#undef PG8_LDB
#undef PG8_MMA
#undef PG8_WAIT_V
#undef PG8_WAIT_L
#undef PG8_BAR
#undef PG8_SCHED
}
}


#define XB_TMO      128
#define XB_XCNT(j)  (256  + 64 * (j))
#define XB_XSUB(j)  (1280 + 64 * (j))
#define XB_XGEN(j)  (2304 + 64 * (j))
#define XB_TOP      3328
#define XB_TOPGEN   3392
#define XCD_BAR_WORDS 3456
#define XB_SPIN_CAP (1u << 22)
__device__ __forceinline__ unsigned xb_ld(unsigned* p)              { return __hip_atomic_load(p, __ATOMIC_RELAXED, __HIP_MEMORY_SCOPE_AGENT); }
__device__ __forceinline__ unsigned xb_add(unsigned* p, unsigned v) { return __hip_atomic_fetch_add(p, v, __ATOMIC_RELAXED, __HIP_MEMORY_SCOPE_AGENT); }
__device__ __forceinline__ unsigned xb_xcc_id() { return (unsigned)__builtin_amdgcn_s_getreg((3 << 11) | 20) & 0xFu; }
#define XB_SPIN(cond, bar) do { unsigned _sp = 0; while (cond) { __builtin_amdgcn_s_sleep(1); \
    if ((++_sp & 255u) == 0u) { if (xb_ld(&(bar)[XB_TMO])) break; if (_sp > XB_SPIN_CAP) { atomicAdd(&(bar)[XB_TMO], 1u); break; } } } } while (0)
struct XcdBarrier { unsigned* bar; unsigned x; volatile LAS unsigned* st; };
__device__ __forceinline__ XcdBarrier xcd_barrier_post(unsigned* bar, volatile LAS unsigned* st, bool leader) {
    XcdBarrier b; b.bar = bar; b.x = xb_xcc_id(); b.st = st;
    if (leader) (void)xb_add(&bar[XB_XCNT(b.x)], 1u);
    return b;
}
__device__ __forceinline__ void xcd_barrier_complete(unsigned* bar, unsigned x, unsigned& nloc, unsigned& nx) {
    const unsigned G = gridDim.x * gridDim.y * gridDim.z;
    unsigned sum, cnt, mine, sp = 0u;
    for (;;) {
        sum = 0u; cnt = 0u; mine = 0u;
#pragma unroll
        for (unsigned j = 0; j < 16; ++j) { const unsigned c = xb_ld(&bar[XB_XCNT(j)]); sum += c; cnt += (c > 0u) ? 1u : 0u; mine = (j == x) ? c : mine; }
        if (sum == G) break;
        __builtin_amdgcn_s_sleep(1);
        if ((++sp & 255u) == 0u) { if (xb_ld(&bar[XB_TMO])) break; if (sp > XB_SPIN_CAP) { atomicAdd(&bar[XB_TMO], 1u); break; } }
    }
    nloc = mine > 0u ? mine : 1u; nx = cnt > 0u ? cnt : 1u;
}
__device__ __forceinline__ void xcd_barrier(const XcdBarrier& b, bool leader) {
    asm volatile("s_waitcnt vmcnt(0)" ::: "memory");
    __syncthreads();
    if (leader) {
        unsigned* bar = b.bar;
        __builtin_amdgcn_s_waitcnt(0);
        unsigned nloc = b.st[0], nx = b.st[1];
        if (nloc == 0u) { xcd_barrier_complete(bar, b.x, nloc, nx); b.st[0] = nloc; b.st[1] = nx; }
        const unsigned old = xb_add(&bar[XB_XSUB(b.x)], 1u);
        const unsigned gen = old / nloc;
        if (old + 1u == (gen + 1u) * nloc) {
            __builtin_amdgcn_fence(__ATOMIC_RELEASE, "agent");
            asm volatile("s_waitcnt vmcnt(0)" ::: "memory");
            const unsigned og = xb_add(&bar[XB_TOP], 1u);
            const unsigned tg = og / nx;
            if (og + 1u == (tg + 1u) * nx) xb_add(&bar[XB_TOPGEN], 1u);
            else XB_SPIN(xb_ld(&bar[XB_TOPGEN]) == tg, bar);
            __builtin_amdgcn_fence(__ATOMIC_ACQUIRE, "agent");
            xb_add(&bar[XB_XGEN(b.x)], 1u);
            asm volatile("s_waitcnt vmcnt(0)" ::: "memory");
        } else {
            XB_SPIN(xb_ld(&bar[XB_XGEN(b.x)]) == gen, bar);
            __builtin_amdgcn_fence(__ATOMIC_ACQUIRE, "agent");
            asm volatile("s_waitcnt vmcnt(0)" ::: "memory");
        }
    }
    __syncthreads();
}

constexpr int RING_BYTES = 131072;
constexpr int LC_TILE_E = RING_BYTES;
constexpr int LC_TSTART = LC_TILE_E + 1280;
constexpr int LC_CNT = LC_TSTART + 128;
constexpr int LC_ROWOFF = LC_CNT + 64;
constexpr int LDS_BYTES = 163840;
constexpr int LC_MISC = LDS_BYTES - 128;
static_assert(LC_ROWOFF + 10 * 256 * 4 <= LC_MISC, "LDS map");

struct Args { const float* in[30]; float* out; unsigned char* ws; };
typedef const __attribute__((address_space(4))) Args CArgs;
__device__ __forceinline__ CArgs* get_args() { CArgs* p = (CArgs*)__builtin_amdgcn_kernarg_segment_ptr(); asm volatile("" : "+s"(p)); return p; }

struct Frame {
    LAS unsigned char* lds; int tid, lane, wave, G, gw, NGW, bx;
};

static_assert(DEPTH == 2, "the residual-stream plumbing below (x = module input in layer 0 / its pre-norm update, bf16 latent stream XB afterwards) is written for two layers");
__device__ __forceinline__ bf16_t* xb_row(CArgs& A, int row) { return (bf16_t*)(A.ws + WS_XB) + (size_t)(row - RC) * D; }
__device__ __forceinline__ const float* xin_row(CArgs& A, int row) { return row < RC ? A.in[2] + (size_t)row * D : A.in[0] + (size_t)(row - RC) * D; }
__device__ __forceinline__ int row_bidx(int row) { return row < RC ? 8 : ((row - RC) >> 12); }

__device__ __forceinline__ float fexp2(float x) { return __builtin_amdgcn_exp2f(x); }
__device__ __forceinline__ float fexp(float x) { return __builtin_amdgcn_exp2f(x * 1.4426950408889634f); }
__device__ __forceinline__ float flog1p_small(float t) {
    return t < 0.03125f ? t * (1.0f + t * (-0.5f + t * (0.33333334f + t * (-0.25f + t * 0.2f)))) : __builtin_amdgcn_logf(1.0f + t) * 0.6931471805599453f;
}
__device__ __forceinline__ void sincos_d(float ang, float& s, float& c) {
    const float n = __builtin_rintf(ang * 0.15915494309189535f);
    float r = __builtin_fmaf(-n, 6.28125f, ang); r = __builtin_fmaf(-n, 1.9353071795864769e-3f, r); r = __builtin_fmaf(-n, 1.0253131677e-11f, r) ;
    const float rev = r * 0.15915494309189535f;
    s = __builtin_amdgcn_sinf(rev); c = __builtin_amdgcn_cosf(rev);
}

struct CvtItem { const float* src; bf16_t* dst; int N, Kdst; };
__device__ __forceinline__ bool cvt_decode(CArgs& A, int l, int it, CvtItem& c) {
    constexpr int I_IN = 16 * 80, I_OUT = 16 * 32, I_E = 16 * 32, I_GLU = 4 * 8, I_POOL = 8;
    constexpr int NITEMS = I_IN + I_OUT + NE * 3 * I_E + I_GLU + I_POOL;
    if (it >= NITEMS) return false;
    unsigned char* ws = A.ws; int r = it;
    if (r < I_IN) { const int kb = r / 80, nb = r % 80; c = {A.in[8] + (size_t)l * D * INW + (size_t)(64 * kb) * INW + 32 * nb, (bf16_t*)(ws + WS_WIN) + (size_t)(32 * nb) * D + 64 * kb, INW, D}; return true; } r -= I_IN;
    if (r < I_OUT) { const int kb = r / 32, nb = r % 32; c = {A.in[9] + (size_t)l * D * D + (size_t)(64 * kb) * D + 32 * nb, (bf16_t*)(ws + WS_WOUT) + (size_t)(32 * nb) * D + 64 * kb, D, D}; return true; } r -= I_OUT;
    if (r < NE * 3 * I_E) { const int e = r / (3 * I_E), q = (r % (3 * I_E)) / I_E, s = r % I_E, kb = s / 32, nb = s % 32, n0 = 32 * nb;
        const size_t wo = ((size_t)l * NE + e) * D * D + (size_t)(64 * kb) * D + n0;
        if (q == 0) c = {A.in[26] + wo, (bf16_t*)(ws + WS_W13) + (size_t)e * 2048 * D + (size_t)(256 * (n0 >> 7) + (n0 & 127)) * D + 64 * kb, D, D};
        else if (q == 1) c = {A.in[27] + wo, (bf16_t*)(ws + WS_W13) + (size_t)e * 2048 * D + (size_t)(256 * (n0 >> 7) + 128 + (n0 & 127)) * D + 64 * kb, D, D};
        else c = {A.in[28] + wo, (bf16_t*)(ws + WS_W2) + (size_t)e * D * D + (size_t)n0 * D + 64 * kb, D, D};
        return true; } r -= NE * 3 * I_E;
    if (r < I_GLU) { const int kb = r / 8, nb = r % 8; c = {A.in[18] + (size_t)l * 256 * 256 + (size_t)(64 * kb) * 256 + 32 * nb, (bf16_t*)(ws + WS_GLUT) + (size_t)(32 * nb) * 256 + 64 * kb, 256, 256}; return true; } r -= I_GLU;
    { const int g = r / 2, nb = r % 2; c = {A.in[22] + ((size_t)l * 4 + g) * 64 * 64 + 32 * nb, (bf16_t*)(ws + WS_POOLT) + g * 64 * 64 + (size_t)(32 * nb) * 64, 64, 64}; return true; }
}
__device__ __forceinline__ void cvt_load(const CvtItem& c, int lane, float (&v)[32]) {
#pragma unroll
    for (int i = 0; i < 32; ++i) v[i] = __builtin_nontemporal_load(c.src + (size_t)(2 * i + (lane >> 5)) * c.N + (lane & 31));
}
__device__ __forceinline__ void cvt_store(const CvtItem& c, int lane, const float (&v)[32], LAS float* scr) {
#pragma unroll
    for (int i = 0; i < 32; ++i) scr[(2 * i + (lane >> 5)) * 33 + (lane & 31)] = v[i];
    LDS_WAIT(); asm volatile("" ::: "memory");
    const int cc = lane & 7;
#pragma unroll
    for (int j = 0; j < 4; ++j) { const int n = (lane >> 3) + 8 * j; const LAS float* s = scr + (8 * cc) * 33 + n;
        u32x4 o; o.x = pk2(s[0 * 33], s[1 * 33]); o.y = pk2(s[2 * 33], s[3 * 33]); o.z = pk2(s[4 * 33], s[5 * 33]); o.w = pk2(s[6 * 33], s[7 * 33]);
        *(u32x4*)(c.dst + (size_t)n * c.Kdst + 8 * cc) = o; }
    LDS_WAIT(); asm volatile("" ::: "memory");
}
__device__ __forceinline__ void phase_weights(Frame& F, int l) {
    CArgs& A = *get_args();
    LAS float* scr = (LAS float*)(F.lds + F.wave * 16384);
    CvtItem ca, cb; float va[32], vb[32];
    constexpr int NIT_ = 16 * 80 + 16 * 32 + NE * 3 * 16 * 32 + 4 * 8 + 8;
    const int per = (NIT_ + F.G - 1) / F.G, base = F.bx * per, lim = (base + per < NIT_) ? base + per : NIT_;
    int it = base + F.wave;
    bool ha = it < lim && cvt_decode(A, l, it, ca); if (ha) cvt_load(ca, F.lane, va);
    while (ha) {
        const bool hb = it + NWAVES < lim && cvt_decode(A, l, it + NWAVES, cb); if (hb) cvt_load(cb, F.lane, vb);
        cvt_store(ca, F.lane, va, scr);
        if (!hb) break;
        it += 2 * NWAVES;
        ha = it < lim && cvt_decode(A, l, it, ca); if (ha) cvt_load(ca, F.lane, va);
        cvt_store(cb, F.lane, vb, scr);
    }
    __syncthreads();
}
__device__ __forceinline__ void phase_tables(Frame& F) {
    CArgs& A = *get_args();
    __syncthreads();
    LAS float* sc = (LAS float*)F.lds;
    LAS float* part = (LAS float*)(F.lds + 40960);
    float* MOD = (float*)(A.ws + WS_MOD);
    if (F.bx < 192) {
        for (int i = F.tid; i < 9 * 1024; i += NTHR) { const int r = i >> 10, k = i & 1023; const float v = r < 8 ? A.in[1][r * 1024 + k] : A.in[3][k]; sc[i] = siluf_(v); }
        __syncthreads();
        for (int it = F.bx; it < 192; it += F.G) {
            const int l = it / 96, cg = it % 96, cq = F.tid & 15, ks = F.tid >> 4;
            const float* W = A.in[4] + (size_t)l * D * 6144 + cg * 64 + cq * 4;
            f32x4 acc[9];
#pragma unroll
            for (int r = 0; r < 9; ++r) acc[r] = zero4();
#pragma unroll 1
            for (int half = 0; half < 2; ++half) { f32x4 w[16];
#pragma unroll
                for (int j = 0; j < 16; ++j) w[j] = __builtin_nontemporal_load((const f32x4*)(W + (size_t)(ks * 32 + half * 16 + j) * 6144));
#pragma unroll
                for (int j = 0; j < 16; ++j) { const int k = ks * 32 + half * 16 + j;
#pragma unroll
                    for (int r = 0; r < 9; ++r) acc[r] = acc[r] + w[j] * sc[r * 1024 + k]; } }
#pragma unroll
            for (int r = 0; r < 9; ++r) *(LAS f32x4*)(part + (ks * 9 + r) * 64 + cq * 4) = acc[r];
            __syncthreads();
            for (int idx = F.tid; idx < 576; idx += NTHR) { const int r = idx >> 6, c = idx & 63; float s = A.in[5][l * 6144 + cg * 64 + c];
#pragma unroll 8
                for (int k8 = 0; k8 < 32; ++k8) s += part[(k8 * 9 + r) * 64 + c];
                MOD[(l * 9 + r) * 6144 + cg * 64 + c] = s; }
            __syncthreads();
        }
    }
    f32x2* ROT = (f32x2*)(A.ws + WS_ROT);
    for (int idx = F.bx * NTHR + F.tid; idx < NPOS * 32; idx += F.G * NTHR) {
        const int pos = idx >> 5, i = idx & 31; const float inv = fexp2(-(float)i * (13.287712379549449f / 32.0f));   const float ang = (float)pos * inv; float s, c; sincos_d(ang, s, c); ROT[(pos << 5) + (((i >> 1) & 3) << 3) + ((i >> 3) << 1) + (i & 1)] = (f32x2){c, s};
    }
    __syncthreads();
}

struct RowComb { float g1, g2; const bf16_t* y1; const bf16_t* y2; };
__device__ __forceinline__ void load_row(const float* p, int lane, f32x4 (&v)[4]) {
#pragma unroll
    for (int j = 0; j < 4; ++j) v[j] = ((const f32x4*)p)[lane + 64 * j];
}
__device__ __forceinline__ void store_row(float* p, int lane, const f32x4 (&v)[4]) {
#pragma unroll
    for (int j = 0; j < 4; ++j) __builtin_nontemporal_store(v[j], (f32x4*)p + lane + 64 * j);
}
__device__ __forceinline__ void moe_combine(CArgs& A, int lp, int row, int lane, const LAS int* tstart, f32x4 (&v)[4]) {
    const int* TOKE = (const int*)(A.ws + WS_TOKE); const int* TOKP = (const int*)(A.ws + WS_TOKP); const float* TOKG = (const float*)(A.ws + WS_TOKG);
    const int e1 = TOKE[row * 2], e2 = TOKE[row * 2 + 1], p1 = TOKP[row * 2], p2 = TOKP[row * 2 + 1];
    const float g1 = TOKG[row * 2], g2 = TOKG[row * 2 + 1];
    const size_t s1 = (size_t)tstart[e1] * 256 + p1, s2 = (size_t)tstart[e2] * 256 + p2;
    const bf16_t* Y = (const bf16_t*)(A.ws + WS_Y);
    const float* gt = (const float*)(A.ws + WS_MOD) + (size_t)(lp * 9 + row_bidx(row)) * 6144 + 5 * 1024;
#pragma unroll
    for (int j = 0; j < 4; ++j) { const u32x2 a = ((const u32x2*)(Y + s1 * 1024))[lane + 64 * j], b = ((const u32x2*)(Y + s2 * 1024))[lane + 64 * j]; const f32x4 g = ((const f32x4*)gt)[lane + 64 * j];
        v[j].x += g.x * (g1 * bflo(a.x) + g2 * bflo(b.x)); v[j].y += g.y * (g1 * bfhi(a.x) + g2 * bfhi(b.x));
        v[j].z += g.z * (g1 * bflo(a.y) + g2 * bflo(b.y)); v[j].w += g.w * (g1 * bfhi(a.y) + g2 * bfhi(b.y)); }
}
__device__ __forceinline__ void add_mixer(CArgs& A, int l, int row, int lane, f32x4 (&v)[4]) {
    const bf16_t* y = (const bf16_t*)(A.ws + WS_YO) + (size_t)row * D;
    const float* gt = (const float*)(A.ws + WS_MOD) + (size_t)(l * 9 + row_bidx(row)) * 6144 + 2 * 1024;
#pragma unroll
    for (int j = 0; j < 4; ++j) { const u32x2 a = ((const u32x2*)y)[lane + 64 * j]; const f32x4 g = ((const f32x4*)gt)[lane + 64 * j];
        v[j].x += g.x * bflo(a.x); v[j].y += g.y * bfhi(a.x); v[j].z += g.z * bflo(a.y); v[j].w += g.w * bfhi(a.y); }
}
__device__ __forceinline__ void build_tstart(Frame& F, int lp) {
    LAS int* tstart = (LAS int*)(F.lds + LC_TSTART); LAS int* cnt = (LAS int*)(F.lds + LC_CNT);
    const unsigned* gcnt = (const unsigned*)(get_args()->ws + WS_CTL) + CW_GCNT + lp * 16;
    __syncthreads();
    if (F.tid == 0) { int s = 0; for (int e = 0; e < NE; ++e) { const int c = (int)__hip_atomic_load(gcnt + e, __ATOMIC_RELAXED, __HIP_MEMORY_SCOPE_AGENT); cnt[e] = c; tstart[e] = s; s += (c + 255) >> 8; } tstart[NE] = s; }
    __syncthreads();
}
__device__ __forceinline__ float row_rstd(const f32x4 (&v)[4]) {
    float ss = 0.f;
#pragma unroll
    for (int j = 0; j < 4; ++j) ss += (v[j].x * v[j].x + v[j].y * v[j].y) + (v[j].z * v[j].z + v[j].w * v[j].w);
    return 1.0f / sqrtf(wave_sum(ss) * (1.0f / D) + 1e-6f);
}
__device__ __forceinline__ void norm_mod_store(const f32x4 (&v)[4], float rstd, const float* nw, const float* sc, const float* sh, bf16_t* orow, int lane, f32x4 (*keep)[4]) {
#pragma unroll
    for (int j = 0; j < 4; ++j) { const f32x4 w = ((const f32x4*)nw)[lane + 64 * j], s = ((const f32x4*)sc)[lane + 64 * j], b = ((const f32x4*)sh)[lane + 64 * j];
        const f32x4 h = v[j] * rstd * w * (s + 1.0f) + b; if (keep) (*keep)[j] = h;
        u32x2 o; o.x = pk2(h.x, h.y); o.y = pk2(h.z, h.w); ((u32x2*)orow)[lane + 64 * j] = o; }
}
struct WideRow { u32x4 c0, c1; };
__device__ __forceinline__ void wide_load(WideRow& W, const bf16_t* row, int lane, bool nt) {
    const u32x4* p0 = (const u32x4*)(row + 8 * (lane >> 1) + 256 * (2 * (lane & 1))); const u32x4* p1 = p0 + 32;
    if (nt) { W.c0 = __builtin_nontemporal_load(p0); W.c1 = __builtin_nontemporal_load(p1); } else { W.c0 = *p0; W.c1 = *p1; }
}
__device__ __forceinline__ void wide_unpack(const WideRow& W, int lane, u32x2 (&o)[4]) {
    const bool odd = lane & 1;
    const unsigned s0 = odd ? W.c0.x : W.c0.z, s1 = odd ? W.c0.y : W.c0.w, s2 = odd ? W.c1.x : W.c1.z, s3 = odd ? W.c1.y : W.c1.w;
    const unsigned r0 = __shfl_xor(s0, 1), r1 = __shfl_xor(s1, 1), r2 = __shfl_xor(s2, 1), r3 = __shfl_xor(s3, 1);
    if (!odd) { o[0] = (u32x2){W.c0.x, W.c0.y}; o[1] = (u32x2){W.c1.x, W.c1.y}; o[2] = (u32x2){r0, r1}; o[3] = (u32x2){r2, r3}; }
    else      { o[0] = (u32x2){r0, r1}; o[1] = (u32x2){r2, r3}; o[2] = (u32x2){W.c0.z, W.c0.w}; o[3] = (u32x2){W.c1.z, W.c1.w}; }
}
__device__ __forceinline__ void wide_store(bf16_t* row, int lane, const u32x2 (&o)[4]) {
    const bool odd = lane & 1;
    const unsigned s0 = odd ? o[0].x : o[2].x, s1 = odd ? o[0].y : o[2].y, s2 = odd ? o[1].x : o[3].x, s3 = odd ? o[1].y : o[3].y;
    const unsigned r0 = __shfl_xor(s0, 1), r1 = __shfl_xor(s1, 1), r2 = __shfl_xor(s2, 1), r3 = __shfl_xor(s3, 1);
    u32x4 c0, c1;
    if (!odd) { c0 = (u32x4){o[0].x, o[0].y, r0, r1}; c1 = (u32x4){o[1].x, o[1].y, r2, r3}; }
    else      { c0 = (u32x4){r0, r1, o[2].x, o[2].y}; c1 = (u32x4){r2, r3, o[3].x, o[3].y}; }
    u32x4* p0 = (u32x4*)(row + 8 * (lane >> 1) + 256 * (2 * (lane & 1)));
    p0[0] = c0; p0[32] = c1;
}
struct RowRaw { f32x4 x[4]; WideRow xw, y, m1, m2; float g1, g2; int e1, e2, p1, p2; };
template <int MODE> __device__ __forceinline__ void row_issue1(RowRaw& R, CArgs& A, int l, int row, int lane) {
    if (MODE == 2) wide_load(R.xw, xb_row(A, row), lane, false);
    else { const float* src = xin_row(A, row);
#pragma unroll
        for (int j = 0; j < 4; ++j) R.x[j] = ((const f32x4*)src)[lane + 64 * j]; }
    if (MODE != 0) {
        wide_load(R.y, (const bf16_t*)(A.ws + WS_YO) + (size_t)row * D, lane, false);
        const int* TOKE = (const int*)(A.ws + WS_TOKE); const int* TOKP = (const int*)(A.ws + WS_TOKP); const float* TOKG = (const float*)(A.ws + WS_TOKG);
        R.e1 = TOKE[row * 2]; R.e2 = TOKE[row * 2 + 1]; R.p1 = TOKP[row * 2]; R.p2 = TOKP[row * 2 + 1]; R.g1 = TOKG[row * 2]; R.g2 = TOKG[row * 2 + 1];
    }
}
template <int MODE> __device__ __forceinline__ void row_issue2(RowRaw& R, CArgs& A, const LAS int* tstart, int lane) {
    if (MODE != 0) {
        const bf16_t* Y = (const bf16_t*)(A.ws + WS_Y);
        const size_t s1 = (size_t)tstart[R.e1] * 256 + R.p1, s2 = (size_t)tstart[R.e2] * 256 + R.p2;
        wide_load(R.m1, Y + s1 * 1024, lane, false); wide_load(R.m2, Y + s2 * 1024, lane, false);
    }
}
struct RowVec { f32x4 ws[4], sh[4], ga[4], gf[4]; };
template <int MODE> __device__ __forceinline__ void row_vecs(RowVec& V, CArgs& A, int l, int b, int lane) {
    const float* MOD = (const float*)(A.ws + WS_MOD);
    if (MODE != 2) { const float* m = MOD + (size_t)(l * 9 + b) * 6144; const float* nw = A.in[6] + l * D;
#pragma unroll
        for (int j = 0; j < 4; ++j) { const f32x4 w = ((const f32x4*)nw)[lane + 64 * j], s = ((const f32x4*)(m + 1024))[lane + 64 * j]; V.ws[j] = w * (s + 1.0f); V.sh[j] = ((const f32x4*)m)[lane + 64 * j]; }
    } else {
#pragma unroll
        for (int j = 0; j < 4; ++j) V.ws[j] = ((const f32x4*)A.in[29])[lane + 64 * j];
    }
    if (MODE != 0) { const int lp = MODE == 1 ? l - 1 : DEPTH - 1; const float* mp = MOD + (size_t)(lp * 9 + b) * 6144;
#pragma unroll
        for (int j = 0; j < 4; ++j) { V.ga[j] = ((const f32x4*)(mp + 2 * 1024))[lane + 64 * j]; V.gf[j] = ((const f32x4*)(mp + 5 * 1024))[lane + 64 * j]; }
    }
}
template <int MODE> __device__ __forceinline__ void row_finish(RowRaw& R, const RowVec& V, CArgs& A, int row, int lane) {
    f32x4 v[4];
    if (MODE == 2) { u32x2 xx[4]; wide_unpack(R.xw, lane, xx);
#pragma unroll
        for (int j = 0; j < 4; ++j) v[j] = (f32x4){bflo(xx[j].x), bfhi(xx[j].x), bflo(xx[j].y), bfhi(xx[j].y)}; }
    else {
#pragma unroll
        for (int j = 0; j < 4; ++j) v[j] = R.x[j]; }
    if (MODE != 0) {
        u32x2 yy[4], aa[4], bb[4]; wide_unpack(R.y, lane, yy); wide_unpack(R.m1, lane, aa); wide_unpack(R.m2, lane, bb);
#pragma unroll
        for (int j = 0; j < 4; ++j) { const f32x4 ga = V.ga[j], gf = V.gf[j];
            const u32x2 y = yy[j], a = aa[j], b = bb[j];
            v[j].x += ga.x * bflo(y.x) + gf.x * (R.g1 * bflo(a.x) + R.g2 * bflo(b.x)); v[j].y += ga.y * bfhi(y.x) + gf.y * (R.g1 * bfhi(a.x) + R.g2 * bfhi(b.x));
            v[j].z += ga.z * bflo(y.y) + gf.z * (R.g1 * bflo(a.y) + R.g2 * bflo(b.y)); v[j].w += ga.w * bfhi(y.y) + gf.w * (R.g1 * bfhi(a.y) + R.g2 * bfhi(b.y)); }
        if (MODE == 1 && row >= RC) { u32x2 xo[4];
#pragma unroll
            for (int j = 0; j < 4; ++j) { xo[j].x = pk2(v[j].x, v[j].y); xo[j].y = pk2(v[j].z, v[j].w); }
            wide_store(xb_row(A, row), lane, xo); }
    }
    const float rstd = row_rstd(v);
    if (MODE == 2) {
#pragma unroll
        for (int j = 0; j < 4; ++j) v[j] = v[j] * rstd * V.ws[j];
        store_row(A.out + (size_t)(row - RC) * D, lane, v);
    } else {
        bf16_t* orow = (bf16_t*)((unsigned char*)A.out) + (size_t)row * D; u32x2 oo[4];
#pragma unroll
        for (int j = 0; j < 4; ++j) { const f32x4 h = v[j] * rstd * V.ws[j] + V.sh[j]; oo[j].x = pk2(h.x, h.y); oo[j].y = pk2(h.z, h.w); }
        wide_store(orow, lane, oo);
    }
}
template <int MODE> __device__ __forceinline__ void row_phase(Frame& F, int l) {
    CArgs& A = *get_args();
    if (MODE != 0) build_tstart(F, MODE == 1 ? l - 1 : DEPTH - 1);
    const LAS int* tstart = (const LAS int*)(F.lds + LC_TSTART);
    const int r0 = MODE == 2 ? RC : 0, per = (RT - r0 + F.NGW - 1) / F.NGW;
    const int rb = r0 + F.gw * per, re = rb + per < RT ? rb + per : RT;
    RowVec V; int bprev = -1;
    for (int row = rb; row < re; row += 2) {
        const int rowB = row + 1; const bool hasB = rowB < re;
        RowRaw Ra, Rb;
        row_issue1<MODE>(Ra, A, l, row, F.lane); if (hasB) row_issue1<MODE>(Rb, A, l, rowB, F.lane);
        row_issue2<MODE>(Ra, A, tstart, F.lane); if (hasB) row_issue2<MODE>(Rb, A, tstart, F.lane);
        { const int b = row_bidx(row); if (b != bprev) { row_vecs<MODE>(V, A, l, b, F.lane); bprev = b; } }
        row_finish<MODE>(Ra, V, A, row, F.lane);
        if (hasB) { const int b = row_bidx(rowB); if (b != bprev) { row_vecs<MODE>(V, A, l, b, F.lane); bprev = b; } row_finish<MODE>(Rb, V, A, rowB, F.lane); }
    }
}
__device__ __forceinline__ void phase_prenorm(Frame& F, int l) { if (l == 0) row_phase<0>(F, l); else row_phase<1>(F, l); }
__device__ __forceinline__ void phase_final(Frame& F) { row_phase<2>(F, DEPTH - 1); }
constexpr size_t WS_RWP = WS_S5M + 6 * MiB;
constexpr size_t WS_WP = WS_S5M + 6 * MiB + 640 * 1024;
constexpr size_t WS_CB = WS_S5M + 6 * MiB + 704 * 1024;
__device__ __forceinline__ void router_precompute(Frame& F, int l) {
    CArgs& A = *get_args();
    const float* MOD = (const float*)(A.ws + WS_MOD);
    bf16_t* RWP = (bf16_t*)(A.ws + WS_RWP); float* WP = (float*)(A.ws + WS_WP); float* CB = (float*)(A.ws + WS_CB);
    for (int it = F.bx; it < 9 * 16; it += F.G) { const int b = it >> 4, e = it & 15;
        const float* m = MOD + (size_t)(l * 9 + b) * 6144;
        float s = 0.f;
        for (int k = F.tid; k < 1024; k += NTHR) { const float wp = A.in[7][l * D + k] * (1.0f + m[4 * 1024 + k]); if (e == 0) WP[b * 1024 + k] = wp;
            const float rw = A.in[24][k * 16 + e], v = wp * rw; const unsigned h = f2bf(v); const float r = v - bf2f(h);
            RWP[((size_t)(b * 2 + 0) * 16 + e) * 1024 + k] = (bf16_t)h; RWP[((size_t)(b * 2 + 1) * 16 + e) * 1024 + k] = (bf16_t)f2bf(r);
            s += m[3 * 1024 + k] * rw; }
        s = wave_sum(s);
        LAS float* red = (LAS float*)F.lds;
        __syncthreads(); if (F.lane == 0) red[F.wave] = s; __syncthreads();
        if (F.tid == 0) { float t = 0.f; for (int w = 0; w < NWAVES; ++w) t += red[w]; CB[b * 16 + e] = t; }
    }
}
__device__ __forceinline__ unsigned pk_hi(float a, float b, float& ra, float& rb) { const unsigned ha = f2bf(a), hb = f2bf(b); ra = a - bf2f(ha); rb = b - bf2f(hb); return ha | (hb << 16); }
struct RtRaw { f32x4 xa[4], xb[4]; u32x4 xw[4], yy[4]; };
__device__ __forceinline__ void rt_load(RtRaw& R, CArgs& A, int l, int T, int r, int kq, int w) {
    const int row = T * 16 + r;
    const bf16_t* yr = (const bf16_t*)(A.ws + WS_YO) + (size_t)row * D + 128 * w + 8 * kq;
    if (l == 0) { const float* xr = xin_row(A, row) + 128 * w + 8 * kq;
#pragma unroll
        for (int s = 0; s < 4; ++s) { R.xa[s] = *(const f32x4*)(xr + s * 32); R.xb[s] = *(const f32x4*)(xr + s * 32 + 4); R.yy[s] = *(const u32x4*)(yr + s * 32); }
    } else { const bf16_t* xr = xb_row(A, row) + 128 * w + 8 * kq;
#pragma unroll
        for (int s = 0; s < 4; ++s) { R.xw[s] = *(const u32x4*)(xr + s * 32); R.yy[s] = *(const u32x4*)(yr + s * 32); }
    }
}
__device__ __forceinline__ void phase_router(Frame& F, int l) {
    CArgs& A = *get_args();
    __syncthreads();
    LAS int* lcnt = (LAS int*)F.lds;
    LAS int* rec = lcnt + 64;
    LAS float* part = (LAS float*)(F.lds + 16384);
    if (F.tid < 64) lcnt[F.tid] = 0;
    __syncthreads();
    bf16_t* FB = (bf16_t*)((unsigned char*)A.out);
    int* TOKE = (int*)(A.ws + WS_TOKE); int* TOKP = (int*)(A.ws + WS_TOKP); float* TOKG = (float*)(A.ws + WS_TOKG); int* LIST = (int*)(A.ws + WS_LIST);
    const bf16_t* RWP = (const bf16_t*)(A.ws + WS_RWP); const float* WP = (const float*)(A.ws + WS_WP); const float* CB = (const float*)(A.ws + WS_CB);
    const float* MOD = (const float*)(A.ws + WS_MOD);
    const int lane = F.lane, r = lane & 15, kq = lane >> 4, w = F.wave;
    const int t0 = (l == DEPTH - 1) ? RC / 16 : 0, nt = RT / 16 - t0;
    const int tb = t0 + (int)((long)F.bx * nt / F.G), te = t0 + (int)((long)(F.bx + 1) * nt / F.G);
    RtRaw R;
    if (tb < te) rt_load(R, A, l, tb, r, kq, w);
    int par = 0, bprev = -1; f32x4 pg0[4], pg1[4]; bf16x8 pwh[4], pwl[4];
    for (int T = tb; T < te; ++T, par ^= 1) {
        const int row = T * 16 + r, b = row_bidx(T * 16);
        const RtRaw C = R;
        if (T + 1 < te) rt_load(R, A, l, T + 1, r, kq, w);
        if (b != bprev) {
            const float* ga = MOD + (size_t)(l * 9 + b) * 6144 + 2 * 1024 + 128 * w + 8 * kq;
            const bf16_t* bh = RWP + (size_t)(b * 2 + 0) * 16 * 1024 + 128 * w, * bl = RWP + (size_t)(b * 2 + 1) * 16 * 1024 + 128 * w;
#pragma unroll
            for (int s = 0; s < 4; ++s) { pg0[s] = *(const f32x4*)(ga + s * 32); pg1[s] = *(const f32x4*)(ga + s * 32 + 4); pwh[s] = gfrag(bh, 1024, s * 32, lane); pwl[s] = gfrag(bl, 1024, s * 32, lane); }
            bprev = b; }
        float x[4][8]; f32x4 acc = zero4(); float ss = 0.f;
#pragma unroll
        for (int s = 0; s < 4; ++s) {
            const f32x4 g0 = pg0[s], g1 = pg1[s]; const u32x4 yy = C.yy[s];
            f32x4 xa, xb;
            if (l == 0) { xa = C.xa[s]; xb = C.xb[s]; } else { const u32x4 xw = C.xw[s]; xa = (f32x4){bflo(xw.x), bfhi(xw.x), bflo(xw.y), bfhi(xw.y)}; xb = (f32x4){bflo(xw.z), bfhi(xw.z), bflo(xw.w), bfhi(xw.w)}; }
            x[s][0] = xa.x + g0.x * bflo(yy.x); x[s][1] = xa.y + g0.y * bfhi(yy.x); x[s][2] = xa.z + g0.z * bflo(yy.y); x[s][3] = xa.w + g0.w * bfhi(yy.y);
            x[s][4] = xb.x + g1.x * bflo(yy.z); x[s][5] = xb.y + g1.y * bfhi(yy.z); x[s][6] = xb.z + g1.z * bflo(yy.w); x[s][7] = xb.w + g1.w * bfhi(yy.w);
            u32x4 h, lo;
#pragma unroll
            for (int e2 = 0; e2 < 4; ++e2) { const float a = x[s][2 * e2], bb = x[s][2 * e2 + 1]; ss += a * a + bb * bb;
                const unsigned ua = __builtin_bit_cast(unsigned, a), ub = __builtin_bit_cast(unsigned, bb);
                h[e2] = __builtin_amdgcn_perm(ub, ua, 0x07060302u);
                lo[e2] = pk2(a - __builtin_bit_cast(float, ua & 0xffff0000u), bb - __builtin_bit_cast(float, ub & 0xffff0000u)); }
            const bf16x8 xh = __builtin_bit_cast(bf16x8, h), xl = __builtin_bit_cast(bf16x8, lo);
            const bf16x8 wh = pwh[s], wl = pwl[s];
            acc = __builtin_amdgcn_mfma_f32_16x16x32_bf16(wh, xh, acc, 0, 0, 0);
            acc = __builtin_amdgcn_mfma_f32_16x16x32_bf16(wl, xh, acc, 0, 0, 0);
            acc = __builtin_amdgcn_mfma_f32_16x16x32_bf16(wh, xl, acc, 0, 0, 0);
        }
        ss += __shfl_xor(ss, 16); ss += __shfl_xor(ss, 32);
        LAS float* pp = part + ((par * 8 + w) * 64 + lane) * 5;
        pp[0] = acc[0]; pp[1] = acc[1]; pp[2] = acc[2]; pp[3] = acc[3]; pp[4] = ss;
        LDS_BARRIER();
        f32x4 lgs = zero4(); float sst = 0.f;
#pragma unroll
        for (int ww = 0; ww < 8; ++ww) { const LAS float* qq = part + ((par * 8 + ww) * 64 + lane) * 5; lgs[0] += qq[0]; lgs[1] += qq[1]; lgs[2] += qq[2]; lgs[3] += qq[3]; sst += qq[4]; }
        const float rstd = 1.0f / sqrtf(sst * (1.0f / D) + 1e-6f);
        if (w == 0) {
            const f32x4 cb = *(const f32x4*)(CB + b * 16 + 4 * kq), bias = *(const f32x4*)(A.in[25] + 4 * kq);
            float lg[4], pr[4], sel[4];
#pragma unroll
            for (int j = 0; j < 4; ++j) lg[j] = rstd * lgs[j] + cb[j];
            float mx = fmaxf(fmaxf(lg[0], lg[1]), fmaxf(lg[2], lg[3])); mx = fmaxf(mx, __shfl_xor(mx, 16)); mx = fmaxf(mx, __shfl_xor(mx, 32));
            float ps = 0.f;
#pragma unroll
            for (int j = 0; j < 4; ++j) { pr[j] = __expf(lg[j] - mx); ps += pr[j]; }
            ps += __shfl_xor(ps, 16); ps += __shfl_xor(ps, 32);
            const float ips = 1.0f / ps;
            float f1 = -INFINITY, f2 = -INFINITY;
#pragma unroll
            for (int j = 0; j < 4; ++j) { pr[j] *= ips; sel[j] = pr[j] + bias[j]; const float xx = sel[j]; if (xx > f1) { f2 = f1; f1 = xx; } else if (xx > f2) f2 = xx; }
            const float gs = f1 + f2;
            int bg = 0; float bs = __shfl(gs, r);
#pragma unroll
            for (int g = 1; g < 4; ++g) { const float o = __shfl(gs, r + 16 * g); if (o > bs) { bs = o; bg = g; } }
            if (kq == bg) {
                int i1 = 0; float b1 = sel[0], q1 = pr[0];
#pragma unroll
                for (int j = 1; j < 4; ++j) if (sel[j] > b1) { b1 = sel[j]; i1 = j; q1 = pr[j]; }
                int i2 = -1; float b2 = -INFINITY, q2 = 0.f;
#pragma unroll
                for (int j = 0; j < 4; ++j) if (j != i1 && sel[j] > b2) { b2 = sel[j]; i2 = j; q2 = pr[j]; }
                const int e1 = bg * 4 + i1, e2 = bg * 4 + i2; const float gsum = q1 + q2;
                const int lp1 = atomicAdd((int*)(lcnt + e1), 1), lp2 = atomicAdd((int*)(lcnt + e2), 1), ri = atomicAdd((int*)(lcnt + 32), 1);
                LAS int* r5 = rec + ri * 5; r5[0] = row; r5[1] = e1; r5[2] = lp1; r5[3] = e2; r5[4] = lp2;
                TOKG[row * 2] = q1 / gsum; TOKG[row * 2 + 1] = q2 / gsum;
            }
        }
        const float* wp = WP + b * 1024 + 128 * w + 8 * kq; const float* sh = MOD + (size_t)(l * 9 + b) * 6144 + 3 * 1024 + 128 * w + 8 * kq;
        bf16_t* fo = FB + (size_t)row * D + 128 * w + 8 * kq;
#pragma unroll
        for (int s = 0; s < 4; ++s) {
            const f32x4 w0 = *(const f32x4*)(wp + s * 32), w1 = *(const f32x4*)(wp + s * 32 + 4), s0 = *(const f32x4*)(sh + s * 32), s1 = *(const f32x4*)(sh + s * 32 + 4);
            u32x4 o; o.x = pk2(x[s][0] * rstd * w0.x + s0.x, x[s][1] * rstd * w0.y + s0.y); o.y = pk2(x[s][2] * rstd * w0.z + s0.z, x[s][3] * rstd * w0.w + s0.w);
            o.z = pk2(x[s][4] * rstd * w1.x + s1.x, x[s][5] * rstd * w1.y + s1.y); o.w = pk2(x[s][6] * rstd * w1.z + s1.z, x[s][7] * rstd * w1.w + s1.w);
            *(u32x4*)(fo + s * 32) = o;
        }
    }
    __syncthreads();
    unsigned* gcnt = (unsigned*)(A.ws + WS_CTL) + CW_GCNT + l * 16;
    if (F.tid < 16) lcnt[16 + F.tid] = (int)__hip_atomic_fetch_add(gcnt + F.tid, (unsigned)lcnt[F.tid], __ATOMIC_RELAXED, __HIP_MEMORY_SCOPE_AGENT);
    __syncthreads();
    const int nrec = lcnt[32];
    for (int i = F.tid; i < nrec; i += NTHR) { const LAS int* r5 = rec + i * 5; const int row = r5[0], e1 = r5[1], e2 = r5[3], p1 = lcnt[16 + e1] + r5[2], p2 = lcnt[16 + e2] + r5[4];
        TOKE[row * 2] = e1; TOKE[row * 2 + 1] = e2; TOKP[row * 2] = p1; TOKP[row * 2 + 1] = p2; LIST[(size_t)e1 * RT + p1] = row; LIST[(size_t)e2 * RT + p2] = row; }
    __syncthreads();
}

__device__ __forceinline__ void phase_gemm_in(Frame& F) {
    CArgs& A = *get_args();
    pg8::DenseOrder S; S.init(RT / 256, INW / 256, F.G, F.bx, 0, D, A.ws + WS_WIN);
    pg8::EpiIn E{(bf16_t*)(A.ws + WS_Z), (bf16_t*)(A.ws + WS_A2)};
    pg8::gemm_phase<pg8::EpiIn, pg8::DenseOrder, true>(F.lds, F.tid, (const char*)((unsigned char*)A.out), D, S, E);
}
__device__ __forceinline__ void phase_gemm_out(Frame& F, int l) {
    CArgs& A = *get_args();
    const bool lastl = (l == DEPTH - 1);
    pg8::DenseOrder S; S.init(lastl ? RL / 256 : RT / 256, D / 256, F.G, F.bx, lastl ? 8 : 0, D, A.ws + WS_WOUT);
    pg8::EpiBf16 E{(bf16_t*)(A.ws + WS_YO), D};
    pg8::gemm_phase<pg8::EpiBf16, pg8::DenseOrder, true>(F.lds, F.tid, (const char*)((unsigned char*)A.out), D, S, E);
}
__device__ __forceinline__ int build_moe_tables(Frame& F, int l, int nN, bool gather) {
    CArgs& A = *get_args();
    build_tstart(F, l);
    const LAS int* tstart = (const LAS int*)(F.lds + LC_TSTART); const LAS int* cnt = (const LAS int*)(F.lds + LC_CNT);
    LAS int* tile_e = (LAS int*)(F.lds + LC_TILE_E); LAS unsigned* rowoff = (LAS unsigned*)(F.lds + LC_ROWOFF);
    const int ntiles = tstart[NE];
    for (int t = F.tid; t < ntiles; t += NTHR) { int e = 0;
#pragma unroll
        for (int q = 1; q < NE; ++q) if (t >= tstart[q]) e = q;
        tile_e[t] = e; }
    __syncthreads();
    if (gather) {
        const int* LIST = (const int*)(A.ws + WS_LIST);
        const pg8::MoeOrder So{ntiles, nN, F.G, F.bx, D, nullptr, 0, (const LAS int*)tile_e, nullptr, true};
        for (int i = 0; i < 10; ++i) { pg8::Unit u; if (!So.next(i, u)) break;
            const int tile = u.pm, e = tile_e[tile], lt = tile - tstart[e];
            for (int r = F.tid; r < 256; r += NTHR) { const int j = lt * 256 + r; const int tok = j < cnt[e] ? LIST[(size_t)e * RT + j] : 0; rowoff[i * 256 + r] = (unsigned)tok * (unsigned)(D * 2); } }
        __syncthreads();
    }
    return ntiles;
}
__device__ __forceinline__ void phase_moe1(Frame& F, int l) {
    CArgs& A = *get_args();
    const int ntiles = build_moe_tables(F, l, 8, true);
    pg8::MoeOrder S{ntiles, 8, F.G, F.bx, D, (const char*)(A.ws + WS_W13), (size_t)2048 * D * 2, (const LAS int*)(F.lds + LC_TILE_E), (const LAS unsigned*)(F.lds + LC_ROWOFF), true};
    pg8::EpiSwiGLU E{(bf16_t*)(A.ws + WS_Z)};
    pg8::gemm_phase<pg8::EpiSwiGLU, pg8::MoeOrder, true>(F.lds, F.tid, (const char*)((unsigned char*)A.out), D, S, E);
}
__device__ __forceinline__ void phase_moe2(Frame& F, int l) {
    CArgs& A = *get_args();
    const int ntiles = build_moe_tables(F, l, 4, false);
    pg8::MoeOrder S{ntiles, 4, F.G, F.bx, D, (const char*)(A.ws + WS_W2), (size_t)D * D * 2, (const LAS int*)(F.lds + LC_TILE_E), nullptr, true};
    pg8::EpiBf16 E{(bf16_t*)(A.ws + WS_Y), D};
    pg8::gemm_phase<pg8::EpiBf16, pg8::MoeOrder, true>(F.lds, F.tid, (const char*)(A.ws + WS_Z), D, S, E);
}

#ifndef PROBE_DUP
#define PROBE_DUP 0
#endif
#define DUP(bit) _Pragma("unroll") for (int rep_ = 0; rep_ < (((PROBE_DUP) >> (bit)) & 1) + 1; ++rep_)
constexpr size_t WS_S5W1 = WS_S5M;
constexpr size_t WS_S5W2 = WS_S5M + 2 * MiB;
constexpr int S5T = 16, NCR = RT / S5T;
constexpr int NCH = 34;

__device__ __forceinline__ float log2_gamma(CArgs& A, int l, int dir, int hd) { const float dl = A.in[20][(l * 2 + dir) * 8 + hd]; return (fminf(dl, 0.f) - flog1p_small(fexp(-fabsf(dl)))) * 1.4426950408889634f; }
__device__ __forceinline__ int ret_row0(int b, int c) { return c < 2 ? b * CTXL + 128 * c : RC + b * SEQ + 128 * (c - 2); }
__device__ __forceinline__ int ret_pos0(int c) { return c < 2 ? 128 * c : CTXL + 128 * (c - 2); }
__device__ __forceinline__ void unpack8(u32x4 w, float (&f)[8]) { f[0] = bflo(w.x); f[1] = bfhi(w.x); f[2] = bflo(w.y); f[3] = bfhi(w.y); f[4] = bflo(w.z); f[5] = bfhi(w.z); f[6] = bflo(w.w); f[7] = bfhi(w.w); }

__device__ __forceinline__ void pool_item(Frame& F, CArgs& A, int l, int rowbase, int j0, int n) {
    LAS bf16_t* Ps = (LAS bf16_t*)F.lds;
    LAS bf16_t* Pl = (LAS bf16_t*)(F.lds + 40960);
    const bf16_t* Z = (const bf16_t*)(A.ws + WS_Z);
    LDS_BARRIER();
    for (int idx = F.tid; idx < 80 * 32; idx += NTHR) { const int r = idx >> 5, ch = idx & 31, jj = j0 - 8 + r;
        u32x4 v = (u32x4){0u, 0u, 0u, 0u}; if (jj >= 0 && jj < n) v = *(const u32x4*)(Z + (size_t)(rowbase + jj) * INW + OFF_P + ch * 8);
        *(LAS u32x4*)(Ps + r * 256 + ch * 8) = v; }
    LDS_BARRIER();
    {
        const int ch = F.tid & 31, tr = F.tid >> 5, g = ch >> 3, win = 2 << g, hw = win >> 1;
        const LAS bf16_t* col = Ps + ch * 8;
        float s[8];
#pragma unroll
        for (int e = 0; e < 8; ++e) s[e] = 0.f;
        const int t0 = tr * 4;
        for (int qq = t0 - hw; qq < t0 - hw + win; ++qq) { float f[8]; unpack8(*(const LAS u32x4*)(col + (qq + 8) * 256), f);
#pragma unroll
            for (int e = 0; e < 8; ++e) s[e] += f[e]; }
#pragma unroll
        for (int tt = 0; tt < 4; ++tt) { const int t = t0 + tt, j = j0 + t;
            int lo = j - hw; if (lo < 0) lo = 0; int hi = j - hw + win - 1; if (hi > n - 1) hi = n - 1;
            const float inv = 1.0f / (float)(hi - lo + 1);
            float f0[8]; unpack8(*(const LAS u32x4*)(col + (t + 8) * 256), f0);
            u32x4 o; o.x = pk2(s[0] * inv - f0[0], s[1] * inv - f0[1]); o.y = pk2(s[2] * inv - f0[2], s[3] * inv - f0[3]); o.z = pk2(s[4] * inv - f0[4], s[5] * inv - f0[5]); o.w = pk2(s[6] * inv - f0[6], s[7] * inv - f0[7]);
            *(LAS u32x4*)(Pl + t * 264 + ch * 8) = o;
            if (tt < 3) { float fa[8], fb[8]; unpack8(*(const LAS u32x4*)(col + (t - hw + win + 8) * 256), fa); unpack8(*(const LAS u32x4*)(col + (t - hw + 8) * 256), fb);
#pragma unroll
                for (int e = 0; e < 8; ++e) s[e] += fa[e] - fb[e]; } } }
    LDS_BARRIER();
    const bf16_t* PT = (const bf16_t*)(A.ws + WS_POOLT); bf16_t* MIX = (bf16_t*)((unsigned char*)A.out);
    const int mt = F.wave & 3, lane = F.lane;
#pragma unroll
    for (int gi = 0; gi < 2; ++gi) { const int g = (F.wave >> 2) * 2 + gi;
        const bf16x8 a0 = ldfrag(Pl + mt * 16 * 264 + g * 64, 264, 0, lane), a1 = ldfrag(Pl + mt * 16 * 264 + g * 64, 264, 32, lane);
#pragma unroll
        for (int nt = 0; nt < 4; ++nt) { f32x4 acc = zero4();
            acc = mfma16(gfrag(PT + g * 4096 + nt * 16 * 64, 64, 0, lane), a0, acc); acc = mfma16(gfrag(PT + g * 4096 + nt * 16 * 64, 64, 32, lane), a1, acc);
            const int ch = g * 64 + nt * 16 + 4 * (lane >> 4); const f32x4 sc = *(const f32x4*)(A.in[23] + l * 256 + ch);
            u32x2 o; o.x = pk2(acc[0] * sc.x, acc[1] * sc.y); o.y = pk2(acc[2] * sc.z, acc[3] * sc.w);
            *(u32x2*)(MIX + (size_t)(rowbase + j0 + mt * 16 + (lane & 15)) * D + 768 + ch) = o; } }
}
__device__ __forceinline__ void phase_pool(Frame& F, int l) {
    CArgs& A = *get_args();
    const int nlat = RL / 64, nctx = (l == DEPTH - 1) ? 0 : NB * 4;
    for (int it = F.G - 1 - F.bx; it < nlat + nctx; it += F.G) {
        if (it < nlat) pool_item(F, A, l, RC + it * 64, 0, 64);
        else { const int q = it - nlat; pool_item(F, A, l, (q >> 2) * CTXL, (q & 3) * 64, CTXL); }
    }
    __syncthreads();
}

__device__ __forceinline__ void rot16(const bf16_t* src, const f32x2* ROT, int pos, int q, float scale, float (&lo)[8], float (&hi)[8]) {
    float a[8], b[8]; unpack8(*(const u32x4*)(src + 8 * q), a); unpack8(*(const u32x4*)(src + 32 + 8 * q), b);
    const f32x4* cs = (const f32x4*)(ROT + (size_t)pos * 32) + q;
#pragma unroll
    for (int e2 = 0; e2 < 4; ++e2) { const f32x4 w = cs[e2 * 4];
        lo[2 * e2] = (a[2 * e2] * w.x - b[2 * e2] * w.y) * scale; hi[2 * e2] = (a[2 * e2] * w.y + b[2 * e2] * w.x) * scale;
        lo[2 * e2 + 1] = (a[2 * e2 + 1] * w.z - b[2 * e2 + 1] * w.w) * scale; hi[2 * e2 + 1] = (a[2 * e2 + 1] * w.w + b[2 * e2 + 1] * w.z) * scale; }
}
__device__ __forceinline__ bf16x8 ldfrag_sw(const LAS bf16_t* base, int ld, int k0, int key, int lane) { return *(const LAS bf16x8*)(base + (lane & 15) * ld + ((k0 + 8 * (lane >> 4)) ^ (key << 4))); }
struct KvRaw { u32x4 k0, k1, v0, v1; f32x4 rf[4], rb[4]; };
__device__ __forceinline__ void kv_load(KvRaw& R, CArgs& A, int it, int iA, int qA) {
    const int hd = it & 7, bc = it >> 3, c = bc % NCH, b = bc / NCH;
    const bf16_t* Z = (const bf16_t*)(A.ws + WS_Z); const f32x2* ROT = (const f32x2*)(A.ws + WS_ROT);
    const bf16_t* za = Z + (size_t)(ret_row0(b, c) + iA) * INW + hd * 64;
    R.k0 = *(const u32x4*)(za + OFF_K + 8 * qA); R.k1 = *(const u32x4*)(za + OFF_K + 32 + 8 * qA);
    R.v0 = *(const u32x4*)(za + OFF_V + 16 * qA); R.v1 = *(const u32x4*)(za + OFF_V + 16 * qA + 8);
    const int pf = ret_pos0(c) + iA, pb = c < 2 ? CTXL - 1 - (128 * c + iA) : CTXL + SEQ - 1 - (128 * (c - 2) + iA);
    const f32x4* cf_ = (const f32x4*)(ROT + (size_t)pf * 32) + qA; const f32x4* cb_ = (const f32x4*)(ROT + (size_t)pb * 32) + qA;
#pragma unroll
    for (int e = 0; e < 4; ++e) { R.rf[e] = cf_[e * 4]; R.rb[e] = cb_[e * 4]; }
}
__device__ __forceinline__ void rot8(const u32x4 a8, const u32x4 b8, const f32x4 (&cs)[4], float scale, float (&l)[8], float (&h)[8]) {
    float a[8], b[8]; unpack8(a8, a); unpack8(b8, b);
#pragma unroll
    for (int e2 = 0; e2 < 4; ++e2) { const f32x4 w = cs[e2];
        l[2 * e2] = (a[2 * e2] * w.x - b[2 * e2] * w.y) * scale; h[2 * e2] = (a[2 * e2] * w.y + b[2 * e2] * w.x) * scale;
        l[2 * e2 + 1] = (a[2 * e2 + 1] * w.z - b[2 * e2 + 1] * w.w) * scale; h[2 * e2 + 1] = (a[2 * e2 + 1] * w.w + b[2 * e2 + 1] * w.z) * scale; }
}
__device__ __forceinline__ void phase_ret_kv(Frame& F, int l) {
    CArgs& A = *get_args();
    bf16_t* KV = (bf16_t*)(A.ws + WS_KV);
    LAS bf16_t* Kt = (LAS bf16_t*)F.lds;
    LAS bf16_t* Vt = (LAS bf16_t*)(F.lds + 2 * 64 * 136 * 2);
    const int iA = F.tid >> 2, qA = F.tid & 3, lane = F.lane, nit = NB * NCH * 8;
    const int hd = F.bx & 7;
    const float lgf = log2_gamma(A, l, 0, hd), lgb = log2_gamma(A, l, 1, hd);
    const float wf = fexp2((float)(127 - iA) * lgf), wb = fexp2((float)iA * lgb);
    const int ik = iA ^ (qA << 4);
    KvRaw R;
    if (F.bx < nit) kv_load(R, A, F.bx, iA, qA);
    for (int it = F.bx; it < nit; it += F.G) {
        const int bc = it >> 3, c = bc % NCH, b = bc / NCH;
        const KvRaw C = R;
        if (it + F.G < nit) kv_load(R, A, it + F.G, iA, qA);
        LDS_BARRIER();
        { float lo[8], hi[8];
            rot8(C.k0, C.k1, C.rf, 0.125f, lo, hi);
#pragma unroll
            for (int e = 0; e < 8; ++e) { Kt[(8 * qA + e) * 136 + ik] = (bf16_t)f2bf(lo[e]); Kt[(32 + 8 * qA + e) * 136 + ik] = (bf16_t)f2bf(hi[e]); }
            rot8(C.k0, C.k1, C.rb, 0.125f, lo, hi);
#pragma unroll
            for (int e = 0; e < 8; ++e) { Kt[(64 + 8 * qA + e) * 136 + ik] = (bf16_t)f2bf(lo[e]); Kt[(64 + 32 + 8 * qA + e) * 136 + ik] = (bf16_t)f2bf(hi[e]); }
            float v0[8], v1[8]; unpack8(C.v0, v0); unpack8(C.v1, v1);
#pragma unroll
            for (int e = 0; e < 8; ++e) { Vt[(16 * qA + e) * 136 + ik] = (bf16_t)f2bf(v0[e] * wf); Vt[(16 * qA + 8 + e) * 136 + ik] = (bf16_t)f2bf(v1[e] * wf);
                Vt[(64 + 16 * qA + e) * 136 + ik] = (bf16_t)f2bf(v0[e] * wb); Vt[(64 + 16 * qA + 8 + e) * 136 + ik] = (bf16_t)f2bf(v1[e] * wb); } }
        LDS_BARRIER();
        const int dir = F.wave >> 2, mt = F.wave & 3;
        bf16x8 vf[4];
#pragma unroll
        for (int ks = 0; ks < 4; ++ks) vf[ks] = ldfrag_sw(Vt + (dir * 64 + mt * 16) * 136, 136, ks * 32, mt, lane);
        bf16_t* out = KV + ((size_t)(((b * 8 + hd) * 2 + dir) * NCH + c)) * 4096 + (mt * 16 + (lane & 15)) * 64 + 4 * (lane >> 4);
#pragma unroll
        for (int nt = 0; nt < 4; ++nt) { f32x4 acc = zero4(); const int kkey = (2 * nt + ((lane & 15) >> 3)) & 3;
#pragma unroll
            for (int ks = 0; ks < 4; ++ks) acc = mfma16(ldfrag_sw(Kt + (dir * 64 + nt * 16) * 136, 136, ks * 32, kkey, lane), vf[ks], acc);
            u32x2 ww; ww.x = pk2(acc[0], acc[1]); ww.y = pk2(acc[2], acc[3]); *(u32x2*)(out + nt * 16) = ww; }
    }
    __syncthreads();
}
__device__ __forceinline__ void ret_scan(CArgs& A, int l, int gidx, int gstride) {
    bf16_t* KV = (bf16_t*)(A.ws + WS_KV);
    for (int idx = gidx; idx < NB * 8 * 2 * 1024; idx += gstride) {
        const int e4 = idx & 1023, chain = idx >> 10, dir = chain & 1, hd = (chain >> 1) & 7;
        const float lg_ = log2_gamma(A, l, dir, hd), cdec = fexp2(128.0f * lg_), cfo = dir == 0 ? fexp2(lg_) : cdec;
        u32x2* base = (u32x2*)(KV + (size_t)chain * NCH * 4096) + e4;
        f32x4 s = zero4();
#pragma unroll
        for (int half = 0; half < 2; ++half) { u32x2 v[17];
#pragma unroll
            for (int j = 0; j < 17; ++j) { const int k = half * 17 + j, c = dir == 0 ? k : (k < 2 ? 1 - k : NCH + 1 - k); v[j] = base[(size_t)c * 1024]; }
#pragma unroll
            for (int j = 0; j < 17; ++j) { const int k = half * 17 + j, c = dir == 0 ? k : (k < 2 ? 1 - k : NCH + 1 - k);
                u32x2 o; o.x = pk2(s[0] * cfo, s[1] * cfo); o.y = pk2(s[2] * cfo, s[3] * cfo); base[(size_t)c * 1024] = o;
                s = s * cdec + (f32x4){bflo(v[j].x), bfhi(v[j].x), bflo(v[j].y), bfhi(v[j].y)}; } }
    }
}
struct RetRaw { u32x4 q0, q1, k0, k1, v0, v1, sf, sb; f32x4 rf[4], rb[4]; };
constexpr int RET_BUF_E = 2 * 128 * 72 + 64 * 136 + 2 * 64 * 72;
static_assert(2 * RET_BUF_E * 2 <= LC_MISC, "ret_out LDS");
__device__ __forceinline__ void ret_decode(int it, int c_lo, int nch, int& hd, int& c, int& b) { hd = it & 7; const int bc = it >> 3; c = c_lo + bc % nch; b = bc / nch; }
__device__ __forceinline__ void ret_load(RetRaw& R, CArgs& A, int it, int c_lo, int nch, int tok, int q, int tid) {
    int hd, c, b; ret_decode(it, c_lo, nch, hd, c, b);
    const bf16_t* Z = (const bf16_t*)(A.ws + WS_Z); const bf16_t* KV = (const bf16_t*)(A.ws + WS_KV); const f32x2* ROT = (const f32x2*)(A.ws + WS_ROT);
    const bf16_t* za = Z + (size_t)(ret_row0(b, c) + tok) * INW + hd * 64;
    R.q0 = *(const u32x4*)(za + OFF_Q + 8 * q); R.q1 = *(const u32x4*)(za + OFF_Q + 32 + 8 * q);
    R.k0 = *(const u32x4*)(za + OFF_K + 8 * q); R.k1 = *(const u32x4*)(za + OFF_K + 32 + 8 * q);
    R.v0 = *(const u32x4*)(za + OFF_V + 16 * q); R.v1 = *(const u32x4*)(za + OFF_V + 16 * q + 8);
    const bf16_t* kvf = KV + ((size_t)(((b * 8 + hd) * 2 + 0) * NCH + c)) * 4096 + (tid >> 3) * 64 + 8 * (tid & 7);
    R.sf = *(const u32x4*)kvf; R.sb = *(const u32x4*)(kvf + (size_t)NCH * 4096);
    const int pf = ret_pos0(c) + tok, pb = c < 2 ? CTXL - 1 - (128 * c + tok) : CTXL + SEQ - 1 - (128 * (c - 2) + tok);
    const f32x4* cf_ = (const f32x4*)(ROT + (size_t)pf * 32) + q; const f32x4* cb_ = (const f32x4*)(ROT + (size_t)pb * 32) + q;
#pragma unroll
    for (int e = 0; e < 4; ++e) { R.rf[e] = cf_[e * 4]; R.rb[e] = cb_[e * 4]; }
}
__device__ __forceinline__ void rot_pack(const u32x4 a8, const u32x4 b8, const f32x4 (&cs)[4], float scale, u32x4& lo, u32x4& hi) {
    float a[8], b[8], l[8], h[8]; unpack8(a8, a); unpack8(b8, b);
#pragma unroll
    for (int e2 = 0; e2 < 4; ++e2) { const f32x4 w = cs[e2];
        l[2 * e2] = (a[2 * e2] * w.x - b[2 * e2] * w.y) * scale; h[2 * e2] = (a[2 * e2] * w.y + b[2 * e2] * w.x) * scale;
        l[2 * e2 + 1] = (a[2 * e2 + 1] * w.z - b[2 * e2 + 1] * w.w) * scale; h[2 * e2 + 1] = (a[2 * e2 + 1] * w.w + b[2 * e2 + 1] * w.z) * scale; }
    lo.x = pk2(l[0], l[1]); lo.y = pk2(l[2], l[3]); lo.z = pk2(l[4], l[5]); lo.w = pk2(l[6], l[7]);
    hi.x = pk2(h[0], h[1]); hi.y = pk2(h[2], h[3]); hi.z = pk2(h[4], h[5]); hi.w = pk2(h[6], h[7]);
}
__device__ __forceinline__ void ret_stage(const RetRaw& C, LAS bf16_t* B, int tok, int q, int tid, float sqf, float skf, float sqb, float skb, u32x4 (&qf)[2][2]) {
    LAS bf16_t* Ks = B; LAS bf16_t* Vt = B + 2 * 128 * 72; LAS bf16_t* Sn = Vt + 64 * 136;
    { const int col = ((tok & ~31) + pg8::perm32(tok & 31)) ^ (q << 5);
#pragma unroll
        for (int e2 = 0; e2 < 4; ++e2) { const unsigned w0 = C.v0[e2], w1 = C.v1[e2];
            Vt[(16 * q + 2 * e2) * 136 + col] = (bf16_t)(w0 & 0xffffu); Vt[(16 * q + 2 * e2 + 1) * 136 + col] = (bf16_t)(w0 >> 16);
            Vt[(16 * q + 8 + 2 * e2) * 136 + col] = (bf16_t)(w1 & 0xffffu); Vt[(16 * q + 8 + 2 * e2 + 1) * 136 + col] = (bf16_t)(w1 >> 16); } }
    { u32x4 lo, hi;
        rot_pack(C.k0, C.k1, C.rf, skf, lo, hi); *(LAS u32x4*)(Ks + tok * 72 + 8 * q) = lo; *(LAS u32x4*)(Ks + tok * 72 + 32 + 8 * q) = hi;
        rot_pack(C.k0, C.k1, C.rb, skb, lo, hi); *(LAS u32x4*)(Ks + (128 + tok) * 72 + 8 * q) = lo; *(LAS u32x4*)(Ks + (128 + tok) * 72 + 32 + 8 * q) = hi; }
    rot_pack(C.q0, C.q1, C.rf, sqf, qf[0][0], qf[0][1]); rot_pack(C.q0, C.q1, C.rb, sqb, qf[1][0], qf[1][1]);
    *(LAS u32x4*)(Sn + (tid >> 3) * 72 + 8 * (tid & 7)) = C.sf; *(LAS u32x4*)(Sn + (64 + (tid >> 3)) * 72 + 8 * (tid & 7)) = C.sb;
}
__device__ __forceinline__ void ret_compute(const LAS bf16_t* B, const u32x4 (&qf)[2][2], int w, int lane, f32x4 (&o)[4]) {
    const LAS bf16_t* Ks = B; const LAS bf16_t* Vt = B + 2 * 128 * 72; const LAS bf16_t* Sn = Vt + 64 * 136;
    const int fr = lane & 15, fq = lane >> 4, ii = 16 * w + fr, wh = w >> 1, nf = wh + 1;
    const f32x4 Z0 = zero4();
#pragma unroll
    for (int t = 0; t < 4; ++t) o[t] = Z0;
#pragma unroll
    for (int s = 0; s < 5; ++s) {
        const bool bwd = s >= nf;
        const int ks = bwd ? wh + (s - nf) : s;
        const LAS bf16_t* Kd = Ks + (bwd ? 128 * 72 : 0) + ks * 32 * 72;
        const bf16x8 qa0 = __builtin_bit_cast(bf16x8, bwd ? qf[1][0] : qf[0][0]), qa1 = __builtin_bit_cast(bf16x8, bwd ? qf[1][1] : qf[0][1]);
        f32x4 s0 = mfma16(ldfrag(Kd, 72, 0, lane), qa0, Z0); s0 = mfma16(ldfrag(Kd, 72, 32, lane), qa1, s0);
        f32x4 s1 = mfma16(ldfrag(Kd + 16 * 72, 72, 0, lane), qa0, Z0); s1 = mfma16(ldfrag(Kd + 16 * 72, 72, 32, lane), qa1, s1);
        const int j0 = ks * 32 + 4 * fq;
        float d0[4], d1[4];
#pragma unroll
        for (int j = 0; j < 4; ++j) { d0[j] = ((j0 + j <= ii) != bwd) ? s0[j] : 0.f; d1[j] = ((j0 + 16 + j <= ii) != bwd) ? s1[j] : 0.f; }
        u32x4 pw; pw.x = pk2(d0[0], d0[1]); pw.y = pk2(d0[2], d0[3]); pw.z = pk2(d1[0], d1[1]); pw.w = pk2(d1[2], d1[3]);
        const bf16x8 sa = __builtin_bit_cast(bf16x8, pw);
#pragma unroll
        for (int t = 0; t < 4; ++t) o[t] = mfma16(*(const LAS bf16x8*)(Vt + (t * 16 + fr) * 136 + ((ks * 32 + 8 * fq) ^ (t << 5))), sa, o[t]);
    }
#pragma unroll
    for (int dir = 0; dir < 2; ++dir) { const bf16x8 qa0 = __builtin_bit_cast(bf16x8, qf[dir][0]), qa1 = __builtin_bit_cast(bf16x8, qf[dir][1]);
#pragma unroll
        for (int t = 0; t < 4; ++t) { o[t] = mfma16(ldfrag(Sn + (dir * 64 + t * 16) * 72, 72, 0, lane), qa0, o[t]); o[t] = mfma16(ldfrag(Sn + (dir * 64 + t * 16) * 72, 72, 32, lane), qa1, o[t]); } }
}
__device__ __forceinline__ void phase_ret_out(Frame& F, int l) {
    CArgs& A = *get_args();
    bf16_t* MIX = (bf16_t*)A.out; const bf16_t* Z = (const bf16_t*)(A.ws + WS_Z);
    LAS bf16_t* L0 = (LAS bf16_t*)F.lds;
    const int lane = F.lane, fr = lane & 15, fq = lane >> 4, w = F.wave, tok = 16 * w + fr;
    const int c_lo = (l == DEPTH - 1) ? 2 : 0, nch = NCH - c_lo, nit = NB * nch * 8;
    const int hd = F.bx & 7;
    const float lgf = log2_gamma(A, l, 0, hd), lgb = log2_gamma(A, l, 1, hd);
    const float sqf = fexp2((float)tok * lgf), skf = 0.125f * fexp2(-(float)tok * lgf), sqb = fexp2(-(float)tok * lgb), skb = 0.125f * fexp2((float)tok * lgb);
    f32x4 gwv[4];
#pragma unroll
    for (int t = 0; t < 4; ++t) gwv[t] = *(const f32x4*)(A.in[21] + l * 512 + hd * 64 + t * 16 + 4 * fq);
    RetRaw R; u32x4 qc[2][2], qn[2][2];
    int it = F.bx;
    if (it < nit) { ret_load(R, A, it, c_lo, nch, tok, fq, F.tid); ret_stage(R, L0, tok, fq, F.tid, sqf, skf, sqb, skb, qc); if (it + F.G < nit) ret_load(R, A, it + F.G, c_lo, nch, tok, fq, F.tid); }
    LDS_BARRIER();
    int p = 0;
    for (; it < nit; it += F.G, p ^= 1) {
        int hd_, c, b; ret_decode(it, c_lo, nch, hd_, c, b);
        const size_t orow = (size_t)(ret_row0(b, c) + tok);
        u32x2 gg[4];
#pragma unroll
        for (int t = 0; t < 4; ++t) gg[t] = *(const u32x2*)(Z + orow * INW + OFF_G + hd * 64 + t * 16 + 4 * fq);
        if (it + F.G < nit) { ret_stage(R, L0 + (p ^ 1) * RET_BUF_E, tok, fq, F.tid, sqf, skf, sqb, skb, qn);
            if (it + 2 * F.G < nit) ret_load(R, A, it + 2 * F.G, c_lo, nch, tok, fq, F.tid); }
        f32x4 o[4];
        ret_compute(L0 + p * RET_BUF_E, qc, w, lane, o);
        float s1 = 0.f;
#pragma unroll
        for (int t = 0; t < 4; ++t) s1 += (o[t][0] + o[t][1]) + (o[t][2] + o[t][3]);
        s1 += __shfl_xor(s1, 16); s1 += __shfl_xor(s1, 32);
        const float mu = s1 * (1.0f / 64.0f); float s2 = 0.f;
#pragma unroll
        for (int t = 0; t < 4; ++t) { o[t] = o[t] - mu; s2 += (o[t][0] * o[t][0] + o[t][1] * o[t][1]) + (o[t][2] * o[t][2] + o[t][3] * o[t][3]); }
        s2 += __shfl_xor(s2, 16); s2 += __shfl_xor(s2, 32);
        const float rstd = 1.0f / sqrtf(s2 * (1.0f / 64.0f) + 1e-5f);
#pragma unroll
        for (int t = 0; t < 4; ++t) { const int ch = hd * 64 + t * 16 + 4 * fq; const f32x4 gw = gwv[t];
            const u32x2 g2 = gg[t];
            u32x2 ww; ww.x = pk2(o[t][0] * rstd * gw.x * siluf_(bflo(g2.x)), o[t][1] * rstd * gw.y * siluf_(bfhi(g2.x))); ww.y = pk2(o[t][2] * rstd * gw.z * siluf_(bflo(g2.y)), o[t][3] * rstd * gw.w * siluf_(bfhi(g2.y)));
            *(u32x2*)(MIX + orow * D + 256 + ch) = ww; }
        LDS_BARRIER();
#pragma unroll
        for (int d = 0; d < 2; ++d) { qc[d][0] = qn[d][0]; qc[d][1] = qn[d][1]; }
    }
    __syncthreads();
}

__device__ __forceinline__ void s5_build_item(Frame& F, CArgs& A, int l, int g, int sub) {
    constexpr int PS = 130;
    LAS float* AP = (LAS float*)F.lds;
    LAS float* BB = AP + 2 * 17 * PS;
    LAS float* CC = BB + 2 * 64 * 16 * 2;
    LAS float* KK = CC + 2 * 16 * PS;
    __syncthreads();
    if (F.tid < 128) { const int dir = F.tid >> 6, p = F.tid & 63, pg = (l * 2 + dir) * 16 + g;
        const float are = A.in[10][pg * 64 + p], aim = A.in[11][pg * 64 + p], dt = fexp(A.in[12][pg]);
        const float mag = fexp(dt * are); float sn, cs; sincos_d(dt * aim, sn, cs);
        const float abr = mag * cs, abi = mag * sn, inv = 1.0f / (are * are + aim * aim);
        const float fre = ((abr - 1.0f) * are + abi * aim) * inv, fim = (abi * are - (abr - 1.0f) * aim) * inv;
        float pr = 1.f, pi = 0.f;
        for (int t = 0; t <= 16; ++t) { AP[(dir * 17 + t) * PS + p * 2] = pr; AP[(dir * 17 + t) * PS + p * 2 + 1] = pi; const float nr = pr * abr - pi * abi, ni = pr * abi + pi * abr; pr = nr; pi = ni; }
        for (int h = 0; h < 16; ++h) { const float br = A.in[13][(pg * 64 + p) * 16 + h], bi = A.in[14][(pg * 64 + p) * 16 + h];
            BB[((dir * 64 + p) * 16 + h) * 2] = fre * br - fim * bi; BB[((dir * 64 + p) * 16 + h) * 2 + 1] = fre * bi + fim * br;
            CC[(dir * 16 + h) * PS + p * 2] = A.in[15][(pg * 16 + h) * 64 + p]; CC[(dir * 16 + h) * PS + p * 2 + 1] = A.in[16][(pg * 16 + h) * 64 + p]; } }
    __syncthreads();
    { const int ho = F.tid & 15, tau = (F.tid >> 4) & 15, dir = F.tid >> 8;
        float s[16];
#pragma unroll
        for (int h = 0; h < 16; ++h) s[h] = 0.f;
        for (int p = 0; p < 64; ++p) { const f32x2 a = *(const LAS f32x2*)(AP + (dir * 17 + tau) * PS + p * 2), c = *(const LAS f32x2*)(CC + (dir * 16 + ho) * PS + p * 2);
            const float tr = c.x * a.x - c.y * a.y, ti = c.x * a.y + c.y * a.x; const LAS f32x4* bp = (const LAS f32x4*)(BB + (dir * 64 + p) * 32);
#pragma unroll
            for (int h2 = 0; h2 < 8; ++h2) { const f32x4 b = bp[h2]; s[2 * h2] += tr * b.x - ti * b.y; s[2 * h2 + 1] += tr * b.z - ti * b.w; } }
#pragma unroll
        for (int h = 0; h < 16; ++h) KK[((dir * 16 + tau) * 16 + ho) * 16 + h] = s[h]; }
    __syncthreads();
    bf16_t* W1 = (bf16_t*)(A.ws + WS_S5W1) + (size_t)g * 256 * 256; bf16_t* W2 = (bf16_t*)(A.ws + WS_S5W2) + (size_t)g * 256 * 512;
    for (int idx = F.tid; idx < 16 * 256; idx += NTHR) { const int k = idx & 255, n = sub * 16 + (idx >> 8), j = k >> 4, hi = k & 15;
        { const int dir = n >> 7, im = (n >> 6) & 1, p = n & 63, tau = dir == 0 ? 15 - j : j;
            const float ar = AP[(dir * 17 + tau) * PS + p * 2], ai = AP[(dir * 17 + tau) * PS + p * 2 + 1], br = BB[((dir * 64 + p) * 16 + hi) * 2], bi = BB[((dir * 64 + p) * 16 + hi) * 2 + 1];
            W1[(size_t)n * 256 + k] = (bf16_t)f2bf(im ? ar * bi + ai * br : ar * br - ai * bi); }
        { const int t = n >> 4, ho = n & 15; float v;
            if (j < t) v = KK[((0 * 16 + (t - j)) * 16 + ho) * 16 + hi]; else if (j > t) v = KK[((1 * 16 + (j - t)) * 16 + ho) * 16 + hi];
            else v = KK[((0 * 16 + 0) * 16 + ho) * 16 + hi] + KK[((1 * 16 + 0) * 16 + ho) * 16 + hi] + (ho == hi ? A.in[17][l * 256 + g * 16 + ho] : 0.f);
            W2[(size_t)n * 512 + k] = (bf16_t)f2bf(v); }
        { const int t = n >> 4, ho = n & 15, dir = k >> 7, im = (k >> 6) & 1, p = k & 63, tau = dir == 0 ? t + 1 : 16 - t;
            const float ar = AP[(dir * 17 + tau) * PS + p * 2], ai = AP[(dir * 17 + tau) * PS + p * 2 + 1], cr = CC[(dir * 16 + ho) * PS + p * 2], ci = CC[(dir * 16 + ho) * PS + p * 2 + 1];
            W2[(size_t)n * 512 + 256 + k] = (bf16_t)f2bf(im ? -(cr * ai + ci * ar) : cr * ar - ci * ai); } }
    __syncthreads();
}
__device__ __forceinline__ void phase_s5_local(Frame& F) {
    CArgs& A = *get_args();
    pg8::S5Order S{F.G, F.bx, 256, (const char*)(A.ws + WS_S5W1), (size_t)256 * 256 * 2};
    pg8::EpiHloc E{(float*)(A.ws + WS_HLOC), NCR};
    pg8::gemm_phase<pg8::EpiHloc, pg8::S5Order, true>(F.lds, F.tid, (const char*)(A.ws + WS_A2), 256, S, E);
}
__device__ __forceinline__ int s5_chain_cr(int b, int dir, int k) {
    constexpr int ncc = CTXL / S5T, ncl = SEQ / S5T;
    if (dir == 0) return k < ncc ? b * ncc + k : RC / S5T + b * ncl + (k - ncc);
    return k < ncc ? b * ncc + (ncc - 1 - k) : RC / S5T + b * ncl + (ncl - 1 - (k - ncc));
}
__device__ __forceinline__ void s5_scan_block(Frame& F, CArgs& A, int l, int chain) {
    LAS float* ex = (LAS float*)F.lds;
    const int dir = chain & 1, g = (chain >> 1) & 15, b = chain >> 5, pg = (l * 2 + dir) * 16 + g, p = F.lane, w = F.wave;
    const float are = A.in[10][pg * 64 + p], aim = A.in[11][pg * 64 + p], dt = fexp(A.in[12][pg]);
    const float mag = fexp(dt * are); float sn, cs; sincos_d(dt * aim, sn, cs);
    float ar = mag * cs, ai = mag * sn;
#pragma unroll
    for (int s = 0; s < 4; ++s) { const float nr = ar * ar - ai * ai, ni = 2.f * ar * ai; ar = nr; ai = ni; }
    const float* HLOC = (const float*)(A.ws + WS_HLOC); bf16_t* A2 = (bf16_t*)(A.ws + WS_A2);
    float lr[34], li[34];
#pragma unroll
    for (int j = 0; j < 34; ++j) { const int cr = s5_chain_cr(b, dir, w * 34 + j); const size_t o = ((size_t)g * 2304 + cr) * 256 + dir * 128 + p; lr[j] = HLOC[o]; li[j] = HLOC[o + 64]; }
    float hr = 0.f, hi = 0.f;
#pragma unroll
    for (int j = 0; j < 34; ++j) { const float nr = ar * hr - ai * hi + lr[j], ni = ar * hi + ai * hr + li[j]; hr = nr; hi = ni; }
    __syncthreads();
    ex[(w * 64 + p) * 2] = hr; ex[(w * 64 + p) * 2 + 1] = hi;
    __syncthreads();
    float br = ar, bi = ai;
#pragma unroll
    for (int s = 0; s < 5; ++s) { const float nr = br * br - bi * bi, ni = 2.f * br * bi; br = nr; bi = ni; }
    { const float x2r = ar * ar - ai * ai, x2i = 2.f * ar * ai; const float nr = br * x2r - bi * x2i, ni = br * x2i + bi * x2r; br = nr; bi = ni; }
    hr = 0.f; hi = 0.f;
    for (int ww = 0; ww < w; ++ww) { const float er = ex[(ww * 64 + p) * 2], ei = ex[(ww * 64 + p) * 2 + 1]; const float nr = br * hr - bi * hi + er, ni = br * hi + bi * hr + ei; hr = nr; hi = ni; }
#pragma unroll
    for (int j = 0; j < 34; ++j) { const int cr = s5_chain_cr(b, dir, w * 34 + j); const size_t o = ((size_t)g * 2304 + cr) * 512 + 256 + dir * 128 + p;
        A2[o] = (bf16_t)f2bf(hr); A2[o + 64] = (bf16_t)f2bf(hi);
        const float nr = ar * hr - ai * hi + lr[j], ni = ar * hi + ai * hr + li[j]; hr = nr; hi = ni; }
}
__device__ __forceinline__ void phase_s5_out(Frame& F) {
    CArgs& A = *get_args();
    pg8::S5Order S{F.G, F.bx, 512, (const char*)(A.ws + WS_S5W2), (size_t)256 * 512 * 2};
    pg8::EpiS5Z E{(bf16_t*)(A.ws + WS_ZB), NCR};
    pg8::gemm_phase<pg8::EpiS5Z, pg8::S5Order, true>(F.lds, F.tid, (const char*)(A.ws + WS_A2), 512, S, E);
}
__device__ __forceinline__ void phase_glu(Frame& F, int l) {
    CArgs& A = *get_args();
    pg8::DenseOrder S; S.init(RT / 256, 1, F.G, F.bx, 0, 256, A.ws + WS_GLUT);
    pg8::EpiGlu E{(const bf16_t*)(A.ws + WS_ZB), (bf16_t*)((unsigned char*)A.out), A.in[19] + l * 256};
    pg8::gemm_phase<pg8::EpiGlu, pg8::DenseOrder, true>(F.lds, F.tid, (const char*)(A.ws + WS_ZB), 256, S, E);
}

__device__ __forceinline__ int lane_id_now() { int l; asm volatile("v_mbcnt_lo_u32_b32 %0, -1, 0\n\tv_mbcnt_hi_u32_b32 %0, -1, %0" : "=v"(l)); return l; }
__global__ void __launch_bounds__(NTHR, 2) mk_fwd(Args args) {
    extern __shared__ __attribute__((aligned(16))) unsigned char lds_raw[];
#define MKF() Frame F; { int t_ = HW_TID(); asm volatile("" : "+v"(t_)); { unsigned lb_ = (unsigned)(uintptr_t)(LAS unsigned char*)lds_raw; asm volatile("" : "+s"(lb_)); F.lds = (LAS unsigned char*)(uintptr_t)lb_; } F.tid = t_; F.lane = t_ & 63; F.wave = __builtin_amdgcn_readfirstlane(t_ >> 6); \
        int b_ = blockIdx.x; asm volatile("" : "+s"(b_)); F.bx = b_; F.G = gridDim.x; F.gw = b_ * NWAVES + F.wave; F.NGW = F.G * NWAVES; }
    const int wv_ = __builtin_amdgcn_readfirstlane((int)threadIdx.x >> 6);
#define HW_TID() (wv_ * 64 + lane_id_now())
    volatile LAS unsigned* MISC = (volatile LAS unsigned*)((LAS unsigned char*)lds_raw + LC_MISC);
    if (HW_TID() < 32) MISC[HW_TID()] = 0u;
    __syncthreads();
    XcdBarrier bar = xcd_barrier_post((unsigned*)(get_args()->ws + WS_CTL) + CW_BAR, MISC + 8, HW_TID() == 0);
#ifndef PROBE_MASK
#define PROBE_MASK 0u
#endif
    unsigned long long pt_last = 0ull, pt_acc = 0ull; int pt_i = 0;
#define PROBE_TICK() do { if (PROBE_MASK) { const unsigned long long now_ = __builtin_amdgcn_s_memrealtime(); if ((PROBE_MASK >> pt_i) & 1u) pt_acc += now_ - pt_last; pt_last = now_; ++pt_i; } } while (0)
    if (PROBE_MASK) pt_last = __builtin_amdgcn_s_memrealtime();
#define GRID_BAR() do { xcd_barrier(bar, HW_TID() == 0); PROBE_TICK(); } while (0)
    DUP(9) { MKF(); phase_tables(F); }
    DUP(8) { MKF(); phase_weights(F, 0); }
    { MKF(); for (int it = F.bx; it < 256; it += F.G) s5_build_item(F, *get_args(), 0, it >> 4, it & 15); }
    { const bool never_ = (get_args()->ws == nullptr);
      if (never_) cooperative_groups::this_grid().sync(); else GRID_BAR(); }
#pragma unroll
    for (int l = 0; l < DEPTH; ++l) {
        if (l > 0) { DUP(8) { MKF(); phase_weights(F, l); } PROBE_TICK(); }
        for (int rep_ = 0; rep_ < ((((PROBE_DUP) >> 10) & 1) && l == 0 ? 2 : 1); ++rep_) { MKF(); phase_prenorm(F, l); }
        { MKF(); router_precompute(F, l); }
        if (l > 0) { MKF(); for (int it = F.bx; it < 256; it += F.G) s5_build_item(F, *get_args(), l, it >> 4, it & 15); }
        GRID_BAR();
        DUP(0) { MKF(); phase_gemm_in(F); } GRID_BAR();
        DUP(11) { MKF(); phase_s5_local(F); } PROBE_TICK();
        DUP(4) { MKF(); phase_ret_kv(F, l); }
        GRID_BAR();
        { MKF(); for (int ch = F.bx; ch < NB * 16 * 2; ch += F.G) s5_scan_block(F, *get_args(), l, ch); PROBE_TICK();
            ret_scan(*get_args(), l, F.bx * NTHR + F.tid, F.G * NTHR); }
        GRID_BAR();
        DUP(6) { MKF(); phase_s5_out(F); } PROBE_TICK();
        DUP(5) { MKF(); phase_ret_out(F, l); }
        GRID_BAR();
        DUP(12) { MKF(); phase_glu(F, l); } PROBE_TICK();
        DUP(7) { MKF(); phase_pool(F, l); }
        GRID_BAR();
        for (int rep_ = 0; rep_ < ((((PROBE_DUP) >> 1) & 1) && l == 0 ? 2 : 1); ++rep_) { MKF(); phase_gemm_out(F, l); } GRID_BAR();
        { MKF(); phase_router(F, l); } GRID_BAR();
        DUP(2) { MKF(); phase_moe1(F, l); } GRID_BAR();
        DUP(3) { MKF(); phase_moe2(F, l); } GRID_BAR();
    }
    { MKF(); phase_final(F); }
    if (PROBE_MASK) { __syncthreads(); PROBE_TICK();
        if (get_args()->ws && __builtin_amdgcn_readfirstlane((int)blockIdx.x) == 0) { const unsigned long long t0_ = __builtin_amdgcn_s_memrealtime(); while (__builtin_amdgcn_s_memrealtime() - t0_ < 8ull * pt_acc) __builtin_amdgcn_s_sleep(8); } }
}

extern "C" void kernel_launch(void* const* d_in, const int* in_sizes, int n_in, void* d_out, int out_size, void* d_ws, size_t ws_size, hipStream_t stream) {
    static int grid = 0;
    if (grid == 0) {
        if (n_in != 30 || out_size != RL * D || ws_size < WS_END) { fprintf(stderr, "kernel_launch: unexpected shapes (n_in %d out %d ws %zu)\n", n_in, out_size, ws_size); grid = -1; return; }
        int dev = 0, cus = 0, per_cu = 0;
        (void)hipGetDevice(&dev); (void)hipDeviceGetAttribute(&cus, hipDeviceAttributeMultiprocessorCount, dev);
        (void)hipFuncSetAttribute((const void*)mk_fwd, hipFuncAttributeMaxDynamicSharedMemorySize, LDS_BYTES);
        (void)hipOccupancyMaxActiveBlocksPerMultiprocessor(&per_cu, (const void*)mk_fwd, NTHR, LDS_BYTES);
        (void)hipGetLastError();
        if (cus % 8 != 0) { fprintf(stderr, "kernel_launch: %d CUs: this kernel needs a CU count that is a multiple of 8\n", cus); grid = -1; return; }
        if (per_cu < 1) { fprintf(stderr, "kernel_launch: occupancy query says %d blocks per CU\n", per_cu); grid = -1; return; }
        grid = cus;
        fprintf(stderr, "kernel_launch: cus %d per_cu %d grid %d ws %zu\n", cus, per_cu, grid, ws_size);
    }
    if (grid < 0) return;
    (void)hipMemsetAsync((char*)d_ws + WS_CTL, 0, CTL_BYTES, stream);
    Args a{}; for (int i = 0; i < 30; ++i) a.in[i] = (const float*)d_in[i];
    a.out = (float*)d_out; a.ws = (unsigned char*)d_ws;
    void* kargs[] = {&a};
    hipError_t e = hipLaunchCooperativeKernel((const void*)mk_fwd, dim3(grid), dim3(NTHR), kargs, LDS_BYTES, stream);
    if (e != hipSuccess) fprintf(stderr, "kernel_launch: cooperative launch failed: %s (grid %d)\n", hipGetErrorString(e), grid);
}
```

```cpp
#include <hip/hip_runtime.h>
#include <hip/hip_cooperative_groups.h>
#include <cstdio>
#include <cstdint>

#define LAS __attribute__((address_space(3)))
typedef unsigned short bf16_t;
typedef short bf16x8 __attribute__((ext_vector_type(8)));
typedef float f32x4 __attribute__((ext_vector_type(4)));
typedef float f32x2 __attribute__((ext_vector_type(2)));
typedef unsigned u32x4 __attribute__((ext_vector_type(4)));
typedef unsigned u32x2 __attribute__((ext_vector_type(2)));

constexpr int D = 1024, NB = 8, SEQ = 4096, CTXL = 256, DEPTH = 2, INW = 2560;
constexpr int RC = NB * CTXL, RL = NB * SEQ, RT = RC + RL;
constexpr int NE = 16;
constexpr int OFF_U = 0, OFF_Q = 256, OFF_K = 768, OFF_V = 1280, OFF_G = 1792, OFF_P = 2304;
constexpr int MAXTILES = 288, NPOS = CTXL + SEQ;
constexpr int NWAVES = 8, NTHR = 512;
__host__ __device__ constexpr size_t z_off(int row, int col) { return ((size_t)(col >> 6) * RT + (size_t)row) * 64 + (size_t)(col & 63); }

constexpr size_t MiB = 1u << 20;
constexpr size_t WS_CTL = 0, CTL_BYTES = 1 * MiB;
constexpr size_t WS_MOD = 1 * MiB;
constexpr size_t WS_ROT = 2 * MiB;
constexpr size_t WS_TOKE = 4 * MiB;
constexpr size_t WS_TOKP = 4 * MiB + 512 * 1024;
constexpr size_t WS_TOKG = 5 * MiB;
constexpr size_t WS_LIST = 5 * MiB + 512 * 1024;
constexpr size_t WS_GLUT = 7 * MiB + 768 * 1024;
constexpr size_t WS_POOLT = 7 * MiB + 896 * 1024;
constexpr size_t WS_S5M = 8 * MiB;
constexpr size_t WS_WIN = 16 * MiB;
constexpr size_t WS_WOUT = 21 * MiB;
constexpr size_t WS_W13 = 24 * MiB;
constexpr size_t WS_W2 = 88 * MiB;
constexpr size_t WS_XB = 120 * MiB;
constexpr size_t WS_Z = 188 * MiB;
constexpr size_t WS_Y = 358 * MiB;
constexpr size_t WS_XRC = 502 * MiB;
constexpr size_t WS_YO = 510 * MiB;
constexpr size_t WS_END = 578 * MiB;
constexpr size_t WS_S5Y = WS_Y + 104 * MiB;
constexpr size_t WS_RO = WS_Y + 34 * MiB;
constexpr size_t WS_POOLED = WS_Y + 102 * MiB;
constexpr size_t WS_KV = WS_Y;
constexpr size_t WS_HLOC = WS_Y + 68 * MiB;
constexpr size_t WS_ZB = WS_Y + 68 * MiB;
constexpr size_t WS_A2 = WS_Y + 104 * MiB;
constexpr int CW_BAR = 4096, CW_GCNT = 8192;
constexpr int CW_BLD = 8320, CW_PRE = 8384;

__device__ __forceinline__ float wave_sum(float v) {
#pragma unroll
    for (int o = 1; o < 64; o <<= 1) v += __shfl_xor(v, o);
    return v;
}
typedef __bf16 bf16x2_t __attribute__((ext_vector_type(2)));
__device__ __forceinline__ unsigned pk2(float lo, float hi) { const bf16x2_t v = __builtin_convertvector((f32x2){lo, hi}, bf16x2_t); return __builtin_bit_cast(unsigned, v); }
__device__ __forceinline__ unsigned f2bf(float f) { return pk2(f, 0.f) & 0xffffu; }
__device__ __forceinline__ float bf2f(unsigned h) { return __builtin_bit_cast(float, h << 16); }
__device__ __forceinline__ float bflo(unsigned w) { return __builtin_bit_cast(float, w << 16); }
__device__ __forceinline__ float bfhi(unsigned w) { return __builtin_bit_cast(float, w & 0xffff0000u); }
__device__ __forceinline__ float sigmoidf_(float x) { return 1.0f / (1.0f + __expf(-x)); }
__device__ __forceinline__ float siluf_(float x) { return x * __builtin_amdgcn_rcpf(1.0f + __builtin_amdgcn_exp2f(-1.4426950408889634f * x)); }
__device__ __forceinline__ float gelu_tanh(float x) { const float u = 0.7978845608028654f * (x + 0.044715f * x * x * x); return 0.5f * x * (1.0f + tanhf(u)); }
#define LDS_WAIT() asm volatile("s_waitcnt lgkmcnt(0)" ::: "memory")
#define VM_WAIT() asm volatile("s_waitcnt vmcnt(0)" ::: "memory")
#define LDS_BARRIER() do { asm volatile("s_waitcnt lgkmcnt(0)" ::: "memory"); __builtin_amdgcn_s_barrier(); asm volatile("" ::: "memory"); } while (0)
__device__ __forceinline__ f32x4 zero4() { float z = 0.f; asm volatile("" : "+v"(z)); return (f32x4){z, z, z, z}; }
__device__ __forceinline__ f32x4 mfma16(bf16x8 nside, bf16x8 mside, f32x4 acc) { return __builtin_amdgcn_mfma_f32_16x16x32_bf16(nside, mside, acc, 0, 0, 0); }
__device__ __forceinline__ bf16x8 ldfrag(const LAS bf16_t* base, int ld, int k0, int lane) { return *(const LAS bf16x8*)(base + (lane & 15) * ld + k0 + 8 * (lane >> 4)); }
__device__ __forceinline__ bf16x8 gfrag(const bf16_t* base, size_t ld, int k0, int lane) { return *(const bf16x8*)(base + (size_t)(lane & 15) * ld + k0 + 8 * (lane >> 4)); }

namespace pg8 {
constexpr int BM = 256, BK = 64, HALF = 128, HTB = HALF * BK * 2, STAGE_BYTES = 8 * HTB, NXCD = 8, WGM = 4;
__host__ __device__ __forceinline__ int lds_byte(int r, int c) { const int st = (r >> 4) * 2 + (c >> 5), rr = r & 15, cc = c & 31, ob = rr * 64 + cc * 2; return st * 1024 + (ob ^ (((ob >> 9) & 1) << 5)); }
__host__ __device__ __forceinline__ void stage_rc(int b, int& R, int& C) { const int st = b / 1024, sb = b % 1024, swz = sb ^ (((sb >> 9) & 1) << 5); R = (st >> 1) * 16 + swz / 64; C = (st & 1) * 32 + (swz % 64) / 2; }
__host__ __device__ __forceinline__ int perm32(int rho) { const int n = rho >> 4, i = rho & 15; return 8 * (i >> 2) + 4 * n + (i & 3); }

struct Unit { int pm, pn, e, ui, hs; };

__device__ __forceinline__ unsigned cvt_pk_bf16(float lo, float hi) { unsigned r; asm volatile("v_cvt_pk_bf16_f32 %0, %1, %2" : "=v"(r) : "v"(lo), "v"(hi)); return r; }

struct DenseOrder {
    int nM, nN, nwg, G, c, pm0, K, nfull, rem2; const char* Bt;
    __device__ void init(int nM_, int nN_, int G_, int c_, int pm0_, int K_, const void* Bt_, bool split = false) { nM = nM_; nN = nN_; nwg = nM * nN; G = G_; c = c_; pm0 = pm0_; K = K_; Bt = (const char*)Bt_;
        const int rem = nwg % G_; if (split && rem > 0 && 2 * rem <= G_) { nfull = nwg - rem; rem2 = 2 * rem; } else { nfull = nwg; rem2 = 0; } }
    __device__ bool next(int i, Unit& u) const {
        const long L = (long)i * G + c; if (L >= (long)nfull + rem2) return false;
        int wgid = (int)L; u.hs = -1; if (L >= nfull) { const int j = (int)L - nfull; wgid = nfull + (j >> 1); u.hs = j & 1; } { const int q = nwg / NXCD, r = nwg % NXCD, xcd = wgid % NXCD, off = wgid / NXCD; wgid = (xcd < r ? xcd * (q + 1) : r * (q + 1) + (xcd - r) * q) + off; }
        const int nig = WGM * nN, gid = wgid / nig, fm = gid * WGM, gsz = (nM - fm) < WGM ? (nM - fm) : WGM;
        u.pm = pm0 + fm + ((wgid % nig) % gsz); u.pn = (wgid % nig) / gsz; u.e = 0; u.ui = i; return true;
    }
    __device__ __forceinline__ void a_offs(const Unit& u, const int (&R)[2], const int (&C)[2], unsigned (&off)[2][2]) const {
#pragma unroll
        for (int h = 0; h < 2; ++h)
#pragma unroll
            for (int i = 0; i < 2; ++i) off[h][i] = (unsigned)((u.pm * BM + h * HALF + R[i]) * K + C[i]) * 2u;
    }
    __device__ __forceinline__ const char* b_ptr(const Unit& u) const { return Bt + ((size_t)u.pn * BM + (u.hs > 0 ? HALF : 0)) * K * 2; }
    __device__ __forceinline__ size_t kstep_a() const { return (size_t)(BK * 2); }
};
struct MoeOrder {
    int ntiles, nN, G, c, K; const char* Bt; size_t bstride; const LAS int* tile_e; const LAS unsigned* rowoff;
    bool xcd_tiles;
    bool split = false;
    __device__ bool next(int i, Unit& u) const {
        long L = (long)i * G + c; const int tot = ntiles * nN, rem = tot % G, nfull = (split && rem > 0 && 2 * rem <= G) ? tot - rem : tot; u.hs = -1;
        if (L >= nfull) { const long j = L - nfull; if (nfull == tot || j >= 2 * rem) return false; L = nfull + (j >> 1); u.hs = (int)(j & 1); }
        if (xcd_tiles && (G & 7) == 0) { const int g = (int)(L >> 3), x = (int)(L & 7), oct = g / nN, gi = g % nN;
            int pn, t;
            if (nN == 8) { t = oct * 8 + 2 * (x & 3) + (gi >> 2); pn = 4 * (x >> 2) + (gi & 3); }
            else { t = oct * 8 + x; pn = gi; }
            if ((oct + 1) * 8 <= ntiles) { u.pn = pn; u.pm = t; u.e = tile_e[t]; u.ui = i; return true; } }
        u.pn = (int)(L % nN); u.pm = (int)(L / nN); u.e = tile_e[u.pm]; u.ui = i; return true;
    }
    __device__ __forceinline__ void a_offs(const Unit& u, const int (&R)[2], const int (&C)[2], unsigned (&off)[2][2]) const {
#pragma unroll
        for (int h = 0; h < 2; ++h)
#pragma unroll
            for (int i = 0; i < 2; ++i) off[h][i] = rowoff ? rowoff[u.ui * 256 + h * HALF + R[i]] + (unsigned)C[i] * 2u : (unsigned)((u.pm * BM + h * HALF + R[i]) * K + C[i]) * 2u;
    }
    __device__ __forceinline__ const char* b_ptr(const Unit& u) const { return Bt + (size_t)u.e * bstride + ((size_t)u.pn * BM + (u.hs > 0 ? HALF : 0)) * K * 2; }
    __device__ __forceinline__ size_t kstep_a() const { return (size_t)(BK * 2); }
};

struct EpiBf16 {
    static constexpr bool PERM = true;
    bf16_t* O; int ldc;
    __device__ __forceinline__ void operator()(const f32x4 (&acc)[2][2][4][2], const Unit& u, int wr, int wc, int fr, int fq) const {
        const int row0 = u.pm * BM + wr * 64 + fr, col0 = u.pn * BM + (u.hs > 0 ? HALF : 0) + wc * 32 + 8 * fq;
#pragma unroll
        for (int ai = 0; ai < 2; ++ai)
#pragma unroll
            for (int m = 0; m < 4; ++m) { bf16_t* rowp = O + (size_t)(row0 + ai * HALF + m * 16) * ldc + col0;
#pragma unroll
                for (int bj = 0; bj < 2; ++bj) if (bj == 0 || u.hs < 0) { const f32x4 v0 = acc[ai][bj][m][0], v1 = acc[ai][bj][m][1];
                    u32x4 w; w.x = cvt_pk_bf16(v0[0], v0[1]); w.y = cvt_pk_bf16(v0[2], v0[3]); w.z = cvt_pk_bf16(v1[0], v1[1]); w.w = cvt_pk_bf16(v1[2], v1[3]);
                    *(u32x4*)(rowp + bj * HALF) = w; } }
    }
};
struct EpiSwiGLU {
    static constexpr bool PERM = true;
    bf16_t* O;
    __device__ __forceinline__ void operator()(const f32x4 (&acc)[2][2][4][2], const Unit& u, int wr, int wc, int fr, int fq) const {
        const int row0 = u.pm * BM + wr * 64 + fr, col0 = u.pn * HALF + wc * 32 + 8 * fq;
#pragma unroll
        for (int ai = 0; ai < 2; ++ai)
#pragma unroll
            for (int m = 0; m < 4; ++m) { bf16_t* rowp = O + (size_t)(row0 + ai * HALF + m * 16) * 1024 + col0;
                float h[8];
#pragma unroll
                for (int n = 0; n < 2; ++n)
#pragma unroll
                    for (int j = 0; j < 4; ++j) { const float a = acc[ai][0][m][n][j], b = acc[ai][1][m][n][j]; h[n * 4 + j] = a * __builtin_amdgcn_rcpf(1.0f + __builtin_amdgcn_exp2f(-1.4426950408889634f * a)) * b; }
                u32x4 w; w.x = cvt_pk_bf16(h[0], h[1]); w.y = cvt_pk_bf16(h[2], h[3]); w.z = cvt_pk_bf16(h[4], h[5]); w.w = cvt_pk_bf16(h[6], h[7]);
                *(u32x4*)rowp = w; }
    }
};
struct EpiRes {
    static constexpr bool PERM = false;
    const float* src_c; const float* src_l; float* dst_c; float* dst_l; const float* modl;
    __device__ __forceinline__ void operator()(const f32x4 (&acc)[2][2][4][2], const Unit& u, int wr, int wc, int fr, int fq) const {
        const bool isc = u.pm < 8; const int bidx = isc ? 8 : ((u.pm - 8) >> 4);
        const float* src = isc ? src_c : src_l; float* dst = isc ? dst_c : dst_l;
        const int rl0 = (isc ? u.pm * BM : (u.pm - 8) * BM) + wr * 64 + fr, col0 = u.pn * BM + wc * 32 + 4 * fq;
        const float* gate = modl + bidx * 6144 + 2048;
        f32x4 gv[2][2];
#pragma unroll
        for (int bj = 0; bj < 2; ++bj)
#pragma unroll
            for (int n = 0; n < 2; ++n) gv[bj][n] = *(const f32x4*)(gate + col0 + bj * HALF + n * 16);
#pragma unroll
        for (int ai = 0; ai < 2; ++ai)
#pragma unroll
            for (int m = 0; m < 4; ++m) { const size_t off = (size_t)(rl0 + ai * HALF + m * 16) * 1024 + col0;
#pragma unroll
                for (int bj = 0; bj < 2; ++bj)
#pragma unroll
                    for (int n = 0; n < 2; ++n) { const f32x4 s = *(const f32x4*)(src + off + bj * HALF + n * 16); *(f32x4*)(dst + off + bj * HALF + n * 16) = s + gv[bj][n] * acc[ai][bj][m][n]; } }
    }
};

struct S5Order {
    int G, c, K; const char* Bt; size_t bstride;
    __device__ bool next(int i, Unit& u) const { const long L = (long)i * G + c; if (L >= 9 * 16) return false; u.pm = (int)(L >> 4); u.e = (int)(L & 15); u.pn = 0; u.ui = i; u.hs = -1; return true; }
    __device__ __forceinline__ void a_offs(const Unit& u, const int (&R)[2], const int (&C)[2], unsigned (&off)[2][2]) const {
#pragma unroll
        for (int h = 0; h < 2; ++h)
#pragma unroll
            for (int i = 0; i < 2; ++i) off[h][i] = (unsigned)(((u.e * 2304 + u.pm * BM + h * HALF + R[i]) * 512 + C[i])) * 2u;
    }
    __device__ __forceinline__ const char* b_ptr(const Unit& u) const { return Bt + (size_t)u.e * bstride; }
    __device__ __forceinline__ size_t kstep_a() const { return (size_t)(BK * 2); }
};
struct GluOrder {
    int nM, G, c; const char* Bt;
    __device__ bool next(int i, Unit& u) const { const long L = (long)i * G + c; if (L >= nM) return false; u.pm = (int)L; u.pn = 0; u.e = 0; u.ui = i; u.hs = -1; return true; }
    __device__ __forceinline__ void a_offs(const Unit& u, const int (&R)[2], const int (&C)[2], unsigned (&off)[2][2]) const {
#pragma unroll
        for (int h = 0; h < 2; ++h)
#pragma unroll
            for (int i = 0; i < 2; ++i) { const int row = u.pm * BM + h * HALF + R[i]; off[h][i] = (unsigned)((((C[i] >> 4) * 2304 + (row >> 4)) * 256 + (row & 15) * 16 + (C[i] & 15))) * 2u; }
    }
    __device__ __forceinline__ const char* b_ptr(const Unit&) const { return Bt; }
    __device__ __forceinline__ size_t kstep_a() const { return (size_t)4 * 2304 * 256 * 2; }
};
struct EpiIn {
    static constexpr bool PERM = true;
    bf16_t* Zb; bf16_t* A2;
    __device__ __forceinline__ void operator()(const f32x4 (&acc)[2][2][4][2], const Unit& u, int wr, int wc, int fr, int fq) const {
        const int row0 = u.pm * BM + wr * 64 + fr, colt = wc * 32 + 8 * fq;
#pragma unroll
        for (int ai = 0; ai < 2; ++ai)
#pragma unroll
            for (int m = 0; m < 4; ++m) { const int row = row0 + ai * HALF + m * 16;
#pragma unroll
                for (int bj = 0; bj < 2; ++bj) if (bj == 0 || u.hs < 0) { const f32x4 v0 = acc[ai][bj][m][0], v1 = acc[ai][bj][m][1]; const int c = colt + bj * HALF + (u.hs > 0 ? HALF : 0);
                    u32x4 w; w.x = cvt_pk_bf16(v0[0], v0[1]); w.y = cvt_pk_bf16(v0[2], v0[3]); w.z = cvt_pk_bf16(v1[0], v1[1]); w.w = cvt_pk_bf16(v1[2], v1[3]);
                    if (u.pn == 0) *(u32x4*)(A2 + ((size_t)((c >> 4) * 2304 + (row >> 4)) * 512 + (row & 15) * 16 + (c & 15))) = w;
                    else *(u32x4*)(Zb + z_off(row, u.pn * BM + c)) = w; } }
    }
};
struct EpiHloc {
    static constexpr bool PERM = true;
    bf16_t* O; int ncr;
    __device__ __forceinline__ void operator()(const f32x4 (&acc)[2][2][4][2], const Unit& u, int wr, int wc, int fr, int fq) const {
        const int row0 = u.pm * BM + wr * 64 + fr, col0 = wc * 32 + 8 * fq;
#pragma unroll
        for (int ai = 0; ai < 2; ++ai)
#pragma unroll
            for (int m = 0; m < 4; ++m) { const int cr = row0 + ai * HALF + m * 16; if (cr < ncr) { bf16_t* rowp = O + ((size_t)u.e * 2304 + cr) * 256 + col0;
#pragma unroll
                for (int bj = 0; bj < 2; ++bj) { const f32x4 v0 = acc[ai][bj][m][0], v1 = acc[ai][bj][m][1];
                    u32x4 w; w.x = cvt_pk_bf16(v0[0], v0[1]); w.y = cvt_pk_bf16(v0[2], v0[3]); w.z = cvt_pk_bf16(v1[0], v1[1]); w.w = cvt_pk_bf16(v1[2], v1[3]);
                    *(u32x4*)(rowp + bj * HALF) = w; } } }
    }
};
__device__ __forceinline__ float gelu_tanh_f(float x) { const float u = 0.7978845608028654f * (x + 0.044715f * x * x * x); const float e = __builtin_amdgcn_exp2f(2.8853900817779268f * u); return x * (1.0f - __builtin_amdgcn_rcpf(1.0f + e)); }
struct EpiS5Z {
    static constexpr bool PERM = true;
    bf16_t* O; int ncr;
    __device__ __forceinline__ void operator()(const f32x4 (&acc)[2][2][4][2], const Unit& u, int wr, int wc, int fr, int fq) const {
        const int row0 = u.pm * BM + wr * 64 + fr, colt = wc * 32 + 8 * fq;
#pragma unroll
        for (int ai = 0; ai < 2; ++ai)
#pragma unroll
            for (int m = 0; m < 4; ++m) { const int cr = row0 + ai * HALF + m * 16; if (cr < ncr) {
#pragma unroll
                for (int bj = 0; bj < 2; ++bj) { const f32x4 v0 = acc[ai][bj][m][0], v1 = acc[ai][bj][m][1]; const int c = colt + bj * HALF;
                    u32x4 w; w.x = cvt_pk_bf16(gelu_tanh_f(v0[0]), gelu_tanh_f(v0[1])); w.y = cvt_pk_bf16(gelu_tanh_f(v0[2]), gelu_tanh_f(v0[3])); w.z = cvt_pk_bf16(gelu_tanh_f(v1[0]), gelu_tanh_f(v1[1])); w.w = cvt_pk_bf16(gelu_tanh_f(v1[2]), gelu_tanh_f(v1[3]));
                    *(u32x4*)(O + ((size_t)u.e * 2304 + cr) * 256 + c) = w; } } }
    }
};
struct EpiGlu {
    static constexpr bool PERM = true;
    const bf16_t* ZB; bf16_t* MIXp; const float* bias;
    __device__ __forceinline__ void operator()(const f32x4 (&acc)[2][2][4][2], const Unit& u, int wr, int wc, int fr, int fq) const {
        const int row0 = u.pm * BM + wr * 64 + fr, colt = wc * 32 + 8 * fq;
#pragma unroll
        for (int bj = 0; bj < 2; ++bj) { const int c = colt + bj * HALF; const f32x4 b0 = *(const f32x4*)(bias + c), b1 = *(const f32x4*)(bias + c + 4);
#pragma unroll
            for (int ai = 0; ai < 2; ++ai)
#pragma unroll
                for (int m = 0; m < 4; ++m) { const size_t row = (size_t)(row0 + ai * HALF + m * 16); const u32x4 z = *(const u32x4*)(ZB + ((size_t)(c >> 4) * 2304 + (row >> 4)) * 256 + (row & 15) * 16 + (c & 15));
                    const f32x4 v0 = acc[ai][bj][m][0] + b0, v1 = acc[ai][bj][m][1] + b1;
#define SG_(x) __builtin_amdgcn_rcpf(1.0f + __builtin_amdgcn_exp2f(-1.4426950408889634f * (x)))
                    u32x4 w; w.x = cvt_pk_bf16(bflo(z.x) * SG_(v0[0]), bfhi(z.x) * SG_(v0[1])); w.y = cvt_pk_bf16(bflo(z.y) * SG_(v0[2]), bfhi(z.y) * SG_(v0[3]));
                    w.z = cvt_pk_bf16(bflo(z.z) * SG_(v1[0]), bfhi(z.z) * SG_(v1[1])); w.w = cvt_pk_bf16(bflo(z.w) * SG_(v1[2]), bfhi(z.w) * SG_(v1[3]));
#undef SG_
                    *(u32x4*)(MIXp + row * 1024 + c) = w; } }
    }
};

template <class Epi, class Sched, bool ALIGN_EPI, bool SPLIT = false>
__device__ __forceinline__ void gemm_phase(LAS unsigned char* lds, const int tid_in, const char* Abase, const int K, const Sched& S, const Epi& E) {
    int tid_ = tid_in; asm volatile("" : "+v"(tid_));
    const int tid = tid_, wid = __builtin_amdgcn_readfirstlane(tid >> 6), lane = tid & 63, wr = wid >> 2, wc = wid & 3, fr = lane & 15, fq = lane >> 4;
    const int nt = K / BK;
    int Rr[2], Cc[2]; unsigned voffB[2];
#pragma unroll
    for (int i = 0; i < 2; ++i) { int R, C; stage_rc(tid * 16 + i * 8192, R, C); Rr[i] = R; Cc[i] = C; const int Rb = Epi::PERM ? ((R & ~31) + perm32(R & 31)) : R; voffB[i] = (unsigned)(Rb * K + C) * 2u; }
    const size_t kstep = (size_t)(BK * 2), kstepA = S.kstep_a();
    const size_t hstepB = (size_t)HALF * K * 2;
    const unsigned ldsw = (unsigned)wid * 1024u;
    const int aoff = lds_byte(wr * 64 + fr, fq * 8), boff = lds_byte(wc * 32 + fr, fq * 8);
#define PG8_SA(b, h) (((b) * 2 + (h)) * HTB)
#define PG8_SB(b, h) ((4 + (b) * 2 + (h)) * HTB)
#define PG8_STAGE_B(bufoff, gbase) do { _Pragma("unroll") for (int _i = 0; _i < 2; ++_i) \
        __builtin_amdgcn_global_load_lds((const unsigned*)((const char*)(gbase) + voffB[_i]), (LAS unsigned*)(lds + (bufoff) + ldsw + _i * 8192), 16, 0, 0); } while (0)
#define PG8_STAGE_A(bufoff, offs, kb) do { _Pragma("unroll") for (int _i = 0; _i < 2; ++_i) \
        __builtin_amdgcn_global_load_lds((const unsigned*)(Abase + (kb) + (offs)[_i]), (LAS unsigned*)(lds + (bufoff) + ldsw + _i * 8192), 16, 0, 0); } while (0)
#define PG8_LDA(dst, b, h) do { _Pragma("unroll") for (int m = 0; m < 4; ++m) _Pragma("unroll") for (int k = 0; k < 2; ++k) dst[m][k] = *(const LAS bf16x8*)(lds + PG8_SA(b, h) + aoff + m * 2048 + k * 1024); } while (0)
#define PG8_LDB(dst, b, h) do { _Pragma("unroll") for (int n = 0; n < 2; ++n) _Pragma("unroll") for (int k = 0; k < 2; ++k) dst[n][k] = *(const LAS bf16x8*)(lds + PG8_SB(b, h) + boff + n * 2048 + k * 1024); } while (0)
#define PG8_MMA(ai, bj, At, Bt) do { __builtin_amdgcn_s_setprio(1); _Pragma("unroll") for (int m = 0; m < 4; ++m) _Pragma("unroll") for (int n = 0; n < 2; ++n) _Pragma("unroll") for (int k = 0; k < 2; ++k) \
        acc[ai][bj][m][n] = __builtin_amdgcn_mfma_f32_16x16x32_bf16(Bt[n][k], At[m][k], acc[ai][bj][m][n], 0, 0, 0); __builtin_amdgcn_s_setprio(0); } while (0)
#define PG8_WAIT_V(n) asm volatile("s_waitcnt vmcnt(" #n ")" ::: "memory")
#define PG8_WAIT_L(n) asm volatile("s_waitcnt lgkmcnt(" #n ")" ::: "memory")
#define PG8_BAR __builtin_amdgcn_s_barrier()
#define PG8_SCHED __builtin_amdgcn_sched_barrier(0)
    Unit cur, nxt; int ui = 0;
    if (!S.next(0, cur)) return;
    float z_ = 0.f; asm volatile("" : "+v"(z_));
    f32x4 acc[2][2][4][2];
#pragma unroll
    for (int a = 0; a < 2; ++a)
#pragma unroll
        for (int b = 0; b < 2; ++b)
#pragma unroll
            for (int m = 0; m < 4; ++m)
#pragma unroll
                for (int n = 0; n < 2; ++n) acc[a][b][m][n] = (f32x4){z_, z_, z_, z_};
    bf16x8 At[4][2], B0[2][2], B1[2][2];
    unsigned cO[2][2], nO[2][2];
    S.a_offs(cur, Rr, Cc, cO);
    const char* cB = S.b_ptr(cur); const char* nB = cB;
    PG8_STAGE_B(PG8_SB(0, 0), cB); PG8_STAGE_B(PG8_SB(0, 1), cB + hstepB); PG8_STAGE_A(PG8_SA(0, 0), cO[0], 0); PG8_STAGE_A(PG8_SA(0, 1), cO[1], 0);
    if (wr == 1) PG8_BAR;
    PG8_WAIT_V(2); PG8_BAR;
    PG8_STAGE_B(PG8_SB(1, 0), cB + kstep); PG8_STAGE_A(PG8_SA(1, 0), cO[0], kstepA); PG8_STAGE_B(PG8_SB(1, 1), cB + hstepB + kstep);
    PG8_WAIT_V(6); PG8_BAR;
    for (;;) {
        const bool has_next = S.next(ui + 1, nxt);
        const bool hf = SPLIT && cur.hs >= 0;
        if (has_next) { S.a_offs(nxt, Rr, Cc, nO); nB = S.b_ptr(nxt); }
        else { nO[0][0] = cO[0][0]; nO[0][1] = cO[0][1]; nO[1][0] = cO[1][0]; nO[1][1] = cO[1][1]; nB = cB; }
#define PG8_KLOOP(HF_) _Pragma("unroll 1")         for (int t = 0; t < nt; t += 2) { \
            const bool last = (t == nt - 2); \
            const size_t k2 = last ? (size_t)0 : (size_t)(t + 2) * kstep, k3 = k2 + kstep; \
            const size_t a1 = (size_t)(t + 1) * kstepA, a2 = last ? (size_t)0 : (size_t)(t + 2) * kstepA, a3 = a2 + kstepA; \
            unsigned o2[2][2]; \
            o2[0][0] = last ? nO[0][0] : cO[0][0]; o2[0][1] = last ? nO[0][1] : cO[0][1]; o2[1][0] = last ? nO[1][0] : cO[1][0]; o2[1][1] = last ? nO[1][1] : cO[1][1]; \
            const char* b2 = (last ? nB : cB) + k2; const char* b3 = b2 + kstep; \
            PG8_LDB(B0, 0, 0); if (!(HF_)) PG8_LDB(B1, 0, 1); PG8_SCHED; PG8_LDA(At, 0, 0); PG8_STAGE_A(PG8_SA(1, 1), cO[1], a1); \
            PG8_WAIT_V(8); PG8_WAIT_L(0); PG8_BAR; PG8_MMA(0, 0, At, B0); if (!(HF_)) PG8_MMA(0, 1, At, B1); PG8_BAR; PG8_SCHED; \
            PG8_LDA(At, 0, 1); PG8_STAGE_B(PG8_SB(0, 0), b2); PG8_STAGE_B(PG8_SB(0, 1), b2 + hstepB); PG8_STAGE_A(PG8_SA(0, 0), o2[0], a2); \
            PG8_WAIT_V(8); PG8_WAIT_L(0); PG8_BAR; PG8_MMA(1, 0, At, B0); if (!(HF_)) PG8_MMA(1, 1, At, B1); PG8_BAR; PG8_SCHED; \
            PG8_LDB(B0, 1, 0); if (!(HF_)) PG8_LDB(B1, 1, 1); PG8_SCHED; PG8_LDA(At, 1, 0); PG8_STAGE_A(PG8_SA(0, 1), o2[1], a2); \
            PG8_WAIT_V(8); PG8_WAIT_L(0); PG8_BAR; PG8_MMA(0, 0, At, B0); if (!(HF_)) PG8_MMA(0, 1, At, B1); PG8_BAR; PG8_SCHED; \
            PG8_LDA(At, 1, 1); PG8_STAGE_B(PG8_SB(1, 0), b3); PG8_STAGE_B(PG8_SB(1, 1), b3 + hstepB); PG8_STAGE_A(PG8_SA(1, 0), o2[0], a3); \
            PG8_WAIT_V(8); PG8_WAIT_L(0); PG8_BAR; PG8_MMA(1, 0, At, B0); if (!(HF_)) PG8_MMA(1, 1, At, B1); PG8_BAR; PG8_SCHED; \
        }
        if (SPLIT && hf) { PG8_KLOOP(true) } else { PG8_KLOOP(false) }
#undef PG8_KLOOP
        if constexpr (ALIGN_EPI) { if (wr == 0) PG8_BAR; }
        E(acc, cur, wr, wc, fr, fq);
        if (!has_next) break;
#pragma unroll
        for (int a = 0; a < 2; ++a)
#pragma unroll
            for (int b = 0; b < 2; ++b)
#pragma unroll
                for (int m = 0; m < 4; ++m)
#pragma unroll
                    for (int n = 0; n < 2; ++n) acc[a][b][m][n] = (f32x4){z_, z_, z_, z_};
        cur = nxt; cB = nB; cO[0][0] = nO[0][0]; cO[0][1] = nO[0][1]; cO[1][0] = nO[1][0]; cO[1][1] = nO[1][1]; ++ui;
        if constexpr (ALIGN_EPI) { if (wr == 1) PG8_BAR; }
    }
    PG8_WAIT_V(0);
    if constexpr (!ALIGN_EPI) { if (wr == 0) PG8_BAR; }
    PG8_BAR;
#undef PG8_SA
#undef PG8_SB
#undef PG8_STAGE_A
#undef PG8_STAGE_B
#undef PG8_LDA
#undef PG8_LDB
#undef PG8_MMA
#undef PG8_WAIT_V
#undef PG8_WAIT_L
#undef PG8_BAR
#undef PG8_SCHED
}
}


#define XB_TMO      128
#define XB_XCNT(j)  (256  + 64 * (j))
#define XB_XSUB(j)  (1280 + 64 * (j))
#define XB_XGEN(j)  (2304 + 64 * (j))
#define XB_TOP      3328
#define XB_TOPGEN   3392
#define XCD_BAR_WORDS 3456
#define XB_SPIN_CAP (1u << 22)
__device__ __forceinline__ unsigned xb_ld(unsigned* p)              { return __hip_atomic_load(p, __ATOMIC_RELAXED, __HIP_MEMORY_SCOPE_AGENT); }
__device__ __forceinline__ unsigned xb_add(unsigned* p, unsigned v) { return __hip_atomic_fetch_add(p, v, __ATOMIC_RELAXED, __HIP_MEMORY_SCOPE_AGENT); }
__device__ __forceinline__ unsigned xb_xcc_id() { return (unsigned)__builtin_amdgcn_s_getreg((3 << 11) | 20) & 0xFu; }
#define XB_SPIN(cond, bar) do { unsigned _sp = 0; while (cond) { __builtin_amdgcn_s_sleep(1); \
    if ((++_sp & 255u) == 0u) { if (xb_ld(&(bar)[XB_TMO])) break; if (_sp > XB_SPIN_CAP) { atomicAdd(&(bar)[XB_TMO], 1u); break; } } } } while (0)
struct XcdBarrier { unsigned* bar; unsigned x; volatile LAS unsigned* st; };
__device__ __forceinline__ XcdBarrier xcd_barrier_post(unsigned* bar, volatile LAS unsigned* st, bool leader) {
    XcdBarrier b; b.bar = bar; b.x = xb_xcc_id(); b.st = st;
    if (leader) (void)xb_add(&bar[XB_XCNT(b.x)], 1u);
    return b;
}
__device__ __forceinline__ void xcd_barrier_complete(unsigned* bar, unsigned x, unsigned& nloc, unsigned& nx) {
    const unsigned G = gridDim.x * gridDim.y * gridDim.z;
    unsigned sum, cnt, mine, sp = 0u;
    for (;;) {
        sum = 0u; cnt = 0u; mine = 0u;
#pragma unroll
        for (unsigned j = 0; j < 16; ++j) { const unsigned c = xb_ld(&bar[XB_XCNT(j)]); sum += c; cnt += (c > 0u) ? 1u : 0u; mine = (j == x) ? c : mine; }
        if (sum == G) break;
        __builtin_amdgcn_s_sleep(1);
        if ((++sp & 255u) == 0u) { if (xb_ld(&bar[XB_TMO])) break; if (sp > XB_SPIN_CAP) { atomicAdd(&bar[XB_TMO], 1u); break; } }
    }
    nloc = mine > 0u ? mine : 1u; nx = cnt > 0u ? cnt : 1u;
}
__device__ __forceinline__ void xcd_barrier(const XcdBarrier& b, bool leader) {
    asm volatile("s_waitcnt vmcnt(0)" ::: "memory");
    __syncthreads();
    if (leader) {
        unsigned* bar = b.bar;
        __builtin_amdgcn_s_waitcnt(0);
        unsigned nloc = b.st[0], nx = b.st[1];
        if (nloc == 0u) { xcd_barrier_complete(bar, b.x, nloc, nx); b.st[0] = nloc; b.st[1] = nx; }
        const unsigned old = xb_add(&bar[XB_XSUB(b.x)], 1u);
        const unsigned gen = old / nloc;
        if (old + 1u == (gen + 1u) * nloc) {
            __builtin_amdgcn_fence(__ATOMIC_RELEASE, "agent");
            asm volatile("s_waitcnt vmcnt(0)" ::: "memory");
            const unsigned og = xb_add(&bar[XB_TOP], 1u);
            const unsigned tg = og / nx;
            if (og + 1u == (tg + 1u) * nx) xb_add(&bar[XB_TOPGEN], 1u);
            else XB_SPIN(xb_ld(&bar[XB_TOPGEN]) == tg, bar);
            __builtin_amdgcn_fence(__ATOMIC_ACQUIRE, "agent");
            xb_add(&bar[XB_XGEN(b.x)], 1u);
            asm volatile("s_waitcnt vmcnt(0)" ::: "memory");
        } else {
            XB_SPIN(xb_ld(&bar[XB_XGEN(b.x)]) == gen, bar);
            __builtin_amdgcn_fence(__ATOMIC_ACQUIRE, "agent");
            asm volatile("s_waitcnt vmcnt(0)" ::: "memory");
        }
    }
    __syncthreads();
}

constexpr int RING_BYTES = 131072;
constexpr int LC_TILE_E = RING_BYTES;
constexpr int LC_TSTART = LC_TILE_E + 1280;
constexpr int LC_CNT = LC_TSTART + 128;
constexpr int LC_ROWOFF = LC_CNT + 64;
constexpr int LDS_BYTES = 163840;
constexpr int LC_MISC = LDS_BYTES - 128;
static_assert(LC_ROWOFF + 10 * 256 * 4 <= LC_MISC, "LDS map");

struct Args { const float* in[30]; float* out; unsigned char* ws; };
typedef const __attribute__((address_space(4))) Args CArgs;
__device__ __forceinline__ CArgs* get_args() { CArgs* p = (CArgs*)__builtin_amdgcn_kernarg_segment_ptr(); asm volatile("" : "+s"(p)); return p; }

struct Frame {
    LAS unsigned char* lds; int tid, lane, wave, G, gw, NGW, bx;
};

static_assert(DEPTH == 2, "the residual-stream plumbing below (x = module input in layer 0 / its pre-norm update, bf16 latent stream XB afterwards) is written for two layers");
__device__ __forceinline__ bf16_t* xb_row(CArgs& A, int row) { return (bf16_t*)(A.ws + WS_XB) + (size_t)row * D; }
__device__ __forceinline__ const float* xin_row(CArgs& A, int row) { return row < RC ? A.in[2] + (size_t)row * D : A.in[0] + (size_t)(row - RC) * D; }
__device__ __forceinline__ int row_bidx(int row) { return row < RC ? 8 : ((row - RC) >> 12); }

__device__ __forceinline__ float fexp2(float x) { return __builtin_amdgcn_exp2f(x); }
__device__ __forceinline__ float fexp(float x) { return __builtin_amdgcn_exp2f(x * 1.4426950408889634f); }
__device__ __forceinline__ float flog1p_small(float t) {
    return t < 0.03125f ? t * (1.0f + t * (-0.5f + t * (0.33333334f + t * (-0.25f + t * 0.2f)))) : __builtin_amdgcn_logf(1.0f + t) * 0.6931471805599453f;
}
__device__ __forceinline__ void sincos_d(float ang, float& s, float& c) {
    const float n = __builtin_rintf(ang * 0.15915494309189535f);
    float r = __builtin_fmaf(-n, 6.28125f, ang); r = __builtin_fmaf(-n, 1.9353071795864769e-3f, r); r = __builtin_fmaf(-n, 1.0253131677e-11f, r) ;
    const float rev = r * 0.15915494309189535f;
    s = __builtin_amdgcn_sinf(rev); c = __builtin_amdgcn_cosf(rev);
}

struct CvtItem { const float* src; bf16_t* dst; int N, Kdst; };
__device__ __forceinline__ bool cvt_decode(CArgs& A, int l, int it, CvtItem& c) {
    constexpr int I_IN = 16 * 80, I_OUT = 16 * 32, I_E = 16 * 32, I_GLU = 4 * 8, I_POOL = 8;
    constexpr int NITEMS = I_IN + I_OUT + NE * 3 * I_E + I_GLU + I_POOL;
    if (it >= NITEMS) return false;
    unsigned char* ws = A.ws; int r = it;
    if (r < I_IN) { const int kb = r / 80, nb = r % 80; c = {A.in[8] + (size_t)l * D * INW + (size_t)(64 * kb) * INW + 32 * nb, (bf16_t*)(ws + WS_WIN) + (size_t)(32 * nb) * D + 64 * kb, INW, D}; return true; } r -= I_IN;
    if (r < I_OUT) { const int kb = r / 32, nb = r % 32; c = {A.in[9] + (size_t)l * D * D + (size_t)(64 * kb) * D + 32 * nb, (bf16_t*)(ws + WS_WOUT) + (size_t)(32 * nb) * D + 64 * kb, D, D}; return true; } r -= I_OUT;
    if (r < NE * 3 * I_E) { const int e = r / (3 * I_E), q = (r % (3 * I_E)) / I_E, s = r % I_E, kb = s / 32, nb = s % 32, n0 = 32 * nb;
        const size_t wo = ((size_t)l * NE + e) * D * D + (size_t)(64 * kb) * D + n0;
        if (q == 0) c = {A.in[26] + wo, (bf16_t*)(ws + WS_W13) + (size_t)e * 2048 * D + (size_t)(256 * (n0 >> 7) + (n0 & 127)) * D + 64 * kb, D, D};
        else if (q == 1) c = {A.in[27] + wo, (bf16_t*)(ws + WS_W13) + (size_t)e * 2048 * D + (size_t)(256 * (n0 >> 7) + 128 + (n0 & 127)) * D + 64 * kb, D, D};
        else c = {A.in[28] + wo, (bf16_t*)(ws + WS_W2) + (size_t)e * D * D + (size_t)n0 * D + 64 * kb, D, D};
        return true; } r -= NE * 3 * I_E;
    if (r < I_GLU) { const int kb = r / 8, nb = r % 8; c = {A.in[18] + (size_t)l * 256 * 256 + (size_t)(64 * kb) * 256 + 32 * nb, (bf16_t*)(ws + WS_GLUT) + (size_t)(32 * nb) * 256 + 64 * kb, 256, 256}; return true; } r -= I_GLU;
    { const int g = r / 2, nb = r % 2; c = {A.in[22] + ((size_t)l * 4 + g) * 64 * 64 + 32 * nb, (bf16_t*)(ws + WS_POOLT) + g * 64 * 64 + (size_t)(32 * nb) * 64, 64, 64}; return true; }
}
__device__ __forceinline__ void cvt_load(const CvtItem& c, int lane, float (&v)[32]) {
#pragma unroll
    for (int i = 0; i < 32; ++i) v[i] = __builtin_nontemporal_load(c.src + (size_t)(2 * i + (lane >> 5)) * c.N + (lane & 31));
}
__device__ __forceinline__ void cvt_store(const CvtItem& c, int lane, const float (&v)[32], LAS float* scr) {
#pragma unroll
    for (int i = 0; i < 32; ++i) scr[(2 * i + (lane >> 5)) * 33 + (lane & 31)] = v[i];
    LDS_WAIT(); asm volatile("" ::: "memory");
    const int cc = lane & 7;
#pragma unroll
    for (int j = 0; j < 4; ++j) { const int n = (lane >> 3) + 8 * j; const LAS float* s = scr + (8 * cc) * 33 + n;
        u32x4 o; o.x = pk2(s[0 * 33], s[1 * 33]); o.y = pk2(s[2 * 33], s[3 * 33]); o.z = pk2(s[4 * 33], s[5 * 33]); o.w = pk2(s[6 * 33], s[7 * 33]);
        *(u32x4*)(c.dst + (size_t)n * c.Kdst + 8 * cc) = o; }
    LDS_WAIT(); asm volatile("" ::: "memory");
}
__device__ __forceinline__ void phase_weights(Frame& F, int l) {
    CArgs& A = *get_args();
    LAS float* scr = (LAS float*)(F.lds + F.wave * 16384);
    CvtItem ca, cb; float va[32], vb[32];
    constexpr int NIT_ = 16 * 80 + 16 * 32 + NE * 3 * 16 * 32 + 4 * 8 + 8;
    const int per = (NIT_ + F.G - 1) / F.G, base = F.bx * per, lim = (base + per < NIT_) ? base + per : NIT_;
    int it = base + F.wave;
    bool ha = it < lim && cvt_decode(A, l, it, ca); if (ha) cvt_load(ca, F.lane, va);
    while (ha) {
        const bool hb = it + NWAVES < lim && cvt_decode(A, l, it + NWAVES, cb); if (hb) cvt_load(cb, F.lane, vb);
        cvt_store(ca, F.lane, va, scr);
        if (!hb) break;
        it += 2 * NWAVES;
        ha = it < lim && cvt_decode(A, l, it, ca); if (ha) cvt_load(ca, F.lane, va);
        cvt_store(cb, F.lane, vb, scr);
    }
    __syncthreads();
}
__device__ __forceinline__ void phase_tables(Frame& F) {
    CArgs& A = *get_args();
    __syncthreads();
    LAS float* sc = (LAS float*)F.lds;
    LAS float* part = (LAS float*)(F.lds + 40960);
    float* MOD = (float*)(A.ws + WS_MOD);
    if (F.bx < 192) {
        for (int i = F.tid; i < 9 * 1024; i += NTHR) { const int r = i >> 10, k = i & 1023; const float v = r < 8 ? A.in[1][r * 1024 + k] : A.in[3][k]; sc[i] = siluf_(v); }
        __syncthreads();
        for (int it = F.bx; it < 192; it += F.G) {
            const int l = it / 96, cg = it % 96, cq = F.tid & 15, ks = F.tid >> 4;
            const float* W = A.in[4] + (size_t)l * D * 6144 + cg * 64 + cq * 4;
            f32x4 acc[9];
#pragma unroll
            for (int r = 0; r < 9; ++r) acc[r] = zero4();
#pragma unroll 1
            for (int half = 0; half < 2; ++half) { f32x4 w[16];
#pragma unroll
                for (int j = 0; j < 16; ++j) w[j] = __builtin_nontemporal_load((const f32x4*)(W + (size_t)(ks * 32 + half * 16 + j) * 6144));
#pragma unroll
                for (int j = 0; j < 16; ++j) { const int k = ks * 32 + half * 16 + j;
#pragma unroll
                    for (int r = 0; r < 9; ++r) acc[r] = acc[r] + w[j] * sc[r * 1024 + k]; } }
#pragma unroll
            for (int r = 0; r < 9; ++r) *(LAS f32x4*)(part + (ks * 9 + r) * 64 + cq * 4) = acc[r];
            __syncthreads();
            for (int idx = F.tid; idx < 576; idx += NTHR) { const int r = idx >> 6, c = idx & 63; float s = A.in[5][l * 6144 + cg * 64 + c];
#pragma unroll 8
                for (int k8 = 0; k8 < 32; ++k8) s += part[(k8 * 9 + r) * 64 + c];
                MOD[(l * 9 + r) * 6144 + cg * 64 + c] = s; }
            __syncthreads();
        }
    }
    __syncthreads();
}

struct RowComb { float g1, g2; const bf16_t* y1; const bf16_t* y2; };
__device__ __forceinline__ void load_row(const float* p, int lane, f32x4 (&v)[4]) {
#pragma unroll
    for (int j = 0; j < 4; ++j) v[j] = ((const f32x4*)p)[lane + 64 * j];
}
__device__ __forceinline__ void store_row(float* p, int lane, const f32x4 (&v)[4]) {
#pragma unroll
    for (int j = 0; j < 4; ++j) __builtin_nontemporal_store(v[j], (f32x4*)p + lane + 64 * j);
}
__device__ __forceinline__ void moe_combine(CArgs& A, int lp, int row, int lane, const LAS int* tstart, f32x4 (&v)[4]) {
    const int* TOKE = (const int*)(A.ws + WS_TOKE); const int* TOKP = (const int*)(A.ws + WS_TOKP); const float* TOKG = (const float*)(A.ws + WS_TOKG);
    const int e1 = TOKE[row * 2], e2 = TOKE[row * 2 + 1], p1 = TOKP[row * 2], p2 = TOKP[row * 2 + 1];
    const float g1 = TOKG[row * 2], g2 = TOKG[row * 2 + 1];
    const size_t s1 = (size_t)tstart[e1] * 256 + p1, s2 = (size_t)tstart[e2] * 256 + p2;
    const bf16_t* Y = (const bf16_t*)(A.ws + WS_Y);
    const float* gt = (const float*)(A.ws + WS_MOD) + (size_t)(lp * 9 + row_bidx(row)) * 6144 + 5 * 1024;
#pragma unroll
    for (int j = 0; j < 4; ++j) { const u32x2 a = ((const u32x2*)(Y + s1 * 1024))[lane + 64 * j], b = ((const u32x2*)(Y + s2 * 1024))[lane + 64 * j]; const f32x4 g = ((const f32x4*)gt)[lane + 64 * j];
        v[j].x += g.x * (g1 * bflo(a.x) + g2 * bflo(b.x)); v[j].y += g.y * (g1 * bfhi(a.x) + g2 * bfhi(b.x));
        v[j].z += g.z * (g1 * bflo(a.y) + g2 * bflo(b.y)); v[j].w += g.w * (g1 * bfhi(a.y) + g2 * bfhi(b.y)); }
}
__device__ __forceinline__ void add_mixer(CArgs& A, int l, int row, int lane, f32x4 (&v)[4]) {
    const bf16_t* y = (const bf16_t*)(A.ws + WS_YO) + (size_t)row * D;
    const float* gt = (const float*)(A.ws + WS_MOD) + (size_t)(l * 9 + row_bidx(row)) * 6144 + 2 * 1024;
#pragma unroll
    for (int j = 0; j < 4; ++j) { const u32x2 a = ((const u32x2*)y)[lane + 64 * j]; const f32x4 g = ((const f32x4*)gt)[lane + 64 * j];
        v[j].x += g.x * bflo(a.x); v[j].y += g.y * bfhi(a.x); v[j].z += g.z * bflo(a.y); v[j].w += g.w * bfhi(a.y); }
}
__device__ __forceinline__ void build_tstart(Frame& F, int lp) {
    LAS int* tstart = (LAS int*)(F.lds + LC_TSTART); LAS int* cnt = (LAS int*)(F.lds + LC_CNT);
    const unsigned* gcnt = (const unsigned*)(get_args()->ws + WS_CTL) + CW_GCNT + lp * 16;
    __syncthreads();
    if (F.tid < 64) {
        const int c = F.tid < NE ? (int)__hip_atomic_load(gcnt + F.tid, __ATOMIC_RELAXED, __HIP_MEMORY_SCOPE_AGENT) : 0, tl = (c + 255) >> 8;
        int inc = tl;
#pragma unroll
        for (int o = 1; o < NE; o <<= 1) { const int v = __shfl_up(inc, o); if (F.tid >= o) inc += v; }
        if (F.tid < NE) { cnt[F.tid] = c; tstart[F.tid] = inc - tl; }
        if (F.tid == NE - 1) tstart[NE] = inc; }
    __syncthreads();
}
__device__ __forceinline__ float row_rstd(const f32x4 (&v)[4]) {
    float ss = 0.f;
#pragma unroll
    for (int j = 0; j < 4; ++j) ss += (v[j].x * v[j].x + v[j].y * v[j].y) + (v[j].z * v[j].z + v[j].w * v[j].w);
    return 1.0f / sqrtf(wave_sum(ss) * (1.0f / D) + 1e-6f);
}
__device__ __forceinline__ void norm_mod_store(const f32x4 (&v)[4], float rstd, const float* nw, const float* sc, const float* sh, bf16_t* orow, int lane, f32x4 (*keep)[4]) {
#pragma unroll
    for (int j = 0; j < 4; ++j) { const f32x4 w = ((const f32x4*)nw)[lane + 64 * j], s = ((const f32x4*)sc)[lane + 64 * j], b = ((const f32x4*)sh)[lane + 64 * j];
        const f32x4 h = v[j] * rstd * w * (s + 1.0f) + b; if (keep) (*keep)[j] = h;
        u32x2 o; o.x = pk2(h.x, h.y); o.y = pk2(h.z, h.w); ((u32x2*)orow)[lane + 64 * j] = o; }
}
struct WideRow { u32x4 c0, c1; };
__device__ __forceinline__ void wide_load(WideRow& W, const bf16_t* row, int lane, bool nt) {
    const u32x4* p0 = (const u32x4*)(row + 8 * (lane >> 1) + 256 * (2 * (lane & 1))); const u32x4* p1 = p0 + 32;
    if (nt) { W.c0 = __builtin_nontemporal_load(p0); W.c1 = __builtin_nontemporal_load(p1); } else { W.c0 = *p0; W.c1 = *p1; }
}
__device__ __forceinline__ void wide_unpack(const WideRow& W, int lane, u32x2 (&o)[4]) {
    const bool odd = lane & 1;
    const unsigned s0 = odd ? W.c0.x : W.c0.z, s1 = odd ? W.c0.y : W.c0.w, s2 = odd ? W.c1.x : W.c1.z, s3 = odd ? W.c1.y : W.c1.w;
    const unsigned r0 = __shfl_xor(s0, 1), r1 = __shfl_xor(s1, 1), r2 = __shfl_xor(s2, 1), r3 = __shfl_xor(s3, 1);
    if (!odd) { o[0] = (u32x2){W.c0.x, W.c0.y}; o[1] = (u32x2){W.c1.x, W.c1.y}; o[2] = (u32x2){r0, r1}; o[3] = (u32x2){r2, r3}; }
    else      { o[0] = (u32x2){r0, r1}; o[1] = (u32x2){r2, r3}; o[2] = (u32x2){W.c0.z, W.c0.w}; o[3] = (u32x2){W.c1.z, W.c1.w}; }
}
__device__ __forceinline__ void wide_store(bf16_t* row, int lane, const u32x2 (&o)[4]) {
    const bool odd = lane & 1;
    const unsigned s0 = odd ? o[0].x : o[2].x, s1 = odd ? o[0].y : o[2].y, s2 = odd ? o[1].x : o[3].x, s3 = odd ? o[1].y : o[3].y;
    const unsigned r0 = __shfl_xor(s0, 1), r1 = __shfl_xor(s1, 1), r2 = __shfl_xor(s2, 1), r3 = __shfl_xor(s3, 1);
    u32x4 c0, c1;
    if (!odd) { c0 = (u32x4){o[0].x, o[0].y, r0, r1}; c1 = (u32x4){o[1].x, o[1].y, r2, r3}; }
    else      { c0 = (u32x4){r0, r1, o[2].x, o[2].y}; c1 = (u32x4){r2, r3, o[3].x, o[3].y}; }
    u32x4* p0 = (u32x4*)(row + 8 * (lane >> 1) + 256 * (2 * (lane & 1)));
    p0[0] = c0; p0[32] = c1;
}
struct RowRaw { f32x4 x[4]; WideRow xw, y, m1, m2; float g1, g2; int e1, e2, p1, p2; };
template <int MODE> __device__ __forceinline__ void row_issue1(RowRaw& R, CArgs& A, int l, int row, int lane) {
    if (MODE != 0) wide_load(R.xw, xb_row(A, row), lane, true);
    else { const float* src = xin_row(A, row);
#pragma unroll
        for (int j = 0; j < 4; ++j) R.x[j] = __builtin_nontemporal_load((const f32x4*)src + lane + 64 * j); }
    if (MODE != 0) {
        if (MODE == 2) wide_load(R.y, (const bf16_t*)(A.ws + WS_YO) + (size_t)row * D, lane, true);
        const int* TOKE = (const int*)(A.ws + WS_TOKE); const int* TOKP = (const int*)(A.ws + WS_TOKP); const float* TOKG = (const float*)(A.ws + WS_TOKG);
        R.e1 = TOKE[row * 2]; R.e2 = TOKE[row * 2 + 1]; R.p1 = TOKP[row * 2]; R.p2 = TOKP[row * 2 + 1]; R.g1 = TOKG[row * 2]; R.g2 = TOKG[row * 2 + 1];
    }
}
template <int MODE> __device__ __forceinline__ void row_issue2(RowRaw& R, CArgs& A, const LAS int* tstart, int lane) {
    if (MODE != 0) {
        const bf16_t* Y = (const bf16_t*)(A.ws + WS_Y);
        const size_t s1 = (size_t)tstart[R.e1] * 256 + R.p1, s2 = (size_t)tstart[R.e2] * 256 + R.p2;
        wide_load(R.m1, Y + s1 * 1024, lane, true); wide_load(R.m2, Y + s2 * 1024, lane, true);
    }
}
struct RowVec { f32x4 ws[4], sh[4], ga[4], gf[4]; };
template <int MODE> __device__ __forceinline__ void row_vecs(RowVec& V, CArgs& A, int l, int b, int lane) {
    const float* MOD = (const float*)(A.ws + WS_MOD);
    if (MODE != 2) { const float* m = MOD + (size_t)(l * 9 + b) * 6144; const float* nw = A.in[6] + l * D;
#pragma unroll
        for (int j = 0; j < 4; ++j) { const f32x4 w = ((const f32x4*)nw)[lane + 64 * j], s = ((const f32x4*)(m + 1024))[lane + 64 * j]; V.ws[j] = w * (s + 1.0f); V.sh[j] = ((const f32x4*)m)[lane + 64 * j]; }
    } else {
#pragma unroll
        for (int j = 0; j < 4; ++j) V.ws[j] = ((const f32x4*)A.in[29])[lane + 64 * j];
    }
    if (MODE != 0) { const int lp = MODE == 1 ? l - 1 : DEPTH - 1; const float* mp = MOD + (size_t)(lp * 9 + b) * 6144;
#pragma unroll
        for (int j = 0; j < 4; ++j) { V.ga[j] = ((const f32x4*)(mp + 2 * 1024))[lane + 64 * j]; V.gf[j] = ((const f32x4*)(mp + 5 * 1024))[lane + 64 * j]; }
    }
}
template <int MODE> __device__ __forceinline__ void row_finish(RowRaw& R, const RowVec& V, CArgs& A, int row, int lane) {
    f32x4 v[4];
    if (MODE != 0) { u32x2 xx[4]; wide_unpack(R.xw, lane, xx);
#pragma unroll
        for (int j = 0; j < 4; ++j) v[j] = (f32x4){bflo(xx[j].x), bfhi(xx[j].x), bflo(xx[j].y), bfhi(xx[j].y)}; }
    else {
#pragma unroll
        for (int j = 0; j < 4; ++j) v[j] = R.x[j]; }
    if (MODE != 0) {
        u32x2 yy[4], aa[4], bb[4]; if (MODE == 2) wide_unpack(R.y, lane, yy); wide_unpack(R.m1, lane, aa); wide_unpack(R.m2, lane, bb);
#pragma unroll
        for (int j = 0; j < 4; ++j) { const f32x4 gf = V.gf[j];
            const u32x2 a = aa[j], b = bb[j];
            v[j].x += gf.x * (R.g1 * bflo(a.x) + R.g2 * bflo(b.x)); v[j].y += gf.y * (R.g1 * bfhi(a.x) + R.g2 * bfhi(b.x));
            v[j].z += gf.z * (R.g1 * bflo(a.y) + R.g2 * bflo(b.y)); v[j].w += gf.w * (R.g1 * bfhi(a.y) + R.g2 * bfhi(b.y));
            if (MODE == 2) { const f32x4 ga = V.ga[j]; const u32x2 y = yy[j]; v[j].x += ga.x * bflo(y.x); v[j].y += ga.y * bfhi(y.x); v[j].z += ga.z * bflo(y.y); v[j].w += ga.w * bfhi(y.y); } }
        if (MODE == 1 && row >= RC) { u32x2 xo[4];
#pragma unroll
            for (int j = 0; j < 4; ++j) { xo[j].x = pk2(v[j].x, v[j].y); xo[j].y = pk2(v[j].z, v[j].w); }
            wide_store(xb_row(A, row), lane, xo); }
    }
    const float rstd = row_rstd(v);
    if (MODE == 2) {
#pragma unroll
        for (int j = 0; j < 4; ++j) v[j] = v[j] * rstd * V.ws[j];
        store_row(A.out + (size_t)(row - RC) * D, lane, v);
    } else {
        bf16_t* orow = (bf16_t*)((unsigned char*)A.out) + (size_t)row * D; u32x2 oo[4];
#pragma unroll
        for (int j = 0; j < 4; ++j) { const f32x4 h = v[j] * rstd * V.ws[j] + V.sh[j]; oo[j].x = pk2(h.x, h.y); oo[j].y = pk2(h.z, h.w); }
        wide_store(orow, lane, oo);
    }
}
template <int MODE> __device__ __forceinline__ void row_phase(Frame& F, int l) {
    CArgs& A = *get_args();
    if (MODE != 0) build_tstart(F, MODE == 1 ? l - 1 : DEPTH - 1);
    const LAS int* tstart = (const LAS int*)(F.lds + LC_TSTART);
    const int r0 = MODE == 2 ? RC : 0, per = (RT - r0 + F.NGW - 1) / F.NGW;
    const int rb = r0 + F.gw * per, re = rb + per < RT ? rb + per : RT;
    RowVec V; int bprev = -1;
    for (int row = rb; row < re; row += 2) {
        const int rowB = row + 1; const bool hasB = rowB < re;
        RowRaw Ra, Rb;
        row_issue1<MODE>(Ra, A, l, row, F.lane); if (hasB) row_issue1<MODE>(Rb, A, l, rowB, F.lane);
        row_issue2<MODE>(Ra, A, tstart, F.lane); if (hasB) row_issue2<MODE>(Rb, A, tstart, F.lane);
        { const int b = row_bidx(row); if (b != bprev) { row_vecs<MODE>(V, A, l, b, F.lane); bprev = b; } }
        row_finish<MODE>(Ra, V, A, row, F.lane);
        if (hasB) { const int b = row_bidx(rowB); if (b != bprev) { row_vecs<MODE>(V, A, l, b, F.lane); bprev = b; } row_finish<MODE>(Rb, V, A, rowB, F.lane); }
    }
}
__device__ __forceinline__ void phase_prenorm(Frame& F, int l) { if (l == 0) row_phase<0>(F, l); else row_phase<1>(F, l); }
__device__ __forceinline__ void phase_final(Frame& F) { row_phase<2>(F, DEPTH - 1); }
constexpr size_t WS_RWP = WS_S5M + 6 * MiB;
constexpr size_t WS_WP = WS_S5M + 6 * MiB + 640 * 1024;
constexpr size_t WS_CB = WS_S5M + 6 * MiB + 704 * 1024;
__device__ __forceinline__ void router_precompute(Frame& F, int l, int first, int stride) {
    CArgs& A = *get_args();
    const float* MOD = (const float*)(A.ws + WS_MOD);
    bf16_t* RWP = (bf16_t*)(A.ws + WS_RWP); float* WP = (float*)(A.ws + WS_WP); float* CB = (float*)(A.ws + WS_CB);
    for (int it = first; it < 9 * 16; it += stride) { const int b = it >> 4, e = it & 15;
        const float* m = MOD + (size_t)(l * 9 + b) * 6144;
        float s = 0.f;
        for (int k = F.tid; k < 1024; k += NTHR) { const float wp = A.in[7][l * D + k] * (1.0f + m[4 * 1024 + k]); if (e == 0) WP[b * 1024 + k] = wp;
            const float rw = A.in[24][k * 16 + e], v = wp * rw; const unsigned h = f2bf(v); const float r = v - bf2f(h);
            RWP[((size_t)(b * 2 + 0) * 16 + e) * 1024 + k] = (bf16_t)h; RWP[((size_t)(b * 2 + 1) * 16 + e) * 1024 + k] = (bf16_t)f2bf(r);
            s += m[3 * 1024 + k] * rw; }
        s = wave_sum(s);
        LAS float* red = (LAS float*)F.lds;
        __syncthreads(); if (F.lane == 0) red[F.wave] = s; __syncthreads();
        if (F.tid == 0) { float t = 0.f; for (int w = 0; w < NWAVES; ++w) t += red[w]; CB[b * 16 + e] = t; }
    }
}
__device__ __forceinline__ unsigned pk_hi(float a, float b, float& ra, float& rb) { const unsigned ha = f2bf(a), hb = f2bf(b); ra = a - bf2f(ha); rb = b - bf2f(hb); return ha | (hb << 16); }
struct RtRaw { f32x4 xa[4], xb[4]; u32x4 xw[4], yy[4]; };
__device__ __forceinline__ void rt_load(RtRaw& R, CArgs& A, int l, int T, int r, int kq, int w) {
    const int row = T * 16 + r;
    const bf16_t* yr = (const bf16_t*)(A.ws + WS_YO) + (size_t)row * D + 128 * w + 8 * kq;
    if (l == 0) { const float* xr = xin_row(A, row) + 128 * w + 8 * kq;
#pragma unroll
        for (int s = 0; s < 4; ++s) { R.xa[s] = __builtin_nontemporal_load((const f32x4*)(xr + s * 32)); R.xb[s] = __builtin_nontemporal_load((const f32x4*)(xr + s * 32 + 4)); R.yy[s] = *(const u32x4*)(yr + s * 32); }
    } else { const bf16_t* xr = xb_row(A, row) + 128 * w + 8 * kq;
#pragma unroll
        for (int s = 0; s < 4; ++s) { R.xw[s] = *(const u32x4*)(xr + s * 32); R.yy[s] = *(const u32x4*)(yr + s * 32); }
    }
}
__device__ __forceinline__ void phase_router(Frame& F, int l) {
    CArgs& A = *get_args();
    __syncthreads();
    LAS int* lcnt = (LAS int*)F.lds;
    LAS int* rec = lcnt + 64;
    LAS float* part = (LAS float*)(F.lds + 16384);
    LAS float* wsl = (LAS float*)(F.lds + 40960) + F.wave * 256;
    if (F.tid < 64) lcnt[F.tid] = 0;
    __syncthreads();
    bf16_t* FB = (bf16_t*)((unsigned char*)A.out);
    int* TOKE = (int*)(A.ws + WS_TOKE); int* TOKP = (int*)(A.ws + WS_TOKP); float* TOKG = (float*)(A.ws + WS_TOKG); int* LIST = (int*)(A.ws + WS_LIST);
    const bf16_t* RWP = (const bf16_t*)(A.ws + WS_RWP); const float* WP = (const float*)(A.ws + WS_WP); const float* CB = (const float*)(A.ws + WS_CB);
    const float* MOD = (const float*)(A.ws + WS_MOD);
    const int lane = F.lane, r = lane & 15, kq = lane >> 4, w = F.wave;
    const int t0 = (l == DEPTH - 1) ? RC / 16 : 0, nt = RT / 16 - t0;
    const int tb = t0 + (int)((long)F.bx * nt / F.G), te = t0 + (int)((long)(F.bx + 1) * nt / F.G);
    RtRaw R;
    if (tb < te) rt_load(R, A, l, tb, r, kq, w);
    int par = 0, bprev = -1; f32x4 pg0[4], pg1[4]; bf16x8 pwh[4], pwl[4]; f32x4 pcb, pbias;
    for (int T = tb; T < te; ++T, par ^= 1) {
        const int row = T * 16 + r, b = row_bidx(T * 16);
        const RtRaw C = R;
        rt_load(R, A, l, T + 1 < te ? T + 1 : T, r, kq, w);
        if (b != bprev) {
            const float* ga = MOD + (size_t)(l * 9 + b) * 6144 + 2 * 1024 + 128 * w + 8 * kq;
            const bf16_t* bh = RWP + (size_t)(b * 2 + 0) * 16 * 1024 + 128 * w, * bl = RWP + (size_t)(b * 2 + 1) * 16 * 1024 + 128 * w;
#pragma unroll
            for (int s = 0; s < 4; ++s) { pg0[s] = *(const f32x4*)(ga + s * 32); pg1[s] = *(const f32x4*)(ga + s * 32 + 4); pwh[s] = gfrag(bh, 1024, s * 32, lane); pwl[s] = gfrag(bl, 1024, s * 32, lane); }
            { const float* srcv = lane < 32 ? WP + b * 1024 + 128 * w + 4 * lane : MOD + (size_t)(l * 9 + b) * 6144 + 3 * 1024 + 128 * w + 4 * (lane - 32);
              LDS_WAIT(); *(LAS f32x4*)(wsl + 4 * lane) = *(const f32x4*)srcv; LDS_WAIT(); asm volatile("" ::: "memory"); }
            pcb = *(const f32x4*)(CB + b * 16 + 4 * kq); pbias = *(const f32x4*)(A.in[25] + 4 * kq);
            bprev = b; }
        float x[4][8]; f32x4 acc = zero4(); float ss = 0.f;
#pragma unroll
        for (int s = 0; s < 4; ++s) {
            const f32x4 g0 = pg0[s], g1 = pg1[s]; const u32x4 yy = C.yy[s];
            f32x4 xa, xb;
            if (l == 0) { xa = C.xa[s]; xb = C.xb[s]; } else { const u32x4 xw = C.xw[s]; xa = (f32x4){bflo(xw.x), bfhi(xw.x), bflo(xw.y), bfhi(xw.y)}; xb = (f32x4){bflo(xw.z), bfhi(xw.z), bflo(xw.w), bfhi(xw.w)}; }
            x[s][0] = xa.x + g0.x * bflo(yy.x); x[s][1] = xa.y + g0.y * bfhi(yy.x); x[s][2] = xa.z + g0.z * bflo(yy.y); x[s][3] = xa.w + g0.w * bfhi(yy.y);
            x[s][4] = xb.x + g1.x * bflo(yy.z); x[s][5] = xb.y + g1.y * bfhi(yy.z); x[s][6] = xb.z + g1.z * bflo(yy.w); x[s][7] = xb.w + g1.w * bfhi(yy.w);
            u32x4 h, lo;
#pragma unroll
            for (int e2 = 0; e2 < 4; ++e2) { const float a = x[s][2 * e2], bb = x[s][2 * e2 + 1]; ss += a * a + bb * bb;
                const unsigned ua = __builtin_bit_cast(unsigned, a), ub = __builtin_bit_cast(unsigned, bb);
                h[e2] = __builtin_amdgcn_perm(ub, ua, 0x07060302u);
                lo[e2] = pk2(a - __builtin_bit_cast(float, ua & 0xffff0000u), bb - __builtin_bit_cast(float, ub & 0xffff0000u)); }
            const bf16x8 xh = __builtin_bit_cast(bf16x8, h), xl = __builtin_bit_cast(bf16x8, lo);
            const bf16x8 wh = pwh[s], wl = pwl[s];
            acc = __builtin_amdgcn_mfma_f32_16x16x32_bf16(wh, xh, acc, 0, 0, 0);
            acc = __builtin_amdgcn_mfma_f32_16x16x32_bf16(wl, xh, acc, 0, 0, 0);
            acc = __builtin_amdgcn_mfma_f32_16x16x32_bf16(wh, xl, acc, 0, 0, 0);
        }
        ss += __shfl_xor(ss, 16); ss += __shfl_xor(ss, 32);
        LAS float* pp = part + ((par * 8 + w) * 64 + lane) * 5;
        pp[0] = acc[0]; pp[1] = acc[1]; pp[2] = acc[2]; pp[3] = acc[3]; pp[4] = ss;
        LDS_BARRIER();
        f32x4 lgs = zero4(); float sst = 0.f;
#pragma unroll
        for (int ww = 0; ww < 8; ++ww) { const LAS float* qq = part + ((par * 8 + ww) * 64 + lane) * 5; lgs[0] += qq[0]; lgs[1] += qq[1]; lgs[2] += qq[2]; lgs[3] += qq[3]; sst += qq[4]; }
        const float rstd = 1.0f / sqrtf(sst * (1.0f / D) + 1e-6f);
        if (w == 0) {
            const f32x4 cb = pcb, bias = pbias;
            float lg[4], pr[4], sel[4];
#pragma unroll
            for (int j = 0; j < 4; ++j) lg[j] = rstd * lgs[j] + cb[j];
            float mx = fmaxf(fmaxf(lg[0], lg[1]), fmaxf(lg[2], lg[3])); mx = fmaxf(mx, __shfl_xor(mx, 16)); mx = fmaxf(mx, __shfl_xor(mx, 32));
            float ps = 0.f;
#pragma unroll
            for (int j = 0; j < 4; ++j) { pr[j] = __expf(lg[j] - mx); ps += pr[j]; }
            ps += __shfl_xor(ps, 16); ps += __shfl_xor(ps, 32);
            const float ips = 1.0f / ps;
            float f1 = -INFINITY, f2 = -INFINITY;
#pragma unroll
            for (int j = 0; j < 4; ++j) { pr[j] *= ips; sel[j] = pr[j] + bias[j]; const float xx = sel[j]; if (xx > f1) { f2 = f1; f1 = xx; } else if (xx > f2) f2 = xx; }
            const float gs = f1 + f2;
            int bg = 0; float bs = __shfl(gs, r);
#pragma unroll
            for (int g = 1; g < 4; ++g) { const float o = __shfl(gs, r + 16 * g); if (o > bs) { bs = o; bg = g; } }
            if (kq == bg) {
                int i1 = 0; float b1 = sel[0], q1 = pr[0];
#pragma unroll
                for (int j = 1; j < 4; ++j) if (sel[j] > b1) { b1 = sel[j]; i1 = j; q1 = pr[j]; }
                int i2 = -1; float b2 = -INFINITY, q2 = 0.f;
#pragma unroll
                for (int j = 0; j < 4; ++j) if (j != i1 && sel[j] > b2) { b2 = sel[j]; i2 = j; q2 = pr[j]; }
                const int e1 = bg * 4 + i1, e2 = bg * 4 + i2; const float gsum = q1 + q2;
                const int lp1 = atomicAdd((int*)(lcnt + e1), 1), lp2 = atomicAdd((int*)(lcnt + e2), 1), ri = atomicAdd((int*)(lcnt + 32), 1);
                LAS int* r5 = rec + ri * 5; r5[0] = row; r5[1] = e1; r5[2] = lp1; r5[3] = e2; r5[4] = lp2;
                TOKG[row * 2] = q1 / gsum; TOKG[row * 2 + 1] = q2 / gsum;
            }
        }
        const LAS float* wp = wsl + 8 * kq; const LAS float* sh = wsl + 128 + 8 * kq;
        bf16_t* fo = FB + (size_t)row * D + 128 * w + 8 * kq;
#pragma unroll
        for (int s = 0; s < 4; ++s) {
            const f32x4 w0 = *(const LAS f32x4*)(wp + s * 32), w1 = *(const LAS f32x4*)(wp + s * 32 + 4), s0 = *(const LAS f32x4*)(sh + s * 32), s1 = *(const LAS f32x4*)(sh + s * 32 + 4);
            u32x4 o; o.x = pk2(x[s][0] * rstd * w0.x + s0.x, x[s][1] * rstd * w0.y + s0.y); o.y = pk2(x[s][2] * rstd * w0.z + s0.z, x[s][3] * rstd * w0.w + s0.w);
            o.z = pk2(x[s][4] * rstd * w1.x + s1.x, x[s][5] * rstd * w1.y + s1.y); o.w = pk2(x[s][6] * rstd * w1.z + s1.z, x[s][7] * rstd * w1.w + s1.w);
            *(u32x4*)(fo + s * 32) = o;
            if (l == 0) { u32x4 xo; xo.x = pk2(x[s][0], x[s][1]); xo.y = pk2(x[s][2], x[s][3]); xo.z = pk2(x[s][4], x[s][5]); xo.w = pk2(x[s][6], x[s][7]);
                *(u32x4*)(xb_row(A, row) + 128 * w + 8 * kq + s * 32) = xo; }
        }
    }
    __syncthreads();
    unsigned* gcnt = (unsigned*)(A.ws + WS_CTL) + CW_GCNT + l * 16;
    if (F.tid < 16) lcnt[16 + F.tid] = (int)__hip_atomic_fetch_add(gcnt + F.tid, (unsigned)lcnt[F.tid], __ATOMIC_RELAXED, __HIP_MEMORY_SCOPE_AGENT);
    __syncthreads();
    const int nrec = lcnt[32];
    for (int i = F.tid; i < nrec; i += NTHR) { const LAS int* r5 = rec + i * 5; const int row = r5[0], e1 = r5[1], e2 = r5[3], p1 = lcnt[16 + e1] + r5[2], p2 = lcnt[16 + e2] + r5[4];
        TOKE[row * 2] = e1; TOKE[row * 2 + 1] = e2; TOKP[row * 2] = p1; TOKP[row * 2 + 1] = p2; LIST[(size_t)e1 * RT + p1] = row; LIST[(size_t)e2 * RT + p2] = row; }
    __syncthreads();
}

__device__ __forceinline__ void phase_gemm_in(Frame& F) {
    CArgs& A = *get_args();
    pg8::DenseOrder S; S.init(RT / 256, INW / 256, F.G, F.bx, 0, D, A.ws + WS_WIN, true);
    pg8::EpiIn E{(bf16_t*)(A.ws + WS_Z), (bf16_t*)(A.ws + WS_A2)};
    pg8::gemm_phase<pg8::EpiIn, pg8::DenseOrder, true, true>(F.lds, F.tid, (const char*)((unsigned char*)A.out), D, S, E);
}
__device__ __forceinline__ bool tail_idle(int entries, int G, int c) { const int r = entries % G; return r != 0 && c >= r; }
__device__ __forceinline__ int queue_take(Frame& F, int word) {
    LAS int* slot = (LAS int*)(F.lds + 64);
    __syncthreads();
    if (F.tid == 0) *slot = (int)__hip_atomic_fetch_add((unsigned*)(get_args()->ws + WS_CTL) + word, 1u, __ATOMIC_RELAXED, __HIP_MEMORY_SCOPE_AGENT);
    __syncthreads();
    const int v = *slot;
    __syncthreads();
    return v;
}
__device__ __forceinline__ int queue_done(int word) { const unsigned v = __hip_atomic_load((const unsigned*)(get_args()->ws + WS_CTL) + word, __ATOMIC_RELAXED, __HIP_MEMORY_SCOPE_AGENT); return (int)(v > 65536u ? 65536u : v); }
__device__ __forceinline__ void router_precompute(Frame& F, int l, int first, int stride);
__device__ __forceinline__ void s5_build_item(Frame& F, CArgs& A, int l, int g, int sub);
__device__ __forceinline__ void tail_builder(Frame& F, int lnext) { const int it = queue_take(F, CW_BLD); if (it < 256) s5_build_item(F, *get_args(), lnext, it >> 4, it & 15); }
__device__ __forceinline__ void tail_precompute(Frame& F, int lnext) {
    for (int k = 0; k < 3; ++k) { const int it = queue_take(F, CW_PRE); if (it >= 9 * 16) break; router_precompute(F, lnext, it, 1 << 20); } }
__device__ __forceinline__ bool phase_gemm_out(Frame& F, int l) {
    CArgs& A = *get_args();
    const bool lastl = (l == DEPTH - 1);
    pg8::DenseOrder S; S.init(lastl ? RL / 256 : RT / 256, D / 256, F.G, F.bx, lastl ? 8 : 0, D, A.ws + WS_WOUT, true);
    pg8::EpiBf16 E{(bf16_t*)(A.ws + WS_YO), D};
    pg8::gemm_phase<pg8::EpiBf16, pg8::DenseOrder, true, true>(F.lds, F.tid, (const char*)((unsigned char*)A.out), D, S, E);
    return tail_idle(S.nfull + S.rem2, F.G, F.bx);
}
__device__ __forceinline__ int build_moe_tables(Frame& F, int l, int nN, bool gather) {
    CArgs& A = *get_args();
    build_tstart(F, l);
    const LAS int* tstart = (const LAS int*)(F.lds + LC_TSTART); const LAS int* cnt = (const LAS int*)(F.lds + LC_CNT);
    LAS int* tile_e = (LAS int*)(F.lds + LC_TILE_E); LAS unsigned* rowoff = (LAS unsigned*)(F.lds + LC_ROWOFF);
    const int ntiles = tstart[NE];
    for (int t = F.tid; t < ntiles; t += NTHR) { int e = 0;
#pragma unroll
        for (int q = 1; q < NE; ++q) if (t >= tstart[q]) e = q;
        tile_e[t] = e; }
    __syncthreads();
    if (gather) {
        const int* LIST = (const int*)(A.ws + WS_LIST);
        const pg8::MoeOrder So{ntiles, nN, F.G, F.bx, D, nullptr, 0, (const LAS int*)tile_e, nullptr, true};
#pragma unroll
        for (int k = 0; k < 5; ++k) { const int idx = F.tid + k * NTHR, i = idx >> 8, r = idx & 255; pg8::Unit u;
            if (So.next(i, u)) { const int tile = u.pm, e = tile_e[tile], lt = tile - tstart[e], j = lt * 256 + r; const int tok = j < cnt[e] ? LIST[(size_t)e * RT + j] : 0; rowoff[idx] = (unsigned)tok * (unsigned)(D * 2); } }
        __syncthreads();
    }
    return ntiles;
}
__device__ __forceinline__ bool phase_moe1(Frame& F, int l) {
    CArgs& A = *get_args();
    const int ntiles = build_moe_tables(F, l, 8, true);
    pg8::MoeOrder S{ntiles, 8, F.G, F.bx, D, (const char*)(A.ws + WS_W13), (size_t)2048 * D * 2, (const LAS int*)(F.lds + LC_TILE_E), (const LAS unsigned*)(F.lds + LC_ROWOFF), true};
    pg8::EpiSwiGLU E{(bf16_t*)(A.ws + WS_Z)};
    pg8::gemm_phase<pg8::EpiSwiGLU, pg8::MoeOrder, true>(F.lds, F.tid, (const char*)((unsigned char*)A.out), D, S, E);
    return tail_idle(ntiles * 8, F.G, F.bx);
}
__device__ __forceinline__ bool phase_moe2(Frame& F, int l) {
    CArgs& A = *get_args();
    const int ntiles = build_moe_tables(F, l, 4, false);
    pg8::MoeOrder S{ntiles, 4, F.G, F.bx, D, (const char*)(A.ws + WS_W2), (size_t)D * D * 2, (const LAS int*)(F.lds + LC_TILE_E), nullptr, true, true};
    pg8::EpiBf16 E{(bf16_t*)(A.ws + WS_Y), D};
    pg8::gemm_phase<pg8::EpiBf16, pg8::MoeOrder, true, true>(F.lds, F.tid, (const char*)(A.ws + WS_Z), D, S, E);
    const int tot = ntiles * 4, rem = tot % F.G;
    return tail_idle((rem > 0 && 2 * rem <= F.G) ? tot + rem : tot, F.G, F.bx);
}

#ifndef PROBE_DUP
#define PROBE_DUP 0
#endif
#define DUP(bit) _Pragma("unroll") for (int rep_ = 0; rep_ < (((PROBE_DUP) >> (bit)) & 1) + 1; ++rep_)
constexpr size_t WS_S5W1 = WS_S5M;
constexpr size_t WS_S5W2 = WS_S5M + 2 * MiB;
constexpr int S5T = 16, NCR = RT / S5T;
constexpr int NCH = 34;

__device__ __forceinline__ float log2_gamma(CArgs& A, int l, int dir, int hd) { const float dl = A.in[20][(l * 2 + dir) * 8 + hd]; return (fminf(dl, 0.f) - flog1p_small(fexp(-fabsf(dl)))) * 1.4426950408889634f; }
__device__ __forceinline__ int ret_row0(int b, int c) { return c < 2 ? b * CTXL + 128 * c : RC + b * SEQ + 128 * (c - 2); }
__device__ __forceinline__ int ret_pos0(int c) { return c < 2 ? 128 * c : CTXL + 128 * (c - 2); }
__device__ __forceinline__ void unpack8(u32x4 w, float (&f)[8]) { f[0] = bflo(w.x); f[1] = bfhi(w.x); f[2] = bflo(w.y); f[3] = bfhi(w.y); f[4] = bflo(w.z); f[5] = bfhi(w.z); f[6] = bflo(w.w); f[7] = bfhi(w.w); }

__device__ __forceinline__ void pool_decode(int it, int nlat, int& rowbase, int& j0, int& n) {
    if (it < nlat) { rowbase = RC + it * 64; j0 = 0; n = 64; } else { const int q = it - nlat; rowbase = (q >> 2) * CTXL; j0 = (q & 3) * 64; n = CTXL; }
}
__device__ __forceinline__ void pool_load(u32x4 (&v)[5], const bf16_t* Z, int tid, int rowbase, int j0, int n) {
#pragma unroll
    for (int k = 0; k < 5; ++k) { const int idx = tid + k * NTHR, r = idx >> 5, ch = idx & 31, jj = j0 - 8 + r;
        v[k] = (u32x4){0u, 0u, 0u, 0u}; if (jj >= 0 && jj < n) v[k] = *(const u32x4*)(Z + z_off(rowbase + jj, OFF_P + ch * 8)); }
}
__device__ __forceinline__ void phase_pool(Frame& F, int l) {
    CArgs& A = *get_args();
    LAS bf16_t* Ps = (LAS bf16_t*)F.lds;
    LAS bf16_t* Pl = (LAS bf16_t*)(F.lds + 40960);
    const bf16_t* Z = (const bf16_t*)(A.ws + WS_Z); const bf16_t* PT = (const bf16_t*)(A.ws + WS_POOLT); bf16_t* MIX = (bf16_t*)((unsigned char*)A.out);
    const int nlat = RL / 64, nctx = (l == DEPTH - 1) ? 0 : NB * 4, nit = nlat + nctx;
    const int mt = F.wave & 3, lane = F.lane;
    int it = F.G - 1 - F.bx;
    if (it >= nit) { __syncthreads(); return; }
    bf16x8 pw[2][4][2]; f32x4 psc[2][4];
#pragma unroll
    for (int gi = 0; gi < 2; ++gi) { const int g = (F.wave >> 2) * 2 + gi;
#pragma unroll
        for (int nt = 0; nt < 4; ++nt) { const int r = lane & 15, row = 32 * (nt >> 1) + 8 * (r >> 2) + 4 * (nt & 1) + (r & 3);
            pw[gi][nt][0] = *(const bf16x8*)(PT + g * 4096 + row * 64 + 8 * (lane >> 4)); pw[gi][nt][1] = *(const bf16x8*)(PT + g * 4096 + row * 64 + 32 + 8 * (lane >> 4));
            psc[gi][nt] = *(const f32x4*)(A.in[23] + l * 256 + g * 64 + 32 * (nt >> 1) + 8 * (lane >> 4) + 4 * (nt & 1)); } }
    u32x4 raw[5];
    { int rb_, j0_, n_; pool_decode(it, nlat, rb_, j0_, n_); pool_load(raw, Z, F.tid, rb_, j0_, n_); }
    for (; it < nit; it += F.G) {
        int rowbase, j0, n; pool_decode(it, nlat, rowbase, j0, n);
        LDS_BARRIER();
#pragma unroll
        for (int k = 0; k < 5; ++k) { const int idx = F.tid + k * NTHR; *(LAS u32x4*)(Ps + (idx >> 5) * 256 + (idx & 31) * 8) = raw[k]; }
        { const int itn = it + F.G < nit ? it + F.G : it; int rb_, j0_, n_; pool_decode(itn, nlat, rb_, j0_, n_); pool_load(raw, Z, F.tid, rb_, j0_, n_); }
        LDS_BARRIER();
        {
            const int ch = F.tid & 31, tr = F.tid >> 5, g = ch >> 3, win = 2 << g, hw = win >> 1;
            const LAS bf16_t* col = Ps + ch * 8;
            float s[8];
#pragma unroll
            for (int e = 0; e < 8; ++e) s[e] = 0.f;
            const int t0 = tr * 4;
            for (int qq = t0 - hw; qq < t0 - hw + win; ++qq) { float f[8]; unpack8(*(const LAS u32x4*)(col + (qq + 8) * 256), f);
#pragma unroll
                for (int e = 0; e < 8; ++e) s[e] += f[e]; }
#pragma unroll
            for (int tt = 0; tt < 4; ++tt) { const int t = t0 + tt, j = j0 + t;
                int lo = j - hw; if (lo < 0) lo = 0; int hi = j - hw + win - 1; if (hi > n - 1) hi = n - 1;
                const float inv = 1.0f / (float)(hi - lo + 1);
                float f0[8]; unpack8(*(const LAS u32x4*)(col + (t + 8) * 256), f0);
                u32x4 o; o.x = pk2(s[0] * inv - f0[0], s[1] * inv - f0[1]); o.y = pk2(s[2] * inv - f0[2], s[3] * inv - f0[3]); o.z = pk2(s[4] * inv - f0[4], s[5] * inv - f0[5]); o.w = pk2(s[6] * inv - f0[6], s[7] * inv - f0[7]);
                *(LAS u32x4*)(Pl + t * 264 + ch * 8) = o;
                if (tt < 3) { float fa[8], fb[8]; unpack8(*(const LAS u32x4*)(col + (t - hw + win + 8) * 256), fa); unpack8(*(const LAS u32x4*)(col + (t - hw + 8) * 256), fb);
#pragma unroll
                    for (int e = 0; e < 8; ++e) s[e] += fa[e] - fb[e]; } } }
        LDS_BARRIER();
#pragma unroll
        for (int gi = 0; gi < 2; ++gi) { const int g = (F.wave >> 2) * 2 + gi;
            const bf16x8 a0 = ldfrag(Pl + mt * 16 * 264 + g * 64, 264, 0, lane), a1 = ldfrag(Pl + mt * 16 * 264 + g * 64, 264, 32, lane);
#pragma unroll
            for (int p = 0; p < 2; ++p) { f32x4 c0 = zero4(), c1 = zero4();
                c0 = mfma16(pw[gi][2 * p][0], a0, c0); c0 = mfma16(pw[gi][2 * p][1], a1, c0); c1 = mfma16(pw[gi][2 * p + 1][0], a0, c1); c1 = mfma16(pw[gi][2 * p + 1][1], a1, c1);
                const f32x4 s0 = psc[gi][2 * p], s1 = psc[gi][2 * p + 1];
                u32x4 o; o.x = pk2(c0[0] * s0.x, c0[1] * s0.y); o.y = pk2(c0[2] * s0.z, c0[3] * s0.w); o.z = pk2(c1[0] * s1.x, c1[1] * s1.y); o.w = pk2(c1[2] * s1.z, c1[3] * s1.w);
                *(u32x4*)(MIX + (size_t)(rowbase + j0 + mt * 16 + (lane & 15)) * D + 768 + g * 64 + 32 * p + 8 * (lane >> 4)) = o; } }
    }
    __syncthreads();
}

__device__ __forceinline__ void rot16(const bf16_t* src, const f32x2* ROT, int pos, int q, float scale, float (&lo)[8], float (&hi)[8]) {
    float a[8], b[8]; unpack8(*(const u32x4*)(src + 8 * q), a); unpack8(*(const u32x4*)(src + 32 + 8 * q), b);
    const f32x4* cs = (const f32x4*)(ROT + (size_t)pos * 32) + q;
#pragma unroll
    for (int e2 = 0; e2 < 4; ++e2) { const f32x4 w = cs[e2 * 4];
        lo[2 * e2] = (a[2 * e2] * w.x - b[2 * e2] * w.y) * scale; hi[2 * e2] = (a[2 * e2] * w.y + b[2 * e2] * w.x) * scale;
        lo[2 * e2 + 1] = (a[2 * e2 + 1] * w.z - b[2 * e2 + 1] * w.w) * scale; hi[2 * e2 + 1] = (a[2 * e2 + 1] * w.w + b[2 * e2 + 1] * w.z) * scale; }
}
struct RetSeq { int bx, G, ns, cnt;
    __device__ __forceinline__ void init(int bx_, int G_, int nit, int ns_) { bx = bx_; G = G_;
        if (G_ != 256 || ns_ * 256 > nit) { ns = 1 << 20; cnt = bx_ < nit ? (nit - bx_ + G_ - 1) / G_ : 0; }
        else { ns = ns_; const int rem = nit - 256 * ns_ - (bx_ - 144); cnt = bx_ < 144 ? ns_ : ns_ + (rem > 0 ? (rem + 111) / 112 : 0); } }
    __device__ __forceinline__ int item(int k) const { return k < ns ? bx + G * k : 256 * ns + (bx - 144) + 112 * (k - ns); }
    __device__ __forceinline__ int item_cl(int k) const { return item(k < cnt ? k : cnt - 1); }
};
__device__ __forceinline__ void rot_factors(int pos, int q, f32x4 (&cs)[4]) {
    const float p = (float)pos;
#pragma unroll
    for (int e = 0; e < 4; ++e) { float s0, c0, s1, c1;
        sincos_d(p * fexp2(-(float)(8 * q + 2 * e) * (13.287712379549449f / 32.0f)), s0, c0);
        sincos_d(p * fexp2(-(float)(8 * q + 2 * e + 1) * (13.287712379549449f / 32.0f)), s1, c1);
        cs[e] = (f32x4){c0, s0, c1, s1}; }
}
struct RotCS { f32x2 c[4], s[4]; };
__device__ __forceinline__ void rot_invf(int q, f32x2 (&invf)[4]) {
#pragma unroll
    for (int e = 0; e < 4; ++e) invf[e] = (f32x2){fexp2(-(float)(8 * q + 2 * e) * (13.287712379549449f / 32.0f)), fexp2(-(float)(8 * q + 2 * e + 1) * (13.287712379549449f / 32.0f))};
}
__device__ __forceinline__ void rot_fwd(int pos, const f32x2 (&invf)[4], RotCS& R) {
    const float p = (float)pos;
#pragma unroll
    for (int e = 0; e < 4; ++e) { float s0, c0, s1, c1; sincos_d(p * invf[e].x, s0, c0); sincos_d(p * invf[e].y, s1, c1); R.c[e] = (f32x2){c0, c1}; R.s[e] = (f32x2){s0, s1}; }
}
__device__ __forceinline__ void rot_bwd(const RotCS& Fw, const RotCS& Sm, RotCS& B) {
#pragma unroll
    for (int e = 0; e < 4; ++e) { B.c[e] = Sm.c[e] * Fw.c[e] + Sm.s[e] * Fw.s[e]; B.s[e] = Sm.s[e] * Fw.c[e] - Sm.c[e] * Fw.s[e]; }
}
__device__ __forceinline__ void rot_pk2(const f32x2 (&a)[4], const f32x2 (&b)[4], const RotCS& R, float scale, u32x4& lo, u32x4& hi) {
#pragma unroll
    for (int e = 0; e < 4; ++e) { const f32x2 l = (a[e] * R.c[e] - b[e] * R.s[e]) * scale, h = (a[e] * R.s[e] + b[e] * R.c[e]) * scale; lo[e] = pk2(l.x, l.y); hi[e] = pk2(h.x, h.y); }
}
__device__ __forceinline__ void unpack_pairs(const u32x4 w, f32x2 (&v)[4]) {
#pragma unroll
    for (int e = 0; e < 4; ++e) v[e] = (f32x2){bflo(w[e]), bfhi(w[e])};
}
__device__ __forceinline__ bf16x8 ldfrag_sw(const LAS bf16_t* base, int ld, int k0, int key, int lane) { return *(const LAS bf16x8*)(base + (lane & 15) * ld + ((k0 + 8 * (lane >> 4)) ^ (key << 4))); }
struct KvRaw { u32x4 k0, k1, v0, v1; };
__device__ __forceinline__ void kv_load(KvRaw& R, CArgs& A, int it, int iA, int qA) {
    const int hd = it & 7, bc = it >> 3, c = bc % NCH, b = bc / NCH;
    const bf16_t* Z = (const bf16_t*)(A.ws + WS_Z);
    const int zrow = ret_row0(b, c) + iA; const bf16_t* zk = Z + z_off(zrow, OFF_K + hd * 64); const bf16_t* zv = Z + z_off(zrow, OFF_V + hd * 64);
    R.k0 = *(const u32x4*)(zk + 8 * qA); R.k1 = *(const u32x4*)(zk + 32 + 8 * qA);
    R.v0 = *(const u32x4*)(zv + 16 * qA); R.v1 = *(const u32x4*)(zv + 16 * qA + 8);
}
__device__ __forceinline__ void rot8(const u32x4 a8, const u32x4 b8, const f32x4 (&cs)[4], float scale, float (&l)[8], float (&h)[8]) {
    float a[8], b[8]; unpack8(a8, a); unpack8(b8, b);
#pragma unroll
    for (int e2 = 0; e2 < 4; ++e2) { const f32x4 w = cs[e2];
        l[2 * e2] = (a[2 * e2] * w.x - b[2 * e2] * w.y) * scale; h[2 * e2] = (a[2 * e2] * w.y + b[2 * e2] * w.x) * scale;
        l[2 * e2 + 1] = (a[2 * e2 + 1] * w.z - b[2 * e2 + 1] * w.w) * scale; h[2 * e2 + 1] = (a[2 * e2 + 1] * w.w + b[2 * e2 + 1] * w.z) * scale; }
}
__device__ __forceinline__ void phase_ret_kv(Frame& F, int l) {
    CArgs& A = *get_args();
    bf16_t* KV = (bf16_t*)(A.ws + WS_KV);
    LAS bf16_t* Kt = (LAS bf16_t*)F.lds;
    LAS bf16_t* Vt = (LAS bf16_t*)(F.lds + 2 * 64 * 136 * 2);
    const int iA = F.tid >> 2, qA = F.tid & 3, lane = F.lane, nit = NB * NCH * 8;
    const int hd = F.bx & 7;
    const float lgf = log2_gamma(A, l, 0, hd), lgb = log2_gamma(A, l, 1, hd);
    const float wf = fexp2((float)(127 - iA) * lgf), wb = fexp2((float)iA * lgb);
    const int ik = iA ^ (qA << 4);
    f32x2 invf[4]; RotCS SL; rot_invf(qA, invf); rot_fwd(CTXL + SEQ + CTXL - 1, invf, SL);
    KvRaw R;
    RetSeq Q; Q.init(F.bx, F.G, nit, 8);
    if (Q.cnt > 0) kv_load(R, A, Q.item(0), iA, qA);
    for (int k = 0; k < Q.cnt; ++k) { const int it = Q.item(k);
        const int bc = it >> 3, c = bc % NCH, b = bc / NCH;
        const KvRaw C = R;
        if (k + 1 < Q.cnt) kv_load(R, A, Q.item(k + 1), iA, qA);
        LDS_BARRIER();
        { RotCS Rf, Rb; f32x2 ka[4], kb[4], va[4], vb[4];
            unpack_pairs(C.k0, ka); unpack_pairs(C.k1, kb); unpack_pairs(C.v0, va); unpack_pairs(C.v1, vb);
            rot_fwd(ret_pos0(c) + iA, invf, Rf);
            if (c < 2) { RotCS Sc; rot_fwd(CTXL - 1, invf, Sc); rot_bwd(Rf, Sc, Rb); } else rot_bwd(Rf, SL, Rb);
#pragma unroll
            for (int e = 0; e < 4; ++e) {
                const f32x2 lf = (ka[e] * Rf.c[e] - kb[e] * Rf.s[e]) * 0.125f, hf = (ka[e] * Rf.s[e] + kb[e] * Rf.c[e]) * 0.125f, lb = (ka[e] * Rb.c[e] - kb[e] * Rb.s[e]) * 0.125f, hb = (ka[e] * Rb.s[e] + kb[e] * Rb.c[e]) * 0.125f;
                const unsigned w0 = pk2(lf.x, lf.y), w1 = pk2(hf.x, hf.y), w2 = pk2(lb.x, lb.y), w3 = pk2(hb.x, hb.y);
                Kt[(8 * qA + 2 * e) * 136 + ik] = (bf16_t)(w0 & 0xffffu); Kt[(8 * qA + 2 * e + 1) * 136 + ik] = (bf16_t)(w0 >> 16);
                Kt[(32 + 8 * qA + 2 * e) * 136 + ik] = (bf16_t)(w1 & 0xffffu); Kt[(32 + 8 * qA + 2 * e + 1) * 136 + ik] = (bf16_t)(w1 >> 16);
                Kt[(64 + 8 * qA + 2 * e) * 136 + ik] = (bf16_t)(w2 & 0xffffu); Kt[(64 + 8 * qA + 2 * e + 1) * 136 + ik] = (bf16_t)(w2 >> 16);
                Kt[(96 + 8 * qA + 2 * e) * 136 + ik] = (bf16_t)(w3 & 0xffffu); Kt[(96 + 8 * qA + 2 * e + 1) * 136 + ik] = (bf16_t)(w3 >> 16);
                const f32x2 a0 = va[e] * wf, a1 = vb[e] * wf, b0 = va[e] * wb, b1 = vb[e] * wb;
                const unsigned x0 = pk2(a0.x, a0.y), x1 = pk2(a1.x, a1.y), x2 = pk2(b0.x, b0.y), x3 = pk2(b1.x, b1.y);
                Vt[(16 * qA + 2 * e) * 136 + ik] = (bf16_t)(x0 & 0xffffu); Vt[(16 * qA + 2 * e + 1) * 136 + ik] = (bf16_t)(x0 >> 16);
                Vt[(16 * qA + 8 + 2 * e) * 136 + ik] = (bf16_t)(x1 & 0xffffu); Vt[(16 * qA + 8 + 2 * e + 1) * 136 + ik] = (bf16_t)(x1 >> 16);
                Vt[(64 + 16 * qA + 2 * e) * 136 + ik] = (bf16_t)(x2 & 0xffffu); Vt[(64 + 16 * qA + 2 * e + 1) * 136 + ik] = (bf16_t)(x2 >> 16);
                Vt[(64 + 16 * qA + 8 + 2 * e) * 136 + ik] = (bf16_t)(x3 & 0xffffu); Vt[(64 + 16 * qA + 8 + 2 * e + 1) * 136 + ik] = (bf16_t)(x3 >> 16); } }
        LDS_BARRIER();
        const int dir = F.wave >> 2, mt = F.wave & 3;
        bf16x8 vf[4];
#pragma unroll
        for (int ks = 0; ks < 4; ++ks) vf[ks] = ldfrag_sw(Vt + (dir * 64 + mt * 16) * 136, 136, ks * 32, mt, lane);
        bf16_t* out = KV + ((size_t)(((b * 8 + hd) * 2 + dir) * NCH + c)) * 4096 + (mt * 16 + (lane & 15)) * 64 + 8 * (lane >> 4);
#pragma unroll
        for (int p = 0; p < 2; ++p) { u32x4 ww;
#pragma unroll
            for (int h = 0; h < 2; ++h) { f32x4 acc = zero4(); const int r = lane & 15, d = 32 * p + 8 * (r >> 2) + 4 * h + (r & 3), kkey = (d >> 3) & 3;
#pragma unroll
                for (int ks = 0; ks < 4; ++ks) acc = mfma16(*(const LAS bf16x8*)(Kt + (dir * 64 + d) * 136 + ((ks * 32 + 8 * (lane >> 4)) ^ (kkey << 4))), vf[ks], acc);
                if (h == 0) { ww.x = pk2(acc[0], acc[1]); ww.y = pk2(acc[2], acc[3]); } else { ww.z = pk2(acc[0], acc[1]); ww.w = pk2(acc[2], acc[3]); } }
            *(u32x4*)(out + 32 * p) = ww; }
    }
    __syncthreads();
}
__device__ __forceinline__ void ret_scan(CArgs& A, int l, int gidx, int gstride) {
    bf16_t* KV = (bf16_t*)(A.ws + WS_KV);
    for (int idx = gidx; idx < NB * 8 * 2 * 1024; idx += gstride) {
        const int e4 = idx & 1023, chain = idx >> 10, dir = chain & 1, hd = (chain >> 1) & 7;
        const float lg_ = log2_gamma(A, l, dir, hd), cdec = fexp2(128.0f * lg_), cfo = dir == 0 ? fexp2(lg_) : cdec;
        u32x2* base = (u32x2*)(KV + (size_t)chain * NCH * 4096) + e4;
        f32x4 s = zero4();
#pragma unroll
        for (int half = 0; half < 2; ++half) { u32x2 v[17];
#pragma unroll
            for (int j = 0; j < 17; ++j) { const int k = half * 17 + j, c = dir == 0 ? k : (k < 2 ? 1 - k : NCH + 1 - k); v[j] = base[(size_t)c * 1024]; }
#pragma unroll
            for (int j = 0; j < 17; ++j) { const int k = half * 17 + j, c = dir == 0 ? k : (k < 2 ? 1 - k : NCH + 1 - k);
                u32x2 o; o.x = pk2(s[0] * cfo, s[1] * cfo); o.y = pk2(s[2] * cfo, s[3] * cfo); base[(size_t)c * 1024] = o;
                s = s * cdec + (f32x4){bflo(v[j].x), bfhi(v[j].x), bflo(v[j].y), bfhi(v[j].y)}; } }
    }
}
struct RetRaw { u32x4 q0, q1, k0, k1, v0, v1, sf, sb; };
constexpr int RET_BUF_E = 2 * 128 * 72 + 64 * 136 + 2 * 64 * 72;
static_assert(2 * RET_BUF_E * 2 <= LC_MISC, "ret_out LDS");
__device__ __forceinline__ void ret_decode(int it, int c_lo, int nch, int& hd, int& c, int& b) { hd = it & 7; const int bc = it >> 3; c = c_lo + bc % nch; b = bc / nch; }
__device__ __forceinline__ void ret_load(RetRaw& R, CArgs& A, int it, int c_lo, int nch, int tok, int q, int tid) {
    int hd, c, b; ret_decode(it, c_lo, nch, hd, c, b);
    const bf16_t* Z = (const bf16_t*)(A.ws + WS_Z); const bf16_t* KV = (const bf16_t*)(A.ws + WS_KV);
    const int zrow = ret_row0(b, c) + tok; const bf16_t* zq = Z + z_off(zrow, OFF_Q + hd * 64); const bf16_t* zk = Z + z_off(zrow, OFF_K + hd * 64); const bf16_t* zv = Z + z_off(zrow, OFF_V + hd * 64);
    R.q0 = *(const u32x4*)(zq + 8 * q); R.q1 = *(const u32x4*)(zq + 32 + 8 * q);
    R.k0 = *(const u32x4*)(zk + 8 * q); R.k1 = *(const u32x4*)(zk + 32 + 8 * q);
    R.v0 = *(const u32x4*)(zv + 16 * q); R.v1 = *(const u32x4*)(zv + 16 * q + 8);
    const bf16_t* kvf = KV + ((size_t)(((b * 8 + hd) * 2 + 0) * NCH + c)) * 4096 + (tid >> 3) * 64 + 8 * (tid & 7);
    R.sf = *(const u32x4*)kvf; R.sb = *(const u32x4*)(kvf + (size_t)NCH * 4096);
}
__device__ __forceinline__ void rot_pack(const u32x4 a8, const u32x4 b8, const f32x4 (&cs)[4], float scale, u32x4& lo, u32x4& hi) {
    float a[8], b[8], l[8], h[8]; unpack8(a8, a); unpack8(b8, b);
#pragma unroll
    for (int e2 = 0; e2 < 4; ++e2) { const f32x4 w = cs[e2];
        l[2 * e2] = (a[2 * e2] * w.x - b[2 * e2] * w.y) * scale; h[2 * e2] = (a[2 * e2] * w.y + b[2 * e2] * w.x) * scale;
        l[2 * e2 + 1] = (a[2 * e2 + 1] * w.z - b[2 * e2 + 1] * w.w) * scale; h[2 * e2 + 1] = (a[2 * e2 + 1] * w.w + b[2 * e2 + 1] * w.z) * scale; }
    lo.x = pk2(l[0], l[1]); lo.y = pk2(l[2], l[3]); lo.z = pk2(l[4], l[5]); lo.w = pk2(l[6], l[7]);
    hi.x = pk2(h[0], h[1]); hi.y = pk2(h[2], h[3]); hi.z = pk2(h[4], h[5]); hi.w = pk2(h[6], h[7]);
}
__device__ __forceinline__ int ret_vrow(int dv) { return 32 * (dv >> 5) + 16 * ((dv >> 2) & 1) + 4 * ((dv >> 3) & 3) + (dv & 3); }
__device__ __forceinline__ void ret_stage(const RetRaw& C, LAS bf16_t* B, int c, int tok, int q, int tid, float sqf, float skf, float sqb, float skb, const f32x2 (&invf)[4], const RotCS& SL, u32x4 (&qf)[2][2]) {
    LAS bf16_t* Ks = B; LAS bf16_t* Vt = B + 2 * 128 * 72; LAS bf16_t* Sn = Vt + 64 * 136;
    { const int colp = (tok & ~31) + pg8::perm32(tok & 31);
#pragma unroll
        for (int e = 0; e < 16; ++e) { const unsigned w_ = e < 8 ? C.v0[e >> 1] : C.v1[(e - 8) >> 1]; const bf16_t val = (bf16_t)((e & 1) ? (w_ >> 16) : (w_ & 0xffffu));
            const int row = ret_vrow(16 * q + e);
            Vt[row * 136 + (colp ^ ((row >> 4) << 5))] = val; } }
    { u32x4 lo, hi; RotCS Rf, Rb; f32x2 ka[4], kb[4], qa[4], qb[4];
        unpack_pairs(C.k0, ka); unpack_pairs(C.k1, kb); unpack_pairs(C.q0, qa); unpack_pairs(C.q1, qb);
        rot_fwd(ret_pos0(c) + tok, invf, Rf);
        if (c < 2) { RotCS Sc; rot_fwd(CTXL - 1, invf, Sc); rot_bwd(Rf, Sc, Rb); } else rot_bwd(Rf, SL, Rb);
        rot_pk2(ka, kb, Rf, skf, lo, hi); *(LAS u32x4*)(Ks + tok * 72 + 8 * q) = lo; *(LAS u32x4*)(Ks + tok * 72 + 32 + 8 * q) = hi;
        rot_pk2(qa, qb, Rf, sqf, qf[0][0], qf[0][1]);
        rot_pk2(ka, kb, Rb, skb, lo, hi); *(LAS u32x4*)(Ks + (128 + tok) * 72 + 8 * q) = lo; *(LAS u32x4*)(Ks + (128 + tok) * 72 + 32 + 8 * q) = hi;
        rot_pk2(qa, qb, Rb, sqb, qf[1][0], qf[1][1]); }
    { const int srow = ret_vrow(tid >> 3); *(LAS u32x4*)(Sn + srow * 72 + 8 * (tid & 7)) = C.sf; *(LAS u32x4*)(Sn + (64 + srow) * 72 + 8 * (tid & 7)) = C.sb; }
}
__device__ __forceinline__ void ret_compute(const LAS bf16_t* B, const u32x4 (&qf)[2][2], int w, int lane, f32x4 (&o)[4]) {
    const LAS bf16_t* Ks = B; const LAS bf16_t* Vt = B + 2 * 128 * 72; const LAS bf16_t* Sn = Vt + 64 * 136;
    const int fr = lane & 15, fq = lane >> 4, ii = 16 * w + fr, wh = w >> 1, nf = wh + 1;
    const f32x4 Z0 = zero4();
#pragma unroll
    for (int t = 0; t < 4; ++t) o[t] = Z0;
#pragma unroll
    for (int s = 0; s < 5; ++s) {
        const bool bwd = s >= nf;
        const int ks = bwd ? wh + (s - nf) : s;
        const LAS bf16_t* Kd = Ks + (bwd ? 128 * 72 : 0) + ks * 32 * 72;
        const bf16x8 qa0 = __builtin_bit_cast(bf16x8, bwd ? qf[1][0] : qf[0][0]), qa1 = __builtin_bit_cast(bf16x8, bwd ? qf[1][1] : qf[0][1]);
        f32x4 s0 = mfma16(ldfrag(Kd, 72, 0, lane), qa0, Z0); s0 = mfma16(ldfrag(Kd, 72, 32, lane), qa1, s0);
        f32x4 s1 = mfma16(ldfrag(Kd + 16 * 72, 72, 0, lane), qa0, Z0); s1 = mfma16(ldfrag(Kd + 16 * 72, 72, 32, lane), qa1, s1);
        const int j0 = ks * 32 + 4 * fq;
        float d0[4], d1[4];
#pragma unroll
        for (int j = 0; j < 4; ++j) { d0[j] = ((j0 + j <= ii) != bwd) ? s0[j] : 0.f; d1[j] = ((j0 + 16 + j <= ii) != bwd) ? s1[j] : 0.f; }
        u32x4 pw; pw.x = pk2(d0[0], d0[1]); pw.y = pk2(d0[2], d0[3]); pw.z = pk2(d1[0], d1[1]); pw.w = pk2(d1[2], d1[3]);
        const bf16x8 sa = __builtin_bit_cast(bf16x8, pw);
#pragma unroll
        for (int t = 0; t < 4; ++t) o[t] = mfma16(*(const LAS bf16x8*)(Vt + (t * 16 + fr) * 136 + ((ks * 32 + 8 * fq) ^ (t << 5))), sa, o[t]);
    }
#pragma unroll
    for (int dir = 0; dir < 2; ++dir) { const bf16x8 qa0 = __builtin_bit_cast(bf16x8, qf[dir][0]), qa1 = __builtin_bit_cast(bf16x8, qf[dir][1]);
#pragma unroll
        for (int t = 0; t < 4; ++t) { o[t] = mfma16(ldfrag(Sn + (dir * 64 + t * 16) * 72, 72, 0, lane), qa0, o[t]); o[t] = mfma16(ldfrag(Sn + (dir * 64 + t * 16) * 72, 72, 32, lane), qa1, o[t]); } }
}
__device__ __forceinline__ void phase_ret_out(Frame& F, int l) {
    CArgs& A = *get_args();
    bf16_t* MIX = (bf16_t*)A.out; const bf16_t* Z = (const bf16_t*)(A.ws + WS_Z);
    LAS bf16_t* L0 = (LAS bf16_t*)F.lds;
    const int lane = F.lane, fr = lane & 15, fq = lane >> 4, w = F.wave, tok = 16 * w + fr;
    const int c_lo = (l == DEPTH - 1) ? 2 : 0, nch = NCH - c_lo, nit = NB * nch * 8;
    const int hd = F.bx & 7;
    const float lgf = log2_gamma(A, l, 0, hd), lgb = log2_gamma(A, l, 1, hd);
    const float sqf = fexp2((float)tok * lgf), skf = 0.125f * fexp2(-(float)tok * lgf), sqb = fexp2(-(float)tok * lgb), skb = 0.125f * fexp2((float)tok * lgb);
    f32x4 gwv[4];
#pragma unroll
    for (int t = 0; t < 4; ++t) gwv[t] = *(const f32x4*)(A.in[21] + l * 512 + hd * 64 + 32 * (t >> 1) + 8 * fq + 4 * (t & 1));
    f32x2 invf[4]; RotCS SL; rot_invf(fq, invf); rot_fwd(CTXL + SEQ + CTXL - 1, invf, SL);
    RetRaw R; u32x4 qc[2][2], qn[2][2];
    RetSeq Q; Q.init(F.bx, F.G, nit, 7);
    if (Q.cnt > 0) { const int it0 = Q.item(0); int h0_, c0_, b0_; ret_decode(it0, c_lo, nch, h0_, c0_, b0_); ret_load(R, A, it0, c_lo, nch, tok, fq, F.tid); ret_stage(R, L0, c0_, tok, fq, F.tid, sqf, skf, sqb, skb, invf, SL, qc); ret_load(R, A, Q.item_cl(1), c_lo, nch, tok, fq, F.tid); }
    LDS_BARRIER();
    int p = 0;
    for (int k = 0; k < Q.cnt; ++k, p ^= 1) { const int it = Q.item(k);
        int hd_, c, b; ret_decode(it, c_lo, nch, hd_, c, b);
        const size_t orow = (size_t)(ret_row0(b, c) + tok);
        u32x4 gg[2];
#pragma unroll
        for (int p2 = 0; p2 < 2; ++p2) gg[p2] = *(const u32x4*)(Z + z_off((int)orow, OFF_G + hd * 64) + 32 * p2 + 8 * fq);
        { int h1_, c1_, b1_; ret_decode(Q.item_cl(k + 1), c_lo, nch, h1_, c1_, b1_);
          ret_stage(R, L0 + (p ^ 1) * RET_BUF_E, c1_, tok, fq, F.tid, sqf, skf, sqb, skb, invf, SL, qn); }
        ret_load(R, A, Q.item_cl(k + 2), c_lo, nch, tok, fq, F.tid);
        f32x4 o[4];
        ret_compute(L0 + p * RET_BUF_E, qc, w, lane, o);
        float s1 = 0.f;
#pragma unroll
        for (int t = 0; t < 4; ++t) s1 += (o[t][0] + o[t][1]) + (o[t][2] + o[t][3]);
        s1 += __shfl_xor(s1, 16); s1 += __shfl_xor(s1, 32);
        const float mu = s1 * (1.0f / 64.0f); float s2 = 0.f;
#pragma unroll
        for (int t = 0; t < 4; ++t) { o[t] = o[t] - mu; s2 += (o[t][0] * o[t][0] + o[t][1] * o[t][1]) + (o[t][2] * o[t][2] + o[t][3] * o[t][3]); }
        s2 += __shfl_xor(s2, 16); s2 += __shfl_xor(s2, 32);
        const float rstd = 1.0f / sqrtf(s2 * (1.0f / 64.0f) + 1e-5f);
#pragma unroll
        for (int p2 = 0; p2 < 2; ++p2) { const f32x4 o0 = o[2 * p2], o1 = o[2 * p2 + 1], w0 = gwv[2 * p2], w1 = gwv[2 * p2 + 1]; const u32x4 g4 = gg[p2];
            u32x4 ww; ww.x = pk2(o0[0] * rstd * w0.x * siluf_(bflo(g4.x)), o0[1] * rstd * w0.y * siluf_(bfhi(g4.x))); ww.y = pk2(o0[2] * rstd * w0.z * siluf_(bflo(g4.y)), o0[3] * rstd * w0.w * siluf_(bfhi(g4.y)));
            ww.z = pk2(o1[0] * rstd * w1.x * siluf_(bflo(g4.z)), o1[1] * rstd * w1.y * siluf_(bfhi(g4.z))); ww.w = pk2(o1[2] * rstd * w1.z * siluf_(bflo(g4.w)), o1[3] * rstd * w1.w * siluf_(bfhi(g4.w)));
            *(u32x4*)(MIX + orow * D + 256 + hd * 64 + 32 * p2 + 8 * fq) = ww; }
        LDS_BARRIER();
#pragma unroll
        for (int d = 0; d < 2; ++d) { qc[d][0] = qn[d][0]; qc[d][1] = qn[d][1]; }
    }
    __syncthreads();
}

__device__ __forceinline__ void s5_build_item(Frame& F, CArgs& A, int l, int g, int sub) {
    constexpr int PS = 130;
    LAS float* AP = (LAS float*)F.lds;
    LAS float* BB = AP + 2 * 17 * PS;
    LAS float* CC = BB + 2 * 64 * 16 * 2;
    LAS float* KK = CC + 2 * 16 * PS;
    __syncthreads();
    if (F.tid < 128) { const int dir = F.tid >> 6, p = F.tid & 63, pg = (l * 2 + dir) * 16 + g;
        const float are = A.in[10][pg * 64 + p], aim = A.in[11][pg * 64 + p], dt = fexp(A.in[12][pg]);
        const float mag = fexp(dt * are); float sn, cs; sincos_d(dt * aim, sn, cs);
        const float abr = mag * cs, abi = mag * sn, inv = 1.0f / (are * are + aim * aim);
        const float fre = ((abr - 1.0f) * are + abi * aim) * inv, fim = (abi * are - (abr - 1.0f) * aim) * inv;
        f32x4 brv[4], biv[4]; float crv[16], civ[16];
#pragma unroll
        for (int q4 = 0; q4 < 4; ++q4) { brv[q4] = *(const f32x4*)(A.in[13] + (size_t)(pg * 64 + p) * 16 + 4 * q4); biv[q4] = *(const f32x4*)(A.in[14] + (size_t)(pg * 64 + p) * 16 + 4 * q4); }
#pragma unroll
        for (int h = 0; h < 16; ++h) { crv[h] = A.in[15][(pg * 16 + h) * 64 + p]; civ[h] = A.in[16][(pg * 16 + h) * 64 + p]; }
        float pr = 1.f, pi = 0.f; asm volatile("" : "+v"(pr), "+v"(pi));
#pragma unroll
        for (int t = 0; t <= 16; ++t) { *(LAS f32x2*)(AP + (dir * 17 + t) * PS + p * 2) = (f32x2){pr, pi}; const float nr = pr * abr - pi * abi, ni = pr * abi + pi * abr; pr = nr; pi = ni; }
#pragma unroll
        for (int h = 0; h < 16; ++h) { const float br = brv[h >> 2][h & 3], bi = biv[h >> 2][h & 3];
            BB[(dir * 64 + p) * 16 + h] = fre * br - fim * bi; BB[2048 + (dir * 64 + p) * 16 + h] = fre * bi + fim * br;
            *(LAS f32x2*)(CC + (dir * 16 + h) * PS + p * 2) = (f32x2){crv[h], civ[h]}; } }
    __syncthreads();
    {
        const int ho = F.lane & 15, hq = F.lane >> 4;
        for (int cb = F.wave; cb < 32; cb += NWAVES) { const int dir = cb >> 4, tau = cb & 15;
            if (dir == 0 ? tau > sub : tau > 15 - sub) continue;
            f32x2 s0 = (f32x2){0.f, 0.f}, s1 = (f32x2){0.f, 0.f};
            for (int p = 0; p < 64; ++p) { const f32x2 a = *(const LAS f32x2*)(AP + (dir * 17 + tau) * PS + p * 2), c = *(const LAS f32x2*)(CC + (dir * 16 + ho) * PS + p * 2);
                const float tr = c.x * a.x - c.y * a.y, ti = c.x * a.y + c.y * a.x;
                const f32x4 br = *(const LAS f32x4*)(BB + (dir * 64 + p) * 16 + 4 * hq), bi = *(const LAS f32x4*)(BB + 2048 + (dir * 64 + p) * 16 + 4 * hq);
                s0 = s0 + (f32x2){br.x, br.y} * tr - (f32x2){bi.x, bi.y} * ti; s1 = s1 + (f32x2){br.z, br.w} * tr - (f32x2){bi.z, bi.w} * ti; }
            *(LAS f32x4*)(KK + ((dir * 16 + tau) * 16 + ho) * 16 + 4 * hq) = (f32x4){s0.x, s0.y, s1.x, s1.y}; } }
    __syncthreads();
    bf16_t* W1 = (bf16_t*)(A.ws + WS_S5W1) + (size_t)g * 256 * 256; bf16_t* W2 = (bf16_t*)(A.ws + WS_S5W2) + (size_t)g * 256 * 512;
    for (int idx = F.tid; idx < 16 * 256; idx += NTHR) { const int k = idx & 255, n = sub * 16 + (idx >> 8), j = k >> 4, hi = k & 15;
        { const int dir = n >> 7, im = (n >> 6) & 1, p = n & 63, tau = dir == 0 ? 15 - j : j;
            const float ar = AP[(dir * 17 + tau) * PS + p * 2], ai = AP[(dir * 17 + tau) * PS + p * 2 + 1], br = BB[(dir * 64 + p) * 16 + hi], bi = BB[2048 + (dir * 64 + p) * 16 + hi];
            W1[(size_t)n * 256 + k] = (bf16_t)f2bf(im ? ar * bi + ai * br : ar * br - ai * bi); }
        { const int t = n >> 4, ho = n & 15; float v;
            if (j < t) v = KK[((0 * 16 + (t - j)) * 16 + ho) * 16 + hi]; else if (j > t) v = KK[((1 * 16 + (j - t)) * 16 + ho) * 16 + hi];
            else v = KK[((0 * 16 + 0) * 16 + ho) * 16 + hi] + KK[((1 * 16 + 0) * 16 + ho) * 16 + hi] + (ho == hi ? A.in[17][l * 256 + g * 16 + ho] : 0.f);
            W2[(size_t)n * 512 + k] = (bf16_t)f2bf(v); }
        { const int t = n >> 4, ho = n & 15, dir = k >> 7, im = (k >> 6) & 1, p = k & 63, tau = dir == 0 ? t + 1 : 16 - t;
            const float ar = AP[(dir * 17 + tau) * PS + p * 2], ai = AP[(dir * 17 + tau) * PS + p * 2 + 1], cr = CC[(dir * 16 + ho) * PS + p * 2], ci = CC[(dir * 16 + ho) * PS + p * 2 + 1];
            W2[(size_t)n * 512 + 256 + k] = (bf16_t)f2bf(im ? -(cr * ai + ci * ar) : cr * ar - ci * ai); } }
    __syncthreads();
}
__device__ __forceinline__ void phase_s5_local(Frame& F) {
    CArgs& A = *get_args();
    pg8::S5Order S{F.G, F.bx, 256, (const char*)(A.ws + WS_S5W1), (size_t)256 * 256 * 2};
    pg8::EpiHloc E{(bf16_t*)(A.ws + WS_HLOC), NCR};
    pg8::gemm_phase<pg8::EpiHloc, pg8::S5Order, true>(F.lds, F.tid, (const char*)(A.ws + WS_A2), 256, S, E);
}
__device__ __forceinline__ int s5_chain_cr(int b, int dir, int k) {
    constexpr int ncc = CTXL / S5T, ncl = SEQ / S5T;
    if (dir == 0) return k < ncc ? b * ncc + k : RC / S5T + b * ncl + (k - ncc);
    return k < ncc ? b * ncc + (ncc - 1 - k) : RC / S5T + b * ncl + (ncl - 1 - (k - ncc));
}
__device__ __forceinline__ void s5_scan_block(Frame& F, CArgs& A, int l, int chain) {
    LAS float* ex = (LAS float*)F.lds;
    const int dir = chain & 1, g = (chain >> 1) & 15, b = chain >> 5, pg = (l * 2 + dir) * 16 + g, p = F.lane, w = F.wave;
    const float are = A.in[10][pg * 64 + p], aim = A.in[11][pg * 64 + p], dt = fexp(A.in[12][pg]);
    const float mag = fexp(dt * are); float sn, cs; sincos_d(dt * aim, sn, cs);
    float ar = mag * cs, ai = mag * sn;
#pragma unroll
    for (int s = 0; s < 4; ++s) { const float nr = ar * ar - ai * ai, ni = 2.f * ar * ai; ar = nr; ai = ni; }
    const bf16_t* HLOC = (const bf16_t*)(A.ws + WS_HLOC); bf16_t* A2 = (bf16_t*)(A.ws + WS_A2);
    float lr[34], li[34];
#pragma unroll
    for (int j = 0; j < 34; ++j) { const int cr = s5_chain_cr(b, dir, w * 34 + j); const size_t o = ((size_t)g * 2304 + cr) * 256 + dir * 128 + p; lr[j] = bf2f(HLOC[o]); li[j] = bf2f(HLOC[o + 64]); }
    float hr = 0.f, hi = 0.f;
#pragma unroll
    for (int j = 0; j < 34; ++j) { const float nr = ar * hr - ai * hi + lr[j], ni = ar * hi + ai * hr + li[j]; hr = nr; hi = ni; }
    __syncthreads();
    ex[(w * 64 + p) * 2] = hr; ex[(w * 64 + p) * 2 + 1] = hi;
    __syncthreads();
    float br = ar, bi = ai;
#pragma unroll
    for (int s = 0; s < 5; ++s) { const float nr = br * br - bi * bi, ni = 2.f * br * bi; br = nr; bi = ni; }
    { const float x2r = ar * ar - ai * ai, x2i = 2.f * ar * ai; const float nr = br * x2r - bi * x2i, ni = br * x2i + bi * x2r; br = nr; bi = ni; }
    hr = 0.f; hi = 0.f;
    for (int ww = 0; ww < w; ++ww) { const float er = ex[(ww * 64 + p) * 2], ei = ex[(ww * 64 + p) * 2 + 1]; const float nr = br * hr - bi * hi + er, ni = br * hi + bi * hr + ei; hr = nr; hi = ni; }
#pragma unroll
    for (int j = 0; j < 34; ++j) { const int cr = s5_chain_cr(b, dir, w * 34 + j); const size_t o = ((size_t)g * 2304 + cr) * 512 + 256 + dir * 128 + p;
        A2[o] = (bf16_t)f2bf(hr); A2[o + 64] = (bf16_t)f2bf(hi);
        const float nr = ar * hr - ai * hi + lr[j], ni = ar * hi + ai * hr + li[j]; hr = nr; hi = ni; }
}
__device__ __forceinline__ void phase_s5_out(Frame& F) {
    CArgs& A = *get_args();
    pg8::S5Order S{F.G, F.bx, 512, (const char*)(A.ws + WS_S5W2), (size_t)256 * 512 * 2};
    pg8::EpiS5Z E{(bf16_t*)(A.ws + WS_ZB), NCR};
    pg8::gemm_phase<pg8::EpiS5Z, pg8::S5Order, true>(F.lds, F.tid, (const char*)(A.ws + WS_A2), 512, S, E);
}
__device__ __forceinline__ void phase_glu(Frame& F, int l) {
    CArgs& A = *get_args();
    pg8::GluOrder S{RT / 256, F.G, F.bx, (const char*)(A.ws + WS_GLUT)};
    pg8::EpiGlu E{(const bf16_t*)(A.ws + WS_ZB), (bf16_t*)((unsigned char*)A.out), A.in[19] + l * 256};
    pg8::gemm_phase<pg8::EpiGlu, pg8::GluOrder, true>(F.lds, F.tid, (const char*)(A.ws + WS_ZB), 256, S, E);
}

__device__ __forceinline__ int lane_id_now() { int l; asm volatile("v_mbcnt_lo_u32_b32 %0, -1, 0\n\tv_mbcnt_hi_u32_b32 %0, -1, %0" : "=v"(l)); return l; }
__global__ void __launch_bounds__(NTHR, 2) mk_fwd(Args args) {
    extern __shared__ __attribute__((aligned(16))) unsigned char lds_raw[];
#define MKF() Frame F; { int t_ = HW_TID(); asm volatile("" : "+v"(t_)); { unsigned lb_ = (unsigned)(uintptr_t)(LAS unsigned char*)lds_raw; asm volatile("" : "+s"(lb_)); F.lds = (LAS unsigned char*)(uintptr_t)lb_; } F.tid = t_; F.lane = t_ & 63; F.wave = __builtin_amdgcn_readfirstlane(t_ >> 6); \
        int b_ = blockIdx.x; asm volatile("" : "+s"(b_)); F.bx = b_; F.G = gridDim.x; F.gw = b_ * NWAVES + F.wave; F.NGW = F.G * NWAVES; }
    const int wv_ = __builtin_amdgcn_readfirstlane((int)threadIdx.x >> 6);
#define HW_TID() (wv_ * 64 + lane_id_now())
    volatile LAS unsigned* MISC = (volatile LAS unsigned*)((LAS unsigned char*)lds_raw + LC_MISC);
    if (HW_TID() < 32) MISC[HW_TID()] = 0u;
    __syncthreads();
    XcdBarrier bar = xcd_barrier_post((unsigned*)(get_args()->ws + WS_CTL) + CW_BAR, MISC + 8, HW_TID() == 0);
#ifndef PROBE_MASK
#define PROBE_MASK 0u
#endif
    unsigned long long pt_last = 0ull, pt_acc = 0ull; int pt_i = 0;
#define PROBE_TICK() do { if (PROBE_MASK) { const unsigned long long now_ = __builtin_amdgcn_s_memrealtime(); if ((PROBE_MASK >> pt_i) & 1u) pt_acc += now_ - pt_last; pt_last = now_; ++pt_i; } } while (0)
    if (PROBE_MASK) pt_last = __builtin_amdgcn_s_memrealtime();
#define GRID_BAR() do { xcd_barrier(bar, HW_TID() == 0); PROBE_TICK(); } while (0)
    DUP(9) { MKF(); phase_tables(F); }
    DUP(8) { MKF(); phase_weights(F, 0); }
    { MKF(); for (int it = F.bx; it < 256; it += F.G) s5_build_item(F, *get_args(), 0, it >> 4, it & 15); }
    { const bool never_ = (get_args()->ws == nullptr);
      if (never_) cooperative_groups::this_grid().sync(); else GRID_BAR(); }
#pragma unroll
    for (int l = 0; l < DEPTH; ++l) {
        if (l > 0) { DUP(8) { MKF(); phase_weights(F, l); } PROBE_TICK(); }
        for (int rep_ = 0; rep_ < ((((PROBE_DUP) >> 10) & 1) && l == 0 ? 2 : 1); ++rep_) { MKF(); phase_prenorm(F, l); }
        if (l == 0) { MKF(); router_precompute(F, l, F.bx, F.G); }
        else { MKF();
            const int pd = queue_done(CW_PRE), bd = queue_done(CW_BLD);
            router_precompute(F, l, (pd < 9 * 16 ? pd : 9 * 16) + F.bx, F.G);
            for (int it = (bd < 256 ? bd : 256) + F.bx; it < 256; it += F.G) s5_build_item(F, *get_args(), l, it >> 4, it & 15); }
        GRID_BAR();
        DUP(0) { MKF(); phase_gemm_in(F); } GRID_BAR();
        DUP(11) { MKF(); phase_s5_local(F); } PROBE_TICK();
        DUP(4) { MKF(); phase_ret_kv(F, l); }
        GRID_BAR();
        { MKF(); for (int ch = F.bx; ch < NB * 16 * 2; ch += F.G) s5_scan_block(F, *get_args(), l, ch); PROBE_TICK();
            ret_scan(*get_args(), l, F.bx * NTHR + F.tid, F.G * NTHR); }
        GRID_BAR();
        DUP(6) { MKF(); phase_s5_out(F); } PROBE_TICK();
        DUP(5) { MKF(); phase_ret_out(F, l); }
        GRID_BAR();
        DUP(12) { MKF(); phase_glu(F, l); } PROBE_TICK();
        DUP(7) { MKF(); phase_pool(F, l); }
        GRID_BAR();
        { MKF(); const bool idle = phase_gemm_out(F, l); if (l + 1 < DEPTH && idle) tail_builder(F, l + 1); } GRID_BAR();
        { MKF(); phase_router(F, l); } GRID_BAR();
        { MKF(); const bool idle = phase_moe1(F, l); if (l + 1 < DEPTH && idle) tail_builder(F, l + 1); } GRID_BAR();
        { MKF(); const bool idle = phase_moe2(F, l); if (l + 1 < DEPTH && idle) tail_precompute(F, l + 1); } GRID_BAR();
    }
    { MKF(); phase_final(F); }
    if (PROBE_MASK) { __syncthreads(); PROBE_TICK();
        if (get_args()->ws && __builtin_amdgcn_readfirstlane((int)blockIdx.x) == 0) { const unsigned long long t0_ = __builtin_amdgcn_s_memrealtime(); while (__builtin_amdgcn_s_memrealtime() - t0_ < 8ull * pt_acc) __builtin_amdgcn_s_sleep(8); } }
}

extern "C" void kernel_launch(void* const* d_in, const int* in_sizes, int n_in, void* d_out, int out_size, void* d_ws, size_t ws_size, hipStream_t stream) {
    static int grid = 0;
    if (grid == 0) {
        if (n_in != 30 || out_size != RL * D || ws_size < WS_END) { fprintf(stderr, "kernel_launch: unexpected shapes (n_in %d out %d ws %zu)\n", n_in, out_size, ws_size); grid = -1; return; }
        int dev = 0, cus = 0, per_cu = 0;
        (void)hipGetDevice(&dev); (void)hipDeviceGetAttribute(&cus, hipDeviceAttributeMultiprocessorCount, dev);
        (void)hipFuncSetAttribute((const void*)mk_fwd, hipFuncAttributeMaxDynamicSharedMemorySize, LDS_BYTES);
        (void)hipOccupancyMaxActiveBlocksPerMultiprocessor(&per_cu, (const void*)mk_fwd, NTHR, LDS_BYTES);
        (void)hipGetLastError();
        if (cus % 8 != 0) { fprintf(stderr, "kernel_launch: %d CUs: this kernel needs a CU count that is a multiple of 8\n", cus); grid = -1; return; }
        if (per_cu < 1) { fprintf(stderr, "kernel_launch: occupancy query says %d blocks per CU\n", per_cu); grid = -1; return; }
        grid = cus;
        fprintf(stderr, "kernel_launch: cus %d per_cu %d grid %d ws %zu\n", cus, per_cu, grid, ws_size);
    }
    if (grid < 0) return;
    (void)hipMemsetAsync((char*)d_ws + WS_CTL, 0, CTL_BYTES, stream);
    Args a{}; for (int i = 0; i < 30; ++i) a.in[i] = (const float*)d_in[i];
    a.out = (float*)d_out; a.ws = (unsigned char*)d_ws;
    void* kargs[] = {&a};
    hipError_t e = hipLaunchCooperativeKernel((const void*)mk_fwd, dim3(grid), dim3(NTHR), kargs, LDS_BYTES, stream);
    if (e != hipSuccess) fprintf(stderr, "kernel_launch: cooperative launch failed: %s (grid %d)\n", hipGetErrorString(e), grid);
}
```
